# Optimizing an MI355X kernel written in HIP

```python
import jax, jax.numpy as jnp
from jax import lax
import numpy as np

D_MODEL = 1024
BATCH = 8
SEQ = 2048
DEPTH = 2
DEC_BATCH = 128
DEC_SEQ = 8
PAST_LEN = 16384
PAGE_SIZE = 128

GLA_HEADS = 4
GLA_KEY_DIM = D_MODEL // 2
GLA_VAL_DIM = D_MODEL
GLA_HEAD_K = GLA_KEY_DIM // GLA_HEADS
GLA_HEAD_V = GLA_VAL_DIM // GLA_HEADS
GLA_GATE_RANK = 16
GLA_GATE_NORMALIZER = 16.0
GLA_CHUNK = 64
POOL_WIDTH = D_MODEL // 2
POOL_WINDOWS = (2, 4, 8, 16)
POOL_GROUPS = 4
POOL_GROUP_DIM = POOL_WIDTH // POOL_GROUPS
POOL_HIST = 15
SG_WIDTH = D_MODEL // 2
SG_GROUPS = 4
SG_GROUP_DIM = SG_WIDTH // SG_GROUPS
SG_CHUNK = 128
N_BRANCHES = 3
D_FF = 4 * D_MODEL
EPS = 1e-6
SPLIT_SIZES = (GLA_KEY_DIM, GLA_KEY_DIM, GLA_VAL_DIM, GLA_VAL_DIM, GLA_GATE_RANK,
               POOL_WIDTH, SG_WIDTH, SG_WIDTH, N_BRANCHES * D_MODEL)
IN_COLS = 2 * GLA_KEY_DIM + 2 * GLA_VAL_DIM + GLA_GATE_RANK + POOL_WIDTH + 2 * SG_WIDTH + N_BRANCHES * D_MODEL

kernel_name = "hybrid_gla_pool_sgmlp_decode_step"


def rms_norm(x, w):
    xf = x.astype(jnp.float32)
    y = xf * lax.rsqrt(jnp.mean(xf * xf, axis=-1, keepdims=True) + EPS)
    return (y * w.astype(jnp.float32)).astype(x.dtype)


def gla_mix(q, k, v, g_log, s0, chunk):
    n, t, _ = q.shape
    nc = t // chunk

    def heads(a, d):
        return a.astype(jnp.float32).reshape(n, nc, chunk, GLA_HEADS, d).transpose(1, 0, 3, 2, 4)

    qs = heads(q, GLA_HEAD_K) * (GLA_HEAD_K ** -0.5)
    ks = heads(k, GLA_HEAD_K)
    vs = heads(v, GLA_HEAD_V)
    gs = heads(g_log, GLA_HEAD_K)
    tri = jnp.tril(jnp.ones((chunk, chunk), dtype=bool))[:, :, None]

    def step(s, inp):
        qc, kc, vc, gc = inp
        b = jnp.cumsum(gc, axis=2)
        inter = jnp.einsum('nhtd,nhde->nhte', qc * jnp.exp(b), s)
        diff = b[:, :, :, None, :] - b[:, :, None, :, :]
        decay = jnp.exp(jnp.where(tri, diff, -jnp.inf))
        att = jnp.einsum('nhtd,nhsd,nhtsd->nhts', qc, kc, decay)
        o = inter + jnp.einsum('nhts,nhse->nhte', att, vc)
        b_last = b[:, :, -1:, :]
        s_new = jnp.exp(b_last[:, :, 0, :])[..., None] * s + jnp.einsum(
            'nhsd,nhse->nhde', kc * jnp.exp(b_last - b), vc)
        return s_new, o

    s_fin, o = lax.scan(step, s0.astype(jnp.float32), (qs, ks, vs, gs))
    o = o.transpose(1, 0, 3, 2, 4).reshape(n, t, GLA_HEADS, GLA_HEAD_V)
    return o, s_fin


def pool_mix(xp, hist, n_prev, w_mix, scale):
    n, t, _ = xp.shape
    xf = xp.astype(jnp.float32)
    full = jnp.concatenate([hist.astype(jnp.float32), xf], axis=1)
    cs = jnp.concatenate([jnp.zeros((n, 1, POOL_WIDTH), jnp.float32), jnp.cumsum(full, axis=1)], axis=1)
    end = cs[:, POOL_HIST + 1:]
    pos = jnp.arange(t)
    means = []
    for gi, w in enumerate(POOL_WINDOWS):
        lo, hi = gi * POOL_GROUP_DIM, (gi + 1) * POOL_GROUP_DIM
        start = cs[:, POOL_HIST + 1 - w: POOL_HIST + 1 - w + t, lo:hi]
        cnt = jnp.minimum(w, pos + 1 + n_prev).astype(jnp.float32)[None, :, None]
        means.append((end[:, :, lo:hi] - start) / cnt)
    pooled = (jnp.concatenate(means, axis=-1) - xf).reshape(n, t, POOL_GROUPS, POOL_GROUP_DIM)
    mixed = jnp.einsum('ntgc,gcd->ntgd', pooled, w_mix.astype(jnp.float32)).reshape(n, t, POOL_WIDTH)
    out = mixed * scale.astype(jnp.float32)
    return out.astype(xp.dtype), full[:, -POOL_HIST:]


def spatial_gate(u, v, w_s, b_s):
    n, t, _ = u.shape
    length = min(t, SG_CHUNK)
    nc = t // length
    w = w_s[:, :length, :length] * jnp.tril(jnp.ones((length, length), w_s.dtype))
    vg = v.reshape(n, nc, length, SG_GROUPS, SG_GROUP_DIM)
    mixed = jnp.einsum('gts,ncsgd->nctgd', w, vg) + b_s[:, :length].T[None, None, :, :, None]
    return u * mixed.reshape(n, t, SG_WIDTH)


def mixer_block(h, norm_mix, w_in, w_gk2, b_gk, gla_norm, w_pool_mix, pool_scale,
                w_spatial, b_spatial, w_br_a, w_br_b, w_br_c, w_out,
                s_gla, pool_hist, n_prev, gla_chunk):
    n, t, _ = h.shape
    hn = rms_norm(h, norm_mix)
    proj = hn @ w_in
    offs = [int(o) for o in np.cumsum(SPLIT_SIZES)[:-1]]
    q, k, v, g_out, g_lr, xp, u, vv, gates = jnp.split(proj, offs, axis=-1)
    g_log = jax.nn.log_sigmoid((g_lr @ w_gk2 + b_gk).astype(jnp.float32)) / GLA_GATE_NORMALIZER
    o, s_new = gla_mix(q, k, v, g_log, s_gla, gla_chunk)
    o = rms_norm(o, gla_norm) * jax.nn.silu(g_out.astype(jnp.float32).reshape(n, t, GLA_HEADS, GLA_HEAD_V))
    branch_a = o.reshape(n, t, GLA_VAL_DIM).astype(h.dtype) @ w_br_a
    pool_out, new_hist = pool_mix(xp, pool_hist, n_prev, w_pool_mix, pool_scale)
    branch_b = pool_out @ w_br_b
    u = jax.nn.gelu(u)
    vv = jax.nn.gelu(vv)
    branch_c = spatial_gate(u, vv, w_spatial, b_spatial) @ w_br_c
    ga, gb, gc = jnp.split(jax.nn.sigmoid(gates.astype(jnp.float32)), N_BRANCHES, axis=-1)
    merged = (ga * branch_a + gb * branch_b + gc * branch_c).astype(h.dtype)
    return h + merged @ w_out, s_new, new_hist, vv


def ffn_block(h, norm_ffn, w_ff1, w_ff2):
    hn = rms_norm(h, norm_ffn)
    a = jax.nn.relu(hn @ w_ff1)
    return h + (a * a) @ w_ff2


def setup_inputs(seed: int = 0) -> dict:
    key = jax.random.key(seed)
    ks = jax.random.split(key, 24)
    f32 = jnp.float32

    def nrm(k, shape, scale):
        return jax.random.normal(k, shape, f32) * scale

    return {
        "x_prompt": nrm(ks[0], (BATCH, SEQ, D_MODEL), 1.0),
        "x_sample": nrm(ks[1], (DEC_BATCH, DEC_SEQ, D_MODEL), 1.0),
        "state_gla": nrm(ks[2], (DEPTH, DEC_BATCH, GLA_HEADS, GLA_HEAD_K, GLA_HEAD_V), 1.0),
        "state_pool": nrm(ks[3], (DEPTH, DEC_BATCH, POOL_HIST, POOL_WIDTH), 1.0),
        "norm_mix": 1.0 + nrm(ks[4], (DEPTH, D_MODEL), 0.02),
        "w_in": nrm(ks[5], (DEPTH, D_MODEL, IN_COLS), D_MODEL ** -0.5),
        "w_gk2": nrm(ks[6], (DEPTH, GLA_GATE_RANK, GLA_KEY_DIM), GLA_GATE_RANK ** -0.5),
        "b_gk": nrm(ks[7], (DEPTH, GLA_KEY_DIM), 0.01),
        "gla_norm": 1.0 + nrm(ks[8], (DEPTH, GLA_HEAD_V), 0.02),
        "w_pool_mix": nrm(ks[9], (DEPTH, POOL_GROUPS, POOL_GROUP_DIM, POOL_GROUP_DIM), POOL_GROUP_DIM ** -0.5),
        "pool_scale": 1.0 + nrm(ks[10], (DEPTH, POOL_WIDTH), 0.02),
        "w_spatial": nrm(ks[11], (DEPTH, SG_GROUPS, SG_CHUNK, SG_CHUNK), SG_CHUNK ** -0.5),
        "b_spatial": 1.0 + nrm(ks[12], (DEPTH, SG_GROUPS, SG_CHUNK), 0.02),
        "w_br_a": nrm(ks[13], (DEPTH, GLA_VAL_DIM, D_MODEL), GLA_VAL_DIM ** -0.5),
        "w_br_b": nrm(ks[14], (DEPTH, POOL_WIDTH, D_MODEL), POOL_WIDTH ** -0.5),
        "w_br_c": nrm(ks[15], (DEPTH, SG_WIDTH, D_MODEL), SG_WIDTH ** -0.5),
        "w_out": nrm(ks[16], (DEPTH, D_MODEL, D_MODEL), D_MODEL ** -0.5),
        "norm_ffn": 1.0 + nrm(ks[17], (DEPTH, D_MODEL), 0.02),
        "w_ff1": nrm(ks[18], (DEPTH, D_MODEL, D_FF), D_MODEL ** -0.5),
        "w_ff2": nrm(ks[19], (DEPTH, D_FF, D_MODEL), D_FF ** -0.5),
        "norm_final": 1.0 + nrm(ks[20], (D_MODEL,), 0.02),
    }


def reference(x_prompt, x_sample, state_gla, state_pool, norm_mix, w_in, w_gk2, b_gk, gla_norm,
              w_pool_mix, pool_scale, w_spatial, b_spatial, w_br_a, w_br_b, w_br_c, w_out,
              norm_ffn, w_ff1, w_ff2, norm_final):
    hp, hs = x_prompt, x_sample
    gla_p, gla_s, pool_p, pool_s, sgv_s = [], [], [], [], []
    prompt_chunk = min(GLA_CHUNK, hp.shape[1])
    sample_chunk = hs.shape[1]
    sample_prev = min(PAST_LEN, POOL_HIST)
    for l in range(DEPTH):
        layer_w = (norm_mix[l], w_in[l], w_gk2[l], b_gk[l], gla_norm[l], w_pool_mix[l], pool_scale[l],
                   w_spatial[l], b_spatial[l], w_br_a[l], w_br_b[l], w_br_c[l], w_out[l])
        s0 = jnp.zeros((hp.shape[0], GLA_HEADS, GLA_HEAD_K, GLA_HEAD_V), jnp.float32)
        hist0 = jnp.zeros((hp.shape[0], POOL_HIST, POOL_WIDTH), jnp.float32)
        hp, sp, histp, _ = mixer_block(hp, *layer_w, s0, hist0, 0, prompt_chunk)
        hp = ffn_block(hp, norm_ffn[l], w_ff1[l], w_ff2[l])
        hs, ss, hists, vs = mixer_block(hs, *layer_w, state_gla[l], state_pool[l], sample_prev, sample_chunk)
        hs = ffn_block(hs, norm_ffn[l], w_ff1[l], w_ff2[l])
        gla_p.append(sp.astype(x_prompt.dtype))
        gla_s.append(ss.astype(state_gla.dtype))
        pool_p.append(histp.astype(x_prompt.dtype))
        pool_s.append(hists.astype(state_pool.dtype))
        sgv_s.append(vs)
    y_prompt = rms_norm(hp, norm_final)
    y_sample = rms_norm(hs, norm_final)
    return (y_prompt, y_sample, jnp.stack(gla_p), jnp.stack(gla_s), jnp.stack(pool_p),
            jnp.stack(pool_s), jnp.stack(sgv_s))
```

```cpp
#include <hip/hip_runtime.h>
#include <hip/hip_cooperative_groups.h>
#include <cstdio>
#include <cstdint>

constexpr int D = 1024, NB = 8, SEQ = 2048, DEPTH = 2, SB = 128, ST = 8;
constexpr int MP = NB * SEQ;
constexpr int MS = SB * ST;
constexpr int M = MP + MS;
constexpr int IN_COLS = 7696;
constexpr int NPJ = 7680;
constexpr int FF = 4096;
constexpr float EPS = 1e-6f;
constexpr int C_Q = 0, C_K = 512, C_V = 1024, C_GO = 2048, C_XP = 3072, C_U = 3584, C_VV = 4096, C_G = 4608;
constexpr int MIXW = 2048;

constexpr size_t MiB = 1u << 20;
constexpr size_t WS_CTL = 0, CTL_ZERO_BYTES = 1 * MiB;
constexpr size_t WS_W = 2 * MiB;
constexpr size_t W_LAYER = 37 * MiB, W_IN = 0, W_BR = 15 * MiB, W_OUT = 19 * MiB, W_FF1 = 21 * MiB, W_FF2 = 29 * MiB;
constexpr size_t WS_HN = 76 * MiB;
constexpr size_t WS_GLOG = 110 * MiB;
constexpr size_t WS_MIX = 144 * MiB;
constexpr size_t WS_PROJ = 212 * MiB;
constexpr size_t WS_END = 468 * MiB;
static_assert(WS_PROJ + (size_t)M * NPJ * 2 <= WS_END, "ws map");
static_assert(WS_MIX + (size_t)M * MIXW * 2 <= WS_PROJ, "ws map");
static_assert(WS_GLOG + (size_t)M * 512 * 4 <= WS_MIX, "ws map");
static_assert(WS_HN + (size_t)M * D * 2 <= WS_GLOG, "ws map");
static_assert(WS_W + 2 * W_LAYER <= WS_HN, "ws map");
constexpr int CW_BAR = 4096;

constexpr size_t O_Y = 0;
constexpr size_t O_GLAP = (size_t)M * D;
constexpr size_t O_GLAS = O_GLAP + (size_t)DEPTH * NB * 4 * 128 * 256;
constexpr size_t O_POOLP = O_GLAS + (size_t)DEPTH * SB * 4 * 128 * 256;
constexpr size_t O_POOLS = O_POOLP + (size_t)DEPTH * NB * 15 * 512;
constexpr size_t O_SGV = O_POOLS + (size_t)DEPTH * SB * 15 * 512;
constexpr size_t O_END = O_SGV + (size_t)DEPTH * SB * ST * 512;
static_assert(O_END == 56614912, "output size");

constexpr int RING_BYTES = 131072;
constexpr int LDSCTL_OFF = RING_BYTES, MISC_OFF = LDSCTL_OFF + 320;
constexpr int LDS_BYTES = 147456;
constexpr int NWAVES = 8;

#define GAS __attribute__((address_space(1)))
#define LAS __attribute__((address_space(3)))
typedef unsigned short bf16;
typedef unsigned v4u __attribute__((ext_vector_type(4)));
typedef unsigned v2u __attribute__((ext_vector_type(2)));
typedef float f32x4 __attribute__((ext_vector_type(4)));
typedef short bf16x8 __attribute__((ext_vector_type(8)));
typedef GAS unsigned gu32;
#define RLX_AGENT __ATOMIC_RELAXED, __HIP_MEMORY_SCOPE_AGENT
#define LDS_WAIT() asm volatile("s_waitcnt lgkmcnt(0)" ::: "memory")

__device__ __forceinline__ unsigned f2bf(float f) { unsigned u = __builtin_bit_cast(unsigned, f); return (u + 0x7fffu + ((u >> 16) & 1u)) >> 16; }
__device__ __forceinline__ unsigned pk2(float lo, float hi) { return f2bf(lo) | (f2bf(hi) << 16); }
__device__ __forceinline__ float bf2f(unsigned short x) { return __builtin_bit_cast(float, (unsigned)x << 16); }
__device__ __forceinline__ float bflo(unsigned w) { return __builtin_bit_cast(float, w << 16); }
__device__ __forceinline__ float bfhi(unsigned w) { return __builtin_bit_cast(float, w & 0xffff0000u); }
__device__ __forceinline__ float sigmoid_f(float x) { return __builtin_amdgcn_rcpf(1.0f + __builtin_amdgcn_exp2f(-1.4426950409f * x)); }
__device__ __forceinline__ float gelu_tanh(float x) { const float z = 1.5957691216f * x * (1.0f + 0.044715f * x * x); return x * sigmoid_f(z); }
__device__ __forceinline__ int opaque_tid() { int t = threadIdx.x; asm volatile("" : "+v"(t)); return t; }
__device__ __forceinline__ float wave_sum(float v) {
#pragma unroll
    for (int o = 1; o < 64; o <<= 1) v += __shfl_xor(v, o);
    return v;
}

namespace pg8 {
#define PG8_LAS __attribute__((address_space(3)))
typedef unsigned short bf16_t;
typedef unsigned u32x4 __attribute__((ext_vector_type(4)));
constexpr int BM = 256, BK = 64, HALF = 128, HTB = HALF * BK * 2, STAGE_BYTES = 8 * HTB, NXCD = 8, WGM = 8;

__host__ __device__ __forceinline__ int lds_byte(int r, int c) { const int st = (r >> 4) * 2 + (c >> 5), rr = r & 15, cc = c & 31, ob = rr * 64 + cc * 2; return st * 1024 + (ob ^ (((ob >> 9) & 1) << 5)); }
__host__ __device__ __forceinline__ void stage_rc(int b, int& R, int& C) { const int st = b / 1024, sb = b % 1024, swz = sb ^ (((sb >> 9) & 1) << 5); R = (st >> 1) * 16 + swz / 64; C = (st & 1) * 32 + (swz % 64) / 2; }
__host__ __device__ __forceinline__ int perm32(int rho) { const int n = rho >> 4, i = rho & 15; return 8 * (i >> 2) + 4 * n + (i & 3); }

struct Unit { int pm, pn, k0, nt, sub, keep; };
struct Gemm { const bf16_t* A; const bf16_t* Bt; int lda, ldb; };

struct Order {
    int nM, nN, nwg, G, c, nsub, ntk;
    __device__ void init(int M_, int N_, int K_, int G_, int c_, int nsub_) { nM = M_ / BM; nN = N_ / BM; nwg = nM * nN; G = G_; c = c_; nsub = nsub_; ntk = K_ / BK; }
    __device__ bool next(int i, Unit& u) const {
        const int ti = i / nsub, sub = i - ti * nsub;
        const long L = (long)ti * G + c; if (L >= nwg) return false;
        int wgid = (int)L; { const int q = nwg / NXCD, r = nwg % NXCD, xcd = wgid % NXCD, off = wgid / NXCD; wgid = (xcd < r ? xcd * (q + 1) : r * (q + 1) + (xcd - r) * q) + off; }
        const int nig = WGM * nN, gid = wgid / nig, fm = gid * WGM, gsz = (nM - fm) < WGM ? (nM - fm) : WGM;
        u.pm = fm + ((wgid % nig) % gsz); u.pn = (wgid % nig) / gsz; u.sub = sub;
        if (nsub == 1) { u.k0 = 0; u.nt = ntk; u.keep = 0; }
        else { u.k0 = sub == 0 ? 0 : (sub == 1 ? 1024 : 1536); u.nt = sub == 0 ? 16 : 8; u.keep = sub < 2 ? 1 : 0; }
        return true;
    }
};

typedef __bf16 bf16x2_t __attribute__((ext_vector_type(2)));
typedef float f32x2_t __attribute__((ext_vector_type(2)));
__device__ __forceinline__ unsigned cvt_pk_bf16(float lo, float hi) { const f32x2_t v = {lo, hi}; const bf16x2_t b = __builtin_convertvector(v, bf16x2_t); return __builtin_bit_cast(unsigned, b); }

typedef f32x4 acc_t[2][2][4][2];

template <int ACT> __device__ __forceinline__ float act_f(float x) {
    if (ACT == 1) return x * 0.08838834764831845f;
    if (ACT == 2) return gelu_tanh(x);
    if (ACT == 3) return sigmoid_f(x);
    if (ACT == 4) { const float r = x > 0.f ? x : 0.f; return r * r; }
    return x;
}
template <int ACT> __device__ __forceinline__ void store_bf16_tile(const acc_t& acc, bf16_t* O, int ldc, int row0, int col0, float* sgv  , int sgcol0) {
#pragma unroll
    for (int ai = 0; ai < 2; ++ai)
#pragma unroll
        for (int m = 0; m < 4; ++m) { const int row = row0 + ai * HALF + m * 16; bf16_t* rowp = O + (size_t)row * ldc + col0;
#pragma unroll
            for (int bj = 0; bj < 2; ++bj) { f32x4 v0 = acc[ai][bj][m][0], v1 = acc[ai][bj][m][1];
#pragma unroll
                for (int j = 0; j < 4; ++j) { v0[j] = act_f<ACT>(v0[j]); v1[j] = act_f<ACT>(v1[j]); }
                u32x4 w; w.x = cvt_pk_bf16(v0[0], v0[1]); w.y = cvt_pk_bf16(v0[2], v0[3]); w.z = cvt_pk_bf16(v1[0], v1[1]); w.w = cvt_pk_bf16(v1[2], v1[3]);
                *(u32x4*)(rowp + bj * HALF) = w;
                if (ACT == 2 && sgv) { float* sp = sgv + (size_t)(row - MP) * 512 + sgcol0 + bj * HALF; *(f32x4*)sp = v0; *(f32x4*)(sp + 4) = v1; }
                if (ACT == 3 && sgv) { float* sp = sgv + (size_t)row * D + sgcol0 + bj * HALF; *(f32x4*)sp = v0; *(f32x4*)(sp + 4) = v1; } } }
}

struct EpiProj {
    static constexpr bool PERM = true;
    bf16_t* O; float* sgv; float* dbg;
    __device__ __forceinline__ void operator()(acc_t& acc, const Unit& u, int wr, int wc, int fr, int fq) const {
        const int row0 = u.pm * BM + wr * 64 + fr, col0 = u.pn * BM + wc * 32 + 8 * fq, pn = u.pn;
        if (pn < 2) store_bf16_tile<1>(acc, O, NPJ, row0, col0, nullptr, 0);
        else if (pn < 14) store_bf16_tile<0>(acc, O, NPJ, row0, col0, nullptr, 0);
        else if (pn < 18) store_bf16_tile<2>(acc, O, NPJ, row0, col0, (pn >= 16 && u.pm >= MP / BM) ? sgv : nullptr, col0 - C_VV);
#ifdef EXP_GATEOUT
        else store_bf16_tile<3>(acc, O, NPJ, row0, col0, (pn >= 26) ? dbg : nullptr, col0 - C_G - 2048);
#else
        else store_bf16_tile<3>(acc, O, NPJ, row0, col0, nullptr, 0);
#endif
    }
};
struct EpiPlain {
    static constexpr bool PERM = true;
    bf16_t* O;
    __device__ __forceinline__ void operator()(acc_t& acc, const Unit& u, int wr, int wc, int fr, int fq) const {
        if (u.keep) return;
        store_bf16_tile<0>(acc, O, D, u.pm * BM + wr * 64 + fr, u.pn * BM + wc * 32 + 8 * fq, nullptr, 0);
    }
};
struct EpiRelu2 {
    static constexpr bool PERM = true;
    bf16_t* O;
    __device__ __forceinline__ void operator()(acc_t& acc, const Unit& u, int wr, int wc, int fr, int fq) const {
        store_bf16_tile<4>(acc, O, FF, u.pm * BM + wr * 64 + fr, u.pn * BM + wc * 32 + 8 * fq, nullptr, 0);
    }
};
struct EpiBranch {
    static constexpr bool PERM = true;
    const bf16_t* P; bf16_t* O;
    __device__ __forceinline__ void operator()(acc_t& acc, const Unit& u, int wr, int wc, int fr, int fq) const {
        const int row0 = u.pm * BM + wr * 64 + fr, col0 = u.pn * BM + wc * 32 + 8 * fq, sub = u.sub;
#pragma unroll
        for (int ai = 0; ai < 2; ++ai)
#pragma unroll
            for (int m = 0; m < 4; ++m) { const int row = row0 + ai * HALF + m * 16; const bf16_t* gp = P + (size_t)row * NPJ + C_G + col0;
#pragma unroll
                for (int bj = 0; bj < 2; ++bj) {
#ifdef EXP_NOLOAD
                    const u32x4 g1 = (u32x4){0x3f003f00u, 0x3f003f00u, 0x3f003f00u, 0x3f003f00u};
#elif defined(EXP_SC1)
                    u32x4 g1; { const unsigned long long* q = (const unsigned long long*)(gp + sub * 1024 + bj * HALF);
                        const unsigned long long q0 = __hip_atomic_load(q, __ATOMIC_RELAXED, __HIP_MEMORY_SCOPE_SYSTEM), q1 = __hip_atomic_load(q + 1, __ATOMIC_RELAXED, __HIP_MEMORY_SCOPE_SYSTEM);
                        g1.x = (unsigned)q0; g1.y = (unsigned)(q0 >> 32); g1.z = (unsigned)q1; g1.w = (unsigned)(q1 >> 32); }
#elif defined(EXP_DEADLOAD)
                    const u32x4 g1_ = *(const u32x4*)(gp + sub * 1024 + bj * HALF);
#else
                    const u32x4 g1 = *(const u32x4*)(gp + sub * 1024 + bj * HALF);
#endif
#ifdef EXP_DEADLOAD
                    u32x4 g1 = g1_; asm volatile("" : "+v"(g1.x), "+v"(g1.y), "+v"(g1.z), "+v"(g1.w)); g1 = (u32x4){0x3f003f00u, 0x3f003f00u, 0x3f003f00u, 0x3f003f00u};
#endif
                    float f[8];
                    f[0] = bflo(g1.x); f[1] = bfhi(g1.x); f[2] = bflo(g1.y); f[3] = bfhi(g1.y); f[4] = bflo(g1.z); f[5] = bfhi(g1.z); f[6] = bflo(g1.w); f[7] = bfhi(g1.w);
#pragma unroll
                    for (int j = 0; j < 8; ++j) f[j] = f[j] > 1e-30f ? f[j] : 1e-30f;
#ifndef EXP_NODIV
                    if (sub < 2) {
                        const u32x4 g2 = *(const u32x4*)(gp + (sub + 1) * 1024 + bj * HALF);
                        float d[8];
                        d[0] = bflo(g2.x); d[1] = bfhi(g2.x); d[2] = bflo(g2.y); d[3] = bfhi(g2.y); d[4] = bflo(g2.z); d[5] = bfhi(g2.z); d[6] = bflo(g2.w); d[7] = bfhi(g2.w);
#pragma unroll
                        for (int j = 0; j < 8; ++j) { d[j] = d[j] > 1e-30f ? d[j] : 1e-30f; f[j] = f[j] / d[j]; }
                    }
#endif
                    f32x4 v0 = acc[ai][bj][m][0], v1 = acc[ai][bj][m][1];
#pragma unroll
                    for (int j = 0; j < 4; ++j) { v0[j] *= f[j]; v1[j] *= f[4 + j]; }
                    acc[ai][bj][m][0] = v0; acc[ai][bj][m][1] = v1;
                    if (sub == 2) { u32x4 w; w.x = cvt_pk_bf16(v0[0], v0[1]); w.y = cvt_pk_bf16(v0[2], v0[3]); w.z = cvt_pk_bf16(v1[0], v1[1]); w.w = cvt_pk_bf16(v1[2], v1[3]);
                        *(u32x4*)(O + (size_t)row * D + col0 + bj * HALF) = w; }
                }
                asm volatile("" ::: "memory"); }
    }
};
struct EpiResid {
    static constexpr bool PERM = false;
    const float* bp; const float* bs; float* out;
    __device__ __forceinline__ void operator()(acc_t& acc, const Unit& u, int wr, int wc, int fr, int fq) const {
        const int row0 = u.pm * BM + wr * 64 + fr, col0 = u.pn * BM + wc * 32 + 4 * fq;
        const bool smp = u.pm >= MP / BM;
#pragma unroll
        for (int ai = 0; ai < 2; ++ai)
#pragma unroll
            for (int m = 0; m < 4; ++m) { const int row = row0 + ai * HALF + m * 16;
                const float* b = smp ? bs + (size_t)(row - MP) * D + col0 : bp + (size_t)row * D + col0; float* o = out + (size_t)row * D + col0;
#pragma unroll
                for (int bj = 0; bj < 2; ++bj)
#pragma unroll
                    for (int n = 0; n < 2; ++n) { const f32x4 bv = *(const f32x4*)(b + bj * HALF + n * 16); *(f32x4*)(o + bj * HALF + n * 16) = bv + acc[ai][bj][m][n]; }
                if (m & 1) asm volatile("" ::: "memory"); }
    }
};

template <class Epi>
__device__ __forceinline__ void gemm_phase(PG8_LAS unsigned char* lds, const Gemm g, const Order& S, const Epi& E) {
    int tid_ = threadIdx.x; asm volatile("" : "+v"(tid_));
    const int tid = tid_, wid = __builtin_amdgcn_readfirstlane(tid >> 6), lane = tid & 63, wr = wid >> 2, wc = wid & 3, fr = lane & 15, fq = lane >> 4;
    unsigned voffA[2], voffB[2];
#pragma unroll
    for (int i = 0; i < 2; ++i) { int R, C; stage_rc(tid * 16 + i * 8192, R, C); const int Rb = Epi::PERM ? ((R & ~31) + perm32(R & 31)) : R;
        voffA[i] = (unsigned)(R * g.lda + C) * 2u; voffB[i] = (unsigned)(Rb * g.ldb + C) * 2u; }
    const size_t kstep = (size_t)(BK * 2);
    const size_t hstepA = (size_t)HALF * g.lda * 2, hstepB = (size_t)HALF * g.ldb * 2;
    const size_t tstepA = 2 * hstepA, tstepB = 2 * hstepB;
    const unsigned ldsw = (unsigned)wid * 1024u;
    const int aoff = lds_byte(wr * 64 + fr, fq * 8), boff = lds_byte(wc * 32 + fr, fq * 8);
#define PG8_SA(b, h) (((b) * 2 + (h)) * HTB)
#define PG8_SB(b, h) ((4 + (b) * 2 + (h)) * HTB)
#define PG8_STAGE(bufoff, gbase, voff) do { _Pragma("unroll") for (int _i = 0; _i < 2; ++_i) \
        __builtin_amdgcn_global_load_lds((const unsigned*)((const char*)(gbase) + (voff)[_i]), (PG8_LAS unsigned*)(lds + (bufoff) + ldsw + _i * 8192), 16, 0, 0); } while (0)
#define PG8_LDA(dst, b, h) do { _Pragma("unroll") for (int m = 0; m < 4; ++m) _Pragma("unroll") for (int k = 0; k < 2; ++k) dst[m][k] = *(const PG8_LAS bf16x8*)(lds + PG8_SA(b, h) + aoff + m * 2048 + k * 1024); } while (0)
#define PG8_LDB(dst, b, h) do { _Pragma("unroll") for (int n = 0; n < 2; ++n) _Pragma("unroll") for (int k = 0; k < 2; ++k) dst[n][k] = *(const PG8_LAS bf16x8*)(lds + PG8_SB(b, h) + boff + n * 2048 + k * 1024); } while (0)
#define PG8_MMA(ai, bj, At, Bt) do { __builtin_amdgcn_s_setprio(1); _Pragma("unroll") for (int m = 0; m < 4; ++m) _Pragma("unroll") for (int n = 0; n < 2; ++n) _Pragma("unroll") for (int k = 0; k < 2; ++k) \
        acc[ai][bj][m][n] = __builtin_amdgcn_mfma_f32_16x16x32_bf16(Bt[n][k], At[m][k], acc[ai][bj][m][n], 0, 0, 0); __builtin_amdgcn_s_setprio(0); } while (0)
#define PG8_WAIT_V(n) asm volatile("s_waitcnt vmcnt(" #n ")" ::: "memory")
#define PG8_WAIT_L(n) asm volatile("s_waitcnt lgkmcnt(" #n ")" ::: "memory")
#define PG8_BAR __builtin_amdgcn_s_barrier()
#define PG8_SCHED __builtin_amdgcn_sched_barrier(0)
    Unit cur, nxt; int ui = 0;
    if (!S.next(0, cur)) return;
    f32x4 acc[2][2][4][2];
#pragma unroll
    for (int a = 0; a < 2; ++a)
#pragma unroll
        for (int b = 0; b < 2; ++b)
#pragma unroll
            for (int m = 0; m < 4; ++m)
#pragma unroll
                for (int n = 0; n < 2; ++n) acc[a][b][m][n] = (f32x4){0.f, 0.f, 0.f, 0.f};
    bf16x8 At[4][2], B0[2][2], B1[2][2];
    const char* cA = (const char*)g.A + (size_t)cur.pm * tstepA + (size_t)cur.k0 * 2; const char* cB = (const char*)g.Bt + (size_t)cur.pn * tstepB + (size_t)cur.k0 * 2;
    PG8_STAGE(PG8_SB(0, 0), cB, voffB); PG8_STAGE(PG8_SB(0, 1), cB + hstepB, voffB); PG8_STAGE(PG8_SA(0, 0), cA, voffA); PG8_STAGE(PG8_SA(0, 1), cA + hstepA, voffA);
    if (wr == 1) PG8_BAR;
    PG8_WAIT_V(2); PG8_BAR;
    PG8_STAGE(PG8_SB(1, 0), cB + kstep, voffB); PG8_STAGE(PG8_SA(1, 0), cA + kstep, voffA); PG8_STAGE(PG8_SB(1, 1), cB + hstepB + kstep, voffB);
    PG8_WAIT_V(6); PG8_BAR;
    for (;;) {
        const bool has_next = S.next(ui + 1, nxt);
        const char* nA = has_next ? (const char*)g.A + (size_t)nxt.pm * tstepA + (size_t)nxt.k0 * 2 : cA; const char* nB = has_next ? (const char*)g.Bt + (size_t)nxt.pn * tstepB + (size_t)nxt.k0 * 2 : cB;
        const int nt = cur.nt;
        for (int t = 0; t < nt; t += 2) {
            const bool last = (t == nt - 2);
            const char* a1 = cA + (size_t)(t + 1) * kstep;
            const char* a2 = last ? nA : cA + (size_t)(t + 2) * kstep; const char* b2 = last ? nB : cB + (size_t)(t + 2) * kstep;
            const char* a3 = a2 + kstep; const char* b3 = b2 + kstep;
            PG8_LDB(B0, 0, 0); PG8_LDB(B1, 0, 1); PG8_SCHED; PG8_LDA(At, 0, 0); PG8_STAGE(PG8_SA(1, 1), a1 + hstepA, voffA);
            PG8_WAIT_V(8); PG8_WAIT_L(0); PG8_BAR; PG8_MMA(0, 0, At, B0); PG8_MMA(0, 1, At, B1); PG8_BAR; PG8_SCHED;
            PG8_LDA(At, 0, 1); PG8_STAGE(PG8_SB(0, 0), b2, voffB); PG8_STAGE(PG8_SB(0, 1), b2 + hstepB, voffB); PG8_STAGE(PG8_SA(0, 0), a2, voffA);
            PG8_WAIT_V(8); PG8_WAIT_L(0); PG8_BAR; PG8_MMA(1, 0, At, B0); PG8_MMA(1, 1, At, B1); PG8_BAR; PG8_SCHED;
            PG8_LDB(B0, 1, 0); PG8_LDB(B1, 1, 1); PG8_SCHED; PG8_LDA(At, 1, 0); PG8_STAGE(PG8_SA(0, 1), a2 + hstepA, voffA);
            PG8_WAIT_V(8); PG8_WAIT_L(0); PG8_BAR; PG8_MMA(0, 0, At, B0); PG8_MMA(0, 1, At, B1); PG8_BAR; PG8_SCHED;
            PG8_LDA(At, 1, 1); PG8_STAGE(PG8_SB(1, 0), b3, voffB); PG8_STAGE(PG8_SB(1, 1), b3 + hstepB, voffB); PG8_STAGE(PG8_SA(1, 0), a3, voffA);
            PG8_WAIT_V(8); PG8_WAIT_L(0); PG8_BAR; PG8_MMA(1, 0, At, B0); PG8_MMA(1, 1, At, B1); PG8_BAR; PG8_SCHED;
        }
        if (wr == 0) PG8_BAR;
        E(acc, cur, wr, wc, fr, fq);
        if (!has_next) break;
        if (!cur.keep) {
#pragma unroll
            for (int a = 0; a < 2; ++a)
#pragma unroll
                for (int b = 0; b < 2; ++b)
#pragma unroll
                    for (int m = 0; m < 4; ++m)
#pragma unroll
                        for (int n = 0; n < 2; ++n) acc[a][b][m][n] = (f32x4){0.f, 0.f, 0.f, 0.f};
        }
        cur = nxt; cA = nA; cB = nB; ++ui;
        if (wr == 1) PG8_BAR;
    }
    PG8_WAIT_V(0);
    PG8_BAR;
#undef PG8_SA
#undef PG8_SB
#undef PG8_STAGE
#undef PG8_LDA
#undef PG8_LDB
#undef PG8_MMA
#undef PG8_WAIT_V
#undef PG8_WAIT_L
#undef PG8_BAR
#undef PG8_SCHED
}
}

#define XB_TMO      128
#define XB_XCNT(j)  (256  + 64 * (j))
#define XB_XSUB(j)  (1280 + 64 * (j))
#define XB_XGEN(j)  (2304 + 64 * (j))
#define XB_TOP      3328
#define XB_TOPGEN   3392
#define XCD_BAR_WORDS 3456
#define XB_SPIN_CAP (1u << 20)

__device__ __forceinline__ unsigned xb_ld(unsigned* p)              { return __hip_atomic_load(p, __ATOMIC_RELAXED, __HIP_MEMORY_SCOPE_AGENT); }
__device__ __forceinline__ unsigned xb_add(unsigned* p, unsigned v) { return __hip_atomic_fetch_add(p, v, __ATOMIC_RELAXED, __HIP_MEMORY_SCOPE_AGENT); }
__device__ __forceinline__ unsigned xb_xcc_id() { return (unsigned)__builtin_amdgcn_s_getreg((3 << 11) | 20) & 0xFu; }
#define XB_SPIN(cond, bar) do { unsigned _sp = 0; while (cond) { __builtin_amdgcn_s_sleep(1); \
    if ((++_sp & 255u) == 0u) { if (xb_ld(&(bar)[XB_TMO])) break; if (_sp > XB_SPIN_CAP) { atomicAdd(&(bar)[XB_TMO], 1u); break; } } } } while (0)

struct XcdBarrier { unsigned* bar; unsigned x; volatile LAS unsigned* st; };

__device__ __forceinline__ XcdBarrier xcd_barrier_post(unsigned* bar, volatile LAS unsigned* st) {
    XcdBarrier b; b.bar = bar; b.x = xb_xcc_id(); b.st = st;
    if (threadIdx.x == 0) (void)xb_add(&bar[XB_XCNT(b.x)], 1u);
    return b;
}
__device__ __forceinline__ void xcd_barrier_complete(unsigned* bar, unsigned x, unsigned& nloc, unsigned& nx) {
    const unsigned G = gridDim.x * gridDim.y * gridDim.z;
    unsigned sum, cnt, mine, sp = 0u;
    for (;;) {
        sum = 0u; cnt = 0u; mine = 0u;
#pragma unroll
        for (unsigned j = 0; j < 16; ++j) { const unsigned c = xb_ld(&bar[XB_XCNT(j)]); sum += c; cnt += (c > 0u) ? 1u : 0u; mine = (j == x) ? c : mine; }
        if (sum == G) break;
        __builtin_amdgcn_s_sleep(1);
        if ((++sp & 255u) == 0u) { if (xb_ld(&bar[XB_TMO])) break; if (sp > XB_SPIN_CAP) { atomicAdd(&bar[XB_TMO], 1u); break; } }
    }
    nloc = mine > 0u ? mine : 1u; nx = cnt > 0u ? cnt : 1u;
}
__device__ __forceinline__ void xcd_barrier(const XcdBarrier& b) {
    asm volatile("s_waitcnt vmcnt(0)" ::: "memory");
    __syncthreads();
    if (threadIdx.x == 0) {
        unsigned* bar = b.bar;
        __builtin_amdgcn_s_waitcnt(0);
        unsigned nloc = b.st[0], nx = b.st[1];
        if (nloc == 0u) { xcd_barrier_complete(bar, b.x, nloc, nx); b.st[0] = nloc; b.st[1] = nx; }
        const unsigned old = xb_add(&bar[XB_XSUB(b.x)], 1u);
        const unsigned gen = old / nloc;
        if (old + 1u == (gen + 1u) * nloc) {
            __builtin_amdgcn_fence(__ATOMIC_RELEASE, "agent");
            asm volatile("s_waitcnt vmcnt(0)" ::: "memory");
            const unsigned og = xb_add(&bar[XB_TOP], 1u);
            const unsigned tg = og / nx;
            if (og + 1u == (tg + 1u) * nx) xb_add(&bar[XB_TOPGEN], 1u);
            else XB_SPIN(xb_ld(&bar[XB_TOPGEN]) == tg, bar);
            __builtin_amdgcn_fence(__ATOMIC_ACQUIRE, "agent");
            xb_add(&bar[XB_XGEN(b.x)], 1u);
            asm volatile("s_waitcnt vmcnt(0)" ::: "memory");
        } else {
            XB_SPIN(xb_ld(&bar[XB_XGEN(b.x)]) == gen, bar);
            __builtin_amdgcn_fence(__ATOMIC_ACQUIRE, "agent");
            asm volatile("s_waitcnt vmcnt(0)" ::: "memory");
        }
    }
    __syncthreads();
}

struct Args {
    const float* in[21];
    float* out; unsigned char* ws;
};

__device__ __forceinline__ void transpose_item(const float* W, int ldw, int ncols, bf16* WT, int ldd, int row_off, int col_off, LAS float* scr, int item, int lane) {
    const int nblk = ncols / 32, kb = item / nblk, nb = item % nblk, k0 = 64 * kb, n0 = 32 * nb;
#pragma unroll 8
    for (int i = 0; i < 32; ++i) { const int kk = 2 * i + (lane >> 5); scr[kk * 33 + (lane & 31)] = W[(size_t)(k0 + kk) * ldw + n0 + (lane & 31)]; }
    LDS_WAIT(); asm volatile("" ::: "memory");
    const int c = lane & 7;
#pragma unroll
    for (int j = 0; j < 4; ++j) { const int n = (lane >> 3) + 8 * j; const LAS float* s = scr + (8 * c) * 33 + n;
        v4u o; o.x = pk2(s[0 * 33], s[1 * 33]); o.y = pk2(s[2 * 33], s[3 * 33]); o.z = pk2(s[4 * 33], s[5 * 33]); o.w = pk2(s[6 * 33], s[7 * 33]);
        *(GAS v4u*)(WT + (size_t)(row_off + n0 + n) * ldd + col_off + k0 + 8 * c) = o; }
    LDS_WAIT(); asm volatile("" ::: "memory");
}

__device__ __forceinline__ void convert_weights(const Args& a, LAS unsigned char* lds, int vcu, int G) {
    const int tid = opaque_tid(), lane = tid & 63, wave = __builtin_amdgcn_readfirstlane(tid >> 6), gw = vcu * NWAVES + wave, NGW = G * NWAVES;
    LAS float* scr = (LAS float*)(lds + wave * 16384);
    constexpr int I_IN1 = 16 * 96, I_IN2 = 16 * 144, I_BA = 16 * 32, I_BB = 8 * 32, I_BC = 8 * 32, I_O = 16 * 32, I_F1 = 16 * 128, I_F2 = 64 * 32;
    constexpr int PER_LAYER = I_IN1 + I_IN2 + I_BA + I_BB + I_BC + I_O + I_F1 + I_F2;
    for (int it = gw; it < 2 * PER_LAYER; it += NGW) {
        const int l = it / PER_LAYER; int r = it - l * PER_LAYER;
        unsigned char* wl = a.ws + WS_W + (size_t)l * W_LAYER;
        const float* w_in = a.in[5] + (size_t)l * D * IN_COLS;
        if (r < I_IN1) { transpose_item(w_in, IN_COLS, 3072, (bf16*)(wl + W_IN), D, 0, 0, scr, r, lane); continue; } r -= I_IN1;
        if (r < I_IN2) { transpose_item(w_in + 3088, IN_COLS, 4608, (bf16*)(wl + W_IN), D, 3072, 0, scr, r, lane); continue; } r -= I_IN2;
        if (r < I_BA) { transpose_item(a.in[13] + (size_t)l * 1024 * 1024, 1024, 1024, (bf16*)(wl + W_BR), 2048, 0, 0, scr, r, lane); continue; } r -= I_BA;
        if (r < I_BB) { transpose_item(a.in[14] + (size_t)l * 512 * 1024, 1024, 1024, (bf16*)(wl + W_BR), 2048, 0, 1024, scr, r, lane); continue; } r -= I_BB;
        if (r < I_BC) { transpose_item(a.in[15] + (size_t)l * 512 * 1024, 1024, 1024, (bf16*)(wl + W_BR), 2048, 0, 1536, scr, r, lane); continue; } r -= I_BC;
        if (r < I_O) { transpose_item(a.in[16] + (size_t)l * 1024 * 1024, 1024, 1024, (bf16*)(wl + W_OUT), 1024, 0, 0, scr, r, lane); continue; } r -= I_O;
        if (r < I_F1) { transpose_item(a.in[18] + (size_t)l * 1024 * FF, FF, FF, (bf16*)(wl + W_FF1), 1024, 0, 0, scr, r, lane); continue; } r -= I_F1;
        transpose_item(a.in[19] + (size_t)l * FF * 1024, 1024, 1024, (bf16*)(wl + W_FF2), FF, 0, 0, scr, r, lane);
    }
}

template <int MODE>
__device__ __forceinline__ void norm_phase(LAS unsigned char* lds, int vcu, int G,
                                           const float* hp, const float* hs, const float* w, bf16* HN, float* GLOG, float* outf,
                                           const float* w_in_l, const float* w_gk2_l, const float* b_gk_l) {
    const int tid = opaque_tid(), lane = tid & 63, wave = __builtin_amdgcn_readfirstlane(tid >> 6), gw = vcu * NWAVES + wave, NGW = G * NWAVES;
    LAS float* Wg = (LAS float*)lds;
    LAS float* Wk = Wg + 16 * 1024;
    if (MODE == 1) {
        for (int idx = tid; idx < 16 * 1024; idx += 512) { const int k = idx >> 4, c = idx & 15; Wg[c * 1024 + k] = w_in_l[(size_t)k * IN_COLS + 3072 + c]; }
        for (int idx = tid; idx < 16 * 512; idx += 512) Wk[idx] = w_gk2_l[idx];
        __syncthreads();
    }
    f32x4 wv[4];
#pragma unroll
    for (int j = 0; j < 4; ++j) wv[j] = *(const f32x4*)(w + 4 * lane + 256 * j);
    for (int m = gw; m < M; m += NGW) {
        const float* xr = (m < MP) ? hp + (size_t)m * D : hs + (size_t)(m - MP) * D;
        f32x4 v[4]; float ss = 0.f;
#pragma unroll
        for (int j = 0; j < 4; ++j) { v[j] = *(const f32x4*)(xr + 4 * lane + 256 * j); ss += (v[j].x * v[j].x + v[j].y * v[j].y) + (v[j].z * v[j].z + v[j].w * v[j].w); }
        const float r = 1.0f / sqrtf(wave_sum(ss) * (1.0f / D) + EPS);
#pragma unroll
        for (int j = 0; j < 4; ++j) v[j] = v[j] * r * wv[j];
        if (MODE == 2) {
#pragma unroll
            for (int j = 0; j < 4; ++j) *(f32x4*)(outf + (size_t)m * D + 4 * lane + 256 * j) = v[j];
        } else {
#pragma unroll
            for (int j = 0; j < 4; ++j) { v2u o; o.x = pk2(v[j].x, v[j].y); o.y = pk2(v[j].z, v[j].w); *(v2u*)(HN + (size_t)m * D + 4 * lane + 256 * j) = o; }
        }
        if (MODE == 1) {
            float gl[16];
#pragma unroll
            for (int c = 0; c < 16; ++c) { float p = 0.f;
#pragma unroll
                for (int j = 0; j < 4; ++j) { const f32x4 wg = *(const LAS f32x4*)(Wg + c * 1024 + 4 * lane + 256 * j); p += (v[j].x * wg.x + v[j].y * wg.y) + (v[j].z * wg.z + v[j].w * wg.w); }
                gl[c] = wave_sum(p); if ((c & 3) == 3) asm volatile("" ::: "memory"); }
#pragma unroll
            for (int hb = 0; hb < 2; ++hb) { const int d0 = 4 * lane + 256 * hb;
                f32x4 acc = *(const f32x4*)(b_gk_l + d0);
#pragma unroll
                for (int c = 0; c < 16; ++c) { const f32x4 wk = *(const LAS f32x4*)(Wk + c * 512 + d0); acc = acc + wk * gl[c]; }
                f32x4 o;
#pragma unroll
                for (int i = 0; i < 4; ++i) { const float x = acc[i]; const float ls = (x < 0.f ? x : 0.f) - log1pf(__expf(-fabsf(x))); o[i] = ls * (1.0f / 16.0f); }
                *(f32x4*)(GLOG + (size_t)m * 512 + d0) = o; }
        }
    }
    if (MODE == 1) __syncthreads();
}

__device__ __forceinline__ void gla_seq(LAS unsigned char* lds, const bf16* PROJ, const float* GLOG, bf16* MIXOUT, const float* gn,
                                        int row0, int T, int h, const float* S0, float* Sout) {
    const int tid = opaque_tid(), lane = tid & 63, wave = __builtin_amdgcn_readfirstlane(tid >> 6);
    LAS float* qs = (LAS float*)lds;
    LAS float* ks = qs + 16 * 128;
    LAS float* as = ks + 16 * 128;
    LAS float* op = as + 16 * 128;
    const int e = tid & 255, dh = __builtin_amdgcn_readfirstlane(tid >> 8);
    float S[64];
#pragma unroll
    for (int i = 0; i < 64; ++i) S[i] = S0 ? S0[(size_t)(dh * 64 + i) * 256 + e] : 0.f;
    const int TB = T < 16 ? T : 16;
    for (int t0 = 0; t0 < T; t0 += TB) {
        __syncthreads();
        for (int idx = tid; idx < TB * 128; idx += 512) { const int t = idx >> 7, d = idx & 127; const size_t row = (size_t)(row0 + t0 + t);
            qs[idx] = bf2f(PROJ[row * NPJ + C_Q + h * 128 + d]); ks[idx] = bf2f(PROJ[row * NPJ + C_K + h * 128 + d]); as[idx] = __expf(GLOG[row * 512 + h * 128 + d]); }
        __syncthreads();
        for (int t = 0; t < TB; ++t) {
            const float v = bf2f(PROJ[(size_t)(row0 + t0 + t) * NPJ + C_V + h * 256 + e]);
            const LAS float* qp = qs + t * 128 + dh * 64; const LAS float* kp = ks + t * 128 + dh * 64; const LAS float* ap = as + t * 128 + dh * 64;
            float o = 0.f;
#pragma unroll
            for (int i4 = 0; i4 < 16; ++i4) { const f32x4 q4 = *(const LAS f32x4*)(qp + 4 * i4), k4 = *(const LAS f32x4*)(kp + 4 * i4), a4 = *(const LAS f32x4*)(ap + 4 * i4);
#pragma unroll
                for (int j = 0; j < 4; ++j) { const int i = 4 * i4 + j; S[i] = a4[j] * S[i] + k4[j] * v; o += q4[j] * S[i]; } }
            op[(t * 2 + dh) * 256 + e] = o;
        }
        __syncthreads();
#pragma unroll
        for (int tt = 0; tt < 2; ++tt) { const int t = wave * 2 + tt;
            if (t < TB) { const int e4 = lane * 4; const size_t row = (size_t)(row0 + t0 + t);
                const f32x4 o = *(const LAS f32x4*)(op + (t * 2) * 256 + e4) + *(const LAS f32x4*)(op + (t * 2 + 1) * 256 + e4);
                const float ss = wave_sum((o.x * o.x + o.y * o.y) + (o.z * o.z + o.w * o.w));
                const float r = 1.0f / sqrtf(ss * (1.0f / 256.0f) + EPS);
                const v2u gw2 = *(const v2u*)(PROJ + row * NPJ + C_GO + h * 256 + e4);
                const f32x4 g4 = *(const f32x4*)(gn + e4);
                const float g0 = bflo(gw2.x), g1 = bfhi(gw2.x), g2 = bflo(gw2.y), g3 = bfhi(gw2.y);
                v2u ow; ow.x = pk2(o.x * r * g4.x * (g0 * sigmoid_f(g0)), o.y * r * g4.y * (g1 * sigmoid_f(g1))); ow.y = pk2(o.z * r * g4.z * (g2 * sigmoid_f(g2)), o.w * r * g4.w * (g3 * sigmoid_f(g3)));
                *(v2u*)(MIXOUT + row * MIXW + h * 256 + e4) = ow; } }
    }
#pragma unroll
    for (int i = 0; i < 64; ++i) Sout[(size_t)(dh * 64 + i) * 256 + e] = S[i];
    __syncthreads();
}

__device__ __forceinline__ void pool_item(LAS unsigned char* lds, const bf16* PROJ, bf16* MIXOUT, const float* wmix, const float* scale, const float* hist  ,
                                          int rowseq0, int tpos0, int nt, int g) {
    const int tid = opaque_tid();
    LAS float* pl = (LAS float*)lds;
    const int w = 2 << g;
    for (int idx = tid; idx < nt * 128; idx += 512) { const int t = idx >> 7, c = idx & 127, pos = tpos0 + t, col = C_XP + g * 128 + c;
        float sum = 0.f;
        for (int i = 0; i < w; ++i) { const int p = pos - i;
            if (p >= 0) sum += bf2f(PROJ[(size_t)(rowseq0 + p) * NPJ + col]);
            else if (hist) sum += hist[(size_t)(15 + p) * 512 + g * 128 + c]; }
        const int cnt = hist ? w : (w < pos + 1 ? w : pos + 1);
        pl[idx] = sum / (float)cnt - bf2f(PROJ[(size_t)(rowseq0 + pos) * NPJ + col]); }
    __syncthreads();
    const int j = tid & 127, tq = __builtin_amdgcn_readfirstlane(tid >> 7), tpq = nt >> 2;
    float acc[4] = {0.f, 0.f, 0.f, 0.f};
    for (int c = 0; c < 128; ++c) { const float wv = wmix[(size_t)(g * 128 + c) * 128 + j];
#pragma unroll
        for (int i = 0; i < 4; ++i) if (i < tpq) acc[i] += pl[(tq * tpq + i) * 128 + c] * wv; }
    const float sc = scale[g * 128 + j];
#pragma unroll
    for (int i = 0; i < 4; ++i) if (i < tpq) MIXOUT[(size_t)(rowseq0 + tpos0 + tq * tpq + i) * MIXW + 1024 + g * 128 + j] = (bf16)f2bf(acc[i] * sc);
    __syncthreads();
}

__device__ __forceinline__ void sg_item(LAS unsigned char* lds, const bf16* PROJ, bf16* MIXOUT, const float* ws, const float* bs, int row0, int L, int g) {
    const int tid = opaque_tid();
    LAS float* vt = (LAS float*)lds;
    LAS float* wt = vt + 128 * 128;
    for (int idx = tid; idx < L * 128; idx += 512) { const int s = idx >> 7, d = idx & 127;
        vt[idx] = bf2f(PROJ[(size_t)(row0 + s) * NPJ + C_VV + g * 128 + d]);
        wt[idx] = ws[(size_t)(g * 128 + s) * 128 + d]; }
    __syncthreads();
    const int d = tid & 127, tq = __builtin_amdgcn_readfirstlane(tid >> 7);
    for (int t = tq; t < L; t += 4) { float acc = 0.f;
        for (int s = 0; s <= t; ++s) acc += wt[t * 128 + s] * vt[s * 128 + d];
        const float u = bf2f(PROJ[(size_t)(row0 + t) * NPJ + C_U + g * 128 + d]);
        MIXOUT[(size_t)(row0 + t) * MIXW + 1536 + g * 128 + d] = (bf16)f2bf(u * (acc + bs[g * 128 + t])); }
    __syncthreads();
}


#ifndef PH
#define PH 0xFFFF
#endif
__global__ void __launch_bounds__(NWAVES * 64, 2) hybrid_fwd(Args args) {
    extern __shared__ __attribute__((aligned(16))) unsigned char lds_raw[];
    LAS unsigned char* lds = (LAS unsigned char*)lds_raw;
    volatile LAS unsigned* MISC = (volatile LAS unsigned*)(lds + MISC_OFF);
    const int G = gridDim.x, bx = blockIdx.x, vcu = (G % 8 == 0) ? (bx % 8) * (G / 8) + bx / 8 : bx;
    unsigned char* ws = args.ws;
    gu32* ctl = (gu32*)(ws + WS_CTL);
    for (int u = threadIdx.x; u < (LDS_BYTES - LDSCTL_OFF) / 4; u += NWAVES * 64) ((LAS unsigned*)(lds + LDSCTL_OFF))[u] = 0u;
    __syncthreads();
    XcdBarrier bar = xcd_barrier_post((unsigned*)(ctl + CW_BAR), MISC + 8);
#ifdef USE_CG
#define GRID_BAR() cooperative_groups::this_grid().sync()
#else
#define GRID_BAR() xcd_barrier(bar)
#endif

    bf16* HN = (bf16*)(ws + WS_HN);
    float* GLOG = (float*)(ws + WS_GLOG);
    bf16* MIX = (bf16*)(ws + WS_MIX);
    bf16* PROJ = (bf16*)(ws + WS_PROJ);
    bf16* FFH = (bf16*)(ws + WS_PROJ);
    float* H = args.out + O_Y;
    const float* xp_in = args.in[0]; const float* xs_in = args.in[1];

#if PH & 1
    convert_weights(args, lds, vcu, G);
    __syncthreads();
#endif
#if PH & 2
    norm_phase<1>(lds, vcu, G, xp_in, xs_in, args.in[4], HN, GLOG, nullptr, args.in[5], args.in[6], args.in[7]);
#endif
    GRID_BAR();

#ifdef EXP_ONELAYER
    for (int l = 0; l < 1; ++l) {
#else
    for (int l = 0; l < DEPTH; ++l) {
#endif
        unsigned char* wl = ws + WS_W + (size_t)l * W_LAYER;
#if PH & 4
        if (l > 0) {
            norm_phase<1>(lds, vcu, G, H, H + (size_t)MP * D, args.in[4] + l * D, HN, GLOG, nullptr, args.in[5] + (size_t)l * D * IN_COLS, args.in[6] + l * 16 * 512, args.in[7] + l * 512);
            GRID_BAR();
        }
#endif
#if PH & 8
        {
            pg8::Gemm g{HN, (const bf16*)(wl + W_IN), D, D}; pg8::Order S; S.init(M, NPJ, D, G, bx, 1);
            pg8::EpiProj E{PROJ, args.out + O_SGV + (size_t)l * MS * 512, H};
            pg8::gemm_phase<pg8::EpiProj>(lds, g, S, E);
        }
#endif
        GRID_BAR();
        {
            const float* gn = args.in[8] + l * 256;
            if (vcu < 32) {
#if PH & 16
                const int n = vcu >> 2, h = vcu & 3;
                gla_seq(lds, PROJ, GLOG, MIX, gn, n * SEQ, SEQ, h, nullptr, args.out + O_GLAP + ((size_t)(l * NB + n) * 4 + h) * 128 * 256);
#endif
            } else {
#if PH & 32
                const float* wmix = args.in[9] + (size_t)l * 4 * 128 * 128; const float* pscale = args.in[10] + l * 512;
                const float* wsp = args.in[11] + (size_t)l * 4 * 128 * 128; const float* bsp = args.in[12] + l * 4 * 128;
                const float* spool = args.in[3] + (size_t)l * SB * 15 * 512;
                constexpr int I_GS = 512, I_PP = 4096, I_PS = 512, I_SP = 512, I_SS = 512, I_ST = 136;
                constexpr int NL = I_GS + I_PP + I_PS + I_SP + I_SS + I_ST;
                for (int it = vcu - 32; it < NL; it += G - 32) {
                    int r = it;
#ifdef EXP_MIXMASK
                    { const int kind = r < I_GS ? 0 : r < I_GS + I_PP ? 1 : r < I_GS + I_PP + I_PS ? 2 : r < I_GS + I_PP + I_PS + I_SP ? 3 : r < I_GS + I_PP + I_PS + I_SP + I_SS ? 4 : 5;
                      if (!((EXP_MIXMASK >> kind) & 1)) continue; }
#endif
                    if (r < I_GS) { const int n = r >> 2, h = r & 3; const size_t so = ((size_t)(l * SB + n) * 4 + h) * 128 * 256;
                        gla_seq(lds, PROJ, GLOG, MIX, gn, MP + n * ST, ST, h, args.in[2] + so, args.out + O_GLAS + so); continue; } r -= I_GS;
                    if (r < I_PP) { const int g = r & 3, tile = r >> 2, n = tile >> 7, tt = tile & 127;
                        pool_item(lds, PROJ, MIX, wmix, pscale, nullptr, n * SEQ, tt * 16, 16, g); continue; } r -= I_PP;
                    if (r < I_PS) { const int g = r & 3, n = r >> 2;
                        pool_item(lds, PROJ, MIX, wmix, pscale, spool + (size_t)n * 15 * 512, MP + n * ST, 0, ST, g); continue; } r -= I_PS;
                    if (r < I_SP) { const int g = r & 3, ch = r >> 2; sg_item(lds, PROJ, MIX, wsp, bsp, ch * 128, 128, g); continue; } r -= I_SP;
                    if (r < I_SS) { const int g = r & 3, n = r >> 2; sg_item(lds, PROJ, MIX, wsp, bsp, MP + n * ST, ST, g); continue; } r -= I_SS;
                    const int tid = opaque_tid();
                    if (r < NB) { const int n = r; float* o = args.out + O_POOLP + (size_t)(l * NB + n) * 15 * 512;
                        for (int idx = tid; idx < 15 * 512; idx += 512) { const int i = idx >> 9, c = idx & 511; o[idx] = bf2f(PROJ[(size_t)(n * SEQ + SEQ - 15 + i) * NPJ + C_XP + c]); } }
                    else { const int n = r - NB; float* o = args.out + O_POOLS + (size_t)(l * SB + n) * 15 * 512; const float* hs = spool + (size_t)n * 15 * 512;
                        for (int idx = tid; idx < 15 * 512; idx += 512) { const int i = idx >> 9, c = idx & 511; o[idx] = i < 7 ? hs[(size_t)(8 + i) * 512 + c] : bf2f(PROJ[(size_t)(MP + n * ST + i - 7) * NPJ + C_XP + c]); } }
                }
#endif
            }
        }
        GRID_BAR();
#ifdef EXP_COPYGATES
        {   const int tid = opaque_tid();
            for (int row = vcu; row < M; row += G) for (int c = tid; c < 1024; c += 512) H[(size_t)row * D + c] = bf2f(PROJ[(size_t)row * NPJ + C_G + c]);
        }
        GRID_BAR();
#endif
#if PH & 64
        {
#ifdef EXP_PLAIN_BRANCH
            pg8::Gemm g{MIX, (const bf16*)(wl + W_BR), MIXW, MIXW}; pg8::Order S; S.init(M, D, MIXW, G, bx, 3);
            pg8::EpiPlain E{HN};
            pg8::gemm_phase<pg8::EpiPlain>(lds, g, S, E);
#else
            pg8::Gemm g{MIX, (const bf16*)(wl + W_BR), MIXW, MIXW}; pg8::Order S; S.init(M, D, MIXW, G, bx, 3);
            pg8::EpiBranch E{PROJ, HN};
            pg8::gemm_phase<pg8::EpiBranch>(lds, g, S, E);
#endif
        }
#endif
        GRID_BAR();
#if PH & 128
        {
            pg8::Gemm g{HN, (const bf16*)(wl + W_OUT), D, D}; pg8::Order S; S.init(M, D, D, G, bx, 1);
            pg8::EpiResid E{l == 0 ? xp_in : H, l == 0 ? xs_in : H + (size_t)MP * D, H};
            pg8::gemm_phase<pg8::EpiResid>(lds, g, S, E);
        }
#endif
        GRID_BAR();
#if PH & 256
        norm_phase<0>(lds, vcu, G, H, H + (size_t)MP * D, args.in[17] + l * D, HN, nullptr, nullptr, nullptr, nullptr, nullptr);
#endif
        GRID_BAR();
#if PH & 512
        {
            pg8::Gemm g{HN, (const bf16*)(wl + W_FF1), D, D}; pg8::Order S; S.init(M, FF, D, G, bx, 1);
            pg8::EpiRelu2 E{FFH};
            pg8::gemm_phase<pg8::EpiRelu2>(lds, g, S, E);
        }
#endif
        GRID_BAR();
#if PH & 1024
        {
            pg8::Gemm g{FFH, (const bf16*)(wl + W_FF2), FF, FF}; pg8::Order S; S.init(M, D, FF, G, bx, 1);
            pg8::EpiResid E{H, H + (size_t)MP * D, H};
            pg8::gemm_phase<pg8::EpiResid>(lds, g, S, E);
        }
#endif
        GRID_BAR();
    }
#if PH & 2048
    norm_phase<2>(lds, vcu, G, H, H + (size_t)MP * D, args.in[20], nullptr, nullptr, H, nullptr, nullptr, nullptr);
#endif
}

extern "C" void kernel_launch(void* const* d_in, const int* in_sizes, int n_in, void* d_out, int out_size, void* d_ws, size_t ws_size, hipStream_t stream) {
    static int grid = 0;
    if (grid == 0) {
        if (n_in != 21 || in_sizes[0] != MP * D || (size_t)out_size != O_END || ws_size < WS_END) {
            fprintf(stderr, "kernel_launch: unexpected shapes: n_in %d in0 %d out %d ws %zu (need %zu)\n", n_in, n_in > 0 ? in_sizes[0] : -1, out_size, ws_size, (size_t)WS_END); grid = -1; return; }
        int dev = 0, cus = 0, per_cu = 0;
        if (hipGetDevice(&dev) != hipSuccess || hipDeviceGetAttribute(&cus, hipDeviceAttributeMultiprocessorCount, dev) != hipSuccess) { grid = -1; return; }
        if (hipFuncSetAttribute((const void*)hybrid_fwd, hipFuncAttributeMaxDynamicSharedMemorySize, LDS_BYTES) != hipSuccess) { fprintf(stderr, "kernel_launch: hipFuncSetAttribute failed\n"); grid = -1; return; }
        if (hipOccupancyMaxActiveBlocksPerMultiprocessor(&per_cu, (const void*)hybrid_fwd, NWAVES * 64, LDS_BYTES) != hipSuccess || per_cu < 1) {
            fprintf(stderr, "kernel_launch: occupancy query reports %d blocks per CU\n", per_cu); (void)hipGetLastError(); grid = -1; return; }
        grid = cus;
    }
    if (grid < 0) return;
    if (hipMemsetAsync((char*)d_ws + WS_CTL, 0, CTL_ZERO_BYTES, stream) != hipSuccess) { fprintf(stderr, "kernel_launch: memset failed\n"); return; }
    Args a{};
    for (int i = 0; i < 21; ++i) a.in[i] = (const float*)d_in[i];
    a.out = (float*)d_out; a.ws = (unsigned char*)d_ws;
    void* kargs[] = {&a};
    hipError_t e = hipLaunchCooperativeKernel((const void*)hybrid_fwd, dim3(grid), dim3(NWAVES * 64), kargs, LDS_BYTES, stream);
    if (e != hipSuccess) fprintf(stderr, "kernel_launch: cooperative launch failed: %s (grid %d)\n", hipGetErrorString(e), grid);
}
```

```cpp
#include <hip/hip_runtime.h>
#include <hip/hip_cooperative_groups.h>
#include <cstdio>
#include <cstdint>

constexpr int D = 1024, NB = 8, SEQ = 2048, DEPTH = 2, SB = 128, ST = 8;
constexpr int MP = NB * SEQ;
constexpr int MS = SB * ST;
constexpr int M = MP + MS;
constexpr int IN_COLS = 7696;
constexpr int NPJ = 7680;
constexpr int FF = 4096;
constexpr float EPS = 1e-6f;
constexpr int C_Q = 0, C_K = 512, C_V = 1024, C_GO = 2048, C_XP = 3072, C_U = 3584, C_VV = 4096, C_G = 4608;
constexpr int MIXW = 2048;

constexpr size_t MiB = 1u << 20;
constexpr size_t WS_CTL = 0, CTL_ZERO_BYTES = 1 * MiB;
constexpr size_t WS_W = 2 * MiB;
constexpr size_t W_LAYER = 37 * MiB, W_IN = 0, W_BR = 15 * MiB, W_OUT = 19 * MiB, W_FF1 = 21 * MiB, W_FF2 = 29 * MiB;
constexpr size_t WS_HN = 76 * MiB;
constexpr size_t WS_GLOG = 110 * MiB;
constexpr size_t WS_MIX = 144 * MiB;
constexpr size_t WS_PROJ = 212 * MiB;
constexpr size_t WS_END = 468 * MiB;
static_assert(WS_PROJ + (size_t)M * NPJ * 2 <= WS_END, "ws map");
static_assert(WS_MIX + (size_t)M * MIXW * 2 <= WS_PROJ, "ws map");
static_assert(WS_GLOG + (size_t)M * 512 * 4 <= WS_MIX, "ws map");
static_assert(WS_HN + (size_t)M * D * 2 <= WS_GLOG, "ws map");
static_assert(WS_W + 2 * W_LAYER <= WS_HN, "ws map");
constexpr int CW_BAR = 4096;

constexpr size_t O_Y = 0;
constexpr size_t O_GLAP = (size_t)M * D;
constexpr size_t O_GLAS = O_GLAP + (size_t)DEPTH * NB * 4 * 128 * 256;
constexpr size_t O_POOLP = O_GLAS + (size_t)DEPTH * SB * 4 * 128 * 256;
constexpr size_t O_POOLS = O_POOLP + (size_t)DEPTH * NB * 15 * 512;
constexpr size_t O_SGV = O_POOLS + (size_t)DEPTH * SB * 15 * 512;
constexpr size_t O_END = O_SGV + (size_t)DEPTH * SB * ST * 512;
static_assert(O_END == 56614912, "output size");

constexpr int RING_BYTES = 131072;
constexpr int LDSCTL_OFF = RING_BYTES, MISC_OFF = LDSCTL_OFF + 320;
constexpr int LDS_BYTES = 147456;
constexpr int NWAVES = 8;

#define GAS __attribute__((address_space(1)))
#define LAS __attribute__((address_space(3)))
typedef unsigned short bf16;
typedef unsigned v4u __attribute__((ext_vector_type(4)));
typedef unsigned v2u __attribute__((ext_vector_type(2)));
typedef float f32x4 __attribute__((ext_vector_type(4)));
typedef short bf16x8 __attribute__((ext_vector_type(8)));
typedef GAS unsigned gu32;
#define RLX_AGENT __ATOMIC_RELAXED, __HIP_MEMORY_SCOPE_AGENT
#define LDS_WAIT() asm volatile("s_waitcnt lgkmcnt(0)" ::: "memory")

__device__ __forceinline__ unsigned f2bf(float f) { unsigned u = __builtin_bit_cast(unsigned, f); return (u + 0x7fffu + ((u >> 16) & 1u)) >> 16; }
__device__ __forceinline__ unsigned pk2(float lo, float hi) { return f2bf(lo) | (f2bf(hi) << 16); }
__device__ __forceinline__ float bf2f(unsigned short x) { return __builtin_bit_cast(float, (unsigned)x << 16); }
__device__ __forceinline__ float bflo(unsigned w) { return __builtin_bit_cast(float, w << 16); }
__device__ __forceinline__ float bfhi(unsigned w) { return __builtin_bit_cast(float, w & 0xffff0000u); }
__device__ __forceinline__ float sigmoid_f(float x) { return __builtin_amdgcn_rcpf(1.0f + __builtin_amdgcn_exp2f(-1.4426950409f * x)); }
__device__ __forceinline__ float gelu_tanh(float x) { const float z = 1.5957691216f * x * (1.0f + 0.044715f * x * x); return x * sigmoid_f(z); }
__device__ __forceinline__ int opaque_tid() { int t = threadIdx.x; asm volatile("" : "+v"(t)); return t; }
__device__ __forceinline__ float wave_sum(float v) {
#pragma unroll
    for (int o = 1; o < 64; o <<= 1) v += __shfl_xor(v, o);
    return v;
}

namespace pg8 {
#define PG8_LAS __attribute__((address_space(3)))
typedef unsigned short bf16_t;
typedef unsigned u32x4 __attribute__((ext_vector_type(4)));
constexpr int BM = 256, BK = 64, HALF = 128, HTB = HALF * BK * 2, STAGE_BYTES = 8 * HTB, NXCD = 8, WGM = 8;

__host__ __device__ __forceinline__ int lds_byte(int r, int c) { const int st = (r >> 4) * 2 + (c >> 5), rr = r & 15, cc = c & 31, ob = rr * 64 + cc * 2; return st * 1024 + (ob ^ (((ob >> 9) & 1) << 5)); }
__host__ __device__ __forceinline__ void stage_rc(int b, int& R, int& C) { const int st = b / 1024, sb = b % 1024, swz = sb ^ (((sb >> 9) & 1) << 5); R = (st >> 1) * 16 + swz / 64; C = (st & 1) * 32 + (swz % 64) / 2; }
__host__ __device__ __forceinline__ int perm32(int rho) { const int n = rho >> 4, i = rho & 15; return 8 * (i >> 2) + 4 * n + (i & 3); }

struct Unit { int pm, pn, k0, nt, sub, keep; };
struct Gemm { const bf16_t* A; const bf16_t* Bt; int lda, ldb; };

struct Order {
    int nM, nN, nwg, G, c, nsub, ntk;
    __device__ void init(int M_, int N_, int K_, int G_, int c_, int nsub_) { nM = M_ / BM; nN = N_ / BM; nwg = nM * nN; G = G_; c = c_; nsub = nsub_; ntk = K_ / BK; }
    __device__ bool next(int i, Unit& u) const {
        const int ti = i / nsub, sub = i - ti * nsub;
        const long L = (long)ti * G + c; if (L >= nwg) return false;
        int wgid = (int)L; { const int q = nwg / NXCD, r = nwg % NXCD, xcd = wgid % NXCD, off = wgid / NXCD; wgid = (xcd < r ? xcd * (q + 1) : r * (q + 1) + (xcd - r) * q) + off; }
        const int nig = WGM * nN, gid = wgid / nig, fm = gid * WGM, gsz = (nM - fm) < WGM ? (nM - fm) : WGM;
        u.pm = fm + ((wgid % nig) % gsz); u.pn = (wgid % nig) / gsz; u.sub = sub;
        if (nsub == 1) { u.k0 = 0; u.nt = ntk; u.keep = 0; }
        else { u.k0 = sub == 0 ? 0 : (sub == 1 ? 1024 : 1536); u.nt = sub == 0 ? 16 : 8; u.keep = sub < 2 ? 1 : 0; }
        return true;
    }
};

typedef __bf16 bf16x2_t __attribute__((ext_vector_type(2)));
typedef float f32x2_t __attribute__((ext_vector_type(2)));
__device__ __forceinline__ unsigned cvt_pk_bf16(float lo, float hi) { const f32x2_t v = {lo, hi}; const bf16x2_t b = __builtin_convertvector(v, bf16x2_t); return __builtin_bit_cast(unsigned, b); }

typedef f32x4 acc_t[2][2][4][2];

template <int ACT> __device__ __forceinline__ float act_f(float x) {
    if (ACT == 1) return x * 0.08838834764831845f;
    if (ACT == 2) return gelu_tanh(x);
    if (ACT == 3) return sigmoid_f(x);
    if (ACT == 4) { const float r = x > 0.f ? x : 0.f; return r * r; }
    return x;
}
template <int ACT> __device__ __forceinline__ void store_bf16_tile(const acc_t& acc, bf16_t* O, int ldc, int row0, int col0, float* sgv  , int sgcol0) {
#pragma unroll
    for (int ai = 0; ai < 2; ++ai)
#pragma unroll
        for (int m = 0; m < 4; ++m) { const int row = row0 + ai * HALF + m * 16; bf16_t* rowp = O + (size_t)row * ldc + col0;
#pragma unroll
            for (int bj = 0; bj < 2; ++bj) { f32x4 v0 = acc[ai][bj][m][0], v1 = acc[ai][bj][m][1];
#pragma unroll
                for (int j = 0; j < 4; ++j) { v0[j] = act_f<ACT>(v0[j]); v1[j] = act_f<ACT>(v1[j]); }
                u32x4 w; w.x = cvt_pk_bf16(v0[0], v0[1]); w.y = cvt_pk_bf16(v0[2], v0[3]); w.z = cvt_pk_bf16(v1[0], v1[1]); w.w = cvt_pk_bf16(v1[2], v1[3]);
                *(u32x4*)(rowp + bj * HALF) = w;
                if (ACT == 2 && sgv) { float* sp = sgv + (size_t)(row - MP) * 512 + sgcol0 + bj * HALF; *(f32x4*)sp = v0; *(f32x4*)(sp + 4) = v1; }
                if (ACT == 3 && sgv) { float* sp = sgv + (size_t)row * D + sgcol0 + bj * HALF; *(f32x4*)sp = v0; *(f32x4*)(sp + 4) = v1; } } }
}

struct EpiProj {
    static constexpr bool PERM = true;
    bf16_t* O; float* sgv; float* dbg;
    __device__ __forceinline__ void operator()(acc_t& acc, const Unit& u, int wr, int wc, int fr, int fq) const {
        const int row0 = u.pm * BM + wr * 64 + fr, col0 = u.pn * BM + wc * 32 + 8 * fq, pn = u.pn;
        if (pn < 2) store_bf16_tile<1>(acc, O, NPJ, row0, col0, nullptr, 0);
        else if (pn < 14) store_bf16_tile<0>(acc, O, NPJ, row0, col0, nullptr, 0);
        else if (pn < 18) store_bf16_tile<2>(acc, O, NPJ, row0, col0, (pn >= 16 && u.pm >= MP / BM) ? sgv : nullptr, col0 - C_VV);
#ifdef EXP_GATEOUT
        else store_bf16_tile<3>(acc, O, NPJ, row0, col0, (pn >= 26) ? dbg : nullptr, col0 - C_G - 2048);
#else
        else store_bf16_tile<3>(acc, O, NPJ, row0, col0, nullptr, 0);
#endif
    }
};
struct EpiPlain {
    static constexpr bool PERM = true;
    bf16_t* O;
    __device__ __forceinline__ void operator()(acc_t& acc, const Unit& u, int wr, int wc, int fr, int fq) const {
        if (u.keep) return;
        store_bf16_tile<0>(acc, O, D, u.pm * BM + wr * 64 + fr, u.pn * BM + wc * 32 + 8 * fq, nullptr, 0);
    }
};
struct EpiRelu2 {
    static constexpr bool PERM = true;
    bf16_t* O;
    __device__ __forceinline__ void operator()(acc_t& acc, const Unit& u, int wr, int wc, int fr, int fq) const {
        store_bf16_tile<4>(acc, O, FF, u.pm * BM + wr * 64 + fr, u.pn * BM + wc * 32 + 8 * fq, nullptr, 0);
    }
};
struct EpiBranch {
    static constexpr bool PERM = true;
    const bf16_t* P; bf16_t* O;
    __device__ __forceinline__ void operator()(acc_t& acc, const Unit& u, int wr, int wc, int fr, int fq) const {
        const int row0 = u.pm * BM + wr * 64 + fr, col0 = u.pn * BM + wc * 32 + 8 * fq, sub = u.sub;
#pragma unroll
        for (int ai = 0; ai < 2; ++ai)
#pragma unroll
            for (int m = 0; m < 4; ++m) { const int row = row0 + ai * HALF + m * 16; const bf16_t* gp = P + (size_t)row * NPJ + C_G + col0;
#pragma unroll
                for (int bj = 0; bj < 2; ++bj) {
#ifdef EXP_NOLOAD
                    const u32x4 g1 = (u32x4){0x3f003f00u, 0x3f003f00u, 0x3f003f00u, 0x3f003f00u};
#elif defined(EXP_SC1)
                    u32x4 g1; { const unsigned long long* q = (const unsigned long long*)(gp + sub * 1024 + bj * HALF);
                        const unsigned long long q0 = __hip_atomic_load(q, __ATOMIC_RELAXED, __HIP_MEMORY_SCOPE_SYSTEM), q1 = __hip_atomic_load(q + 1, __ATOMIC_RELAXED, __HIP_MEMORY_SCOPE_SYSTEM);
                        g1.x = (unsigned)q0; g1.y = (unsigned)(q0 >> 32); g1.z = (unsigned)q1; g1.w = (unsigned)(q1 >> 32); }
#elif defined(EXP_DEADLOAD)
                    const u32x4 g1_ = *(const u32x4*)(gp + sub * 1024 + bj * HALF);
#else
                    const u32x4 g1 = *(const u32x4*)(gp + sub * 1024 + bj * HALF);
#endif
#ifdef EXP_DEADLOAD
                    u32x4 g1 = g1_; asm volatile("" : "+v"(g1.x), "+v"(g1.y), "+v"(g1.z), "+v"(g1.w)); g1 = (u32x4){0x3f003f00u, 0x3f003f00u, 0x3f003f00u, 0x3f003f00u};
#endif
                    float f[8];
                    f[0] = bflo(g1.x); f[1] = bfhi(g1.x); f[2] = bflo(g1.y); f[3] = bfhi(g1.y); f[4] = bflo(g1.z); f[5] = bfhi(g1.z); f[6] = bflo(g1.w); f[7] = bfhi(g1.w);
#pragma unroll
                    for (int j = 0; j < 8; ++j) f[j] = f[j] > 1e-30f ? f[j] : 1e-30f;
#ifndef EXP_NODIV
                    if (sub < 2) {
                        const u32x4 g2 = *(const u32x4*)(gp + (sub + 1) * 1024 + bj * HALF);
                        float d[8];
                        d[0] = bflo(g2.x); d[1] = bfhi(g2.x); d[2] = bflo(g2.y); d[3] = bfhi(g2.y); d[4] = bflo(g2.z); d[5] = bfhi(g2.z); d[6] = bflo(g2.w); d[7] = bfhi(g2.w);
#pragma unroll
                        for (int j = 0; j < 8; ++j) { d[j] = d[j] > 1e-30f ? d[j] : 1e-30f; f[j] = f[j] / d[j]; }
                    }
#endif
                    f32x4 v0 = acc[ai][bj][m][0], v1 = acc[ai][bj][m][1];
#pragma unroll
                    for (int j = 0; j < 4; ++j) { v0[j] *= f[j]; v1[j] *= f[4 + j]; }
                    acc[ai][bj][m][0] = v0; acc[ai][bj][m][1] = v1;
                    if (sub == 2) { u32x4 w; w.x = cvt_pk_bf16(v0[0], v0[1]); w.y = cvt_pk_bf16(v0[2], v0[3]); w.z = cvt_pk_bf16(v1[0], v1[1]); w.w = cvt_pk_bf16(v1[2], v1[3]);
                        *(u32x4*)(O + (size_t)row * D + col0 + bj * HALF) = w; }
                }
                asm volatile("" ::: "memory"); }
    }
};
struct EpiResid {
    static constexpr bool PERM = false;
    const float* bp; const float* bs; float* out;
    __device__ __forceinline__ void operator()(acc_t& acc, const Unit& u, int wr, int wc, int fr, int fq) const {
        const int row0 = u.pm * BM + wr * 64 + fr, col0 = u.pn * BM + wc * 32 + 4 * fq;
        const bool smp = u.pm >= MP / BM;
#pragma unroll
        for (int ai = 0; ai < 2; ++ai)
#pragma unroll
            for (int m = 0; m < 4; ++m) { const int row = row0 + ai * HALF + m * 16;
                const float* b = smp ? bs + (size_t)(row - MP) * D + col0 : bp + (size_t)row * D + col0; float* o = out + (size_t)row * D + col0;
#pragma unroll
                for (int bj = 0; bj < 2; ++bj)
#pragma unroll
                    for (int n = 0; n < 2; ++n) { const f32x4 bv = *(const f32x4*)(b + bj * HALF + n * 16); *(f32x4*)(o + bj * HALF + n * 16) = bv + acc[ai][bj][m][n]; }
                if (m & 1) asm volatile("" ::: "memory"); }
    }
};

template <class Epi>
__device__ __forceinline__ void gemm_phase(PG8_LAS unsigned char* lds, const Gemm g, const Order& S, const Epi& E) {
    int tid_ = threadIdx.x; asm volatile("" : "+v"(tid_));
    const int tid = tid_, wid = __builtin_amdgcn_readfirstlane(tid >> 6), lane = tid & 63, wr = wid >> 2, wc = wid & 3, fr = lane & 15, fq = lane >> 4;
    unsigned voffA[2], voffB[2];
#pragma unroll
    for (int i = 0; i < 2; ++i) { int R, C; stage_rc(tid * 16 + i * 8192, R, C); const int Rb = Epi::PERM ? ((R & ~31) + perm32(R & 31)) : R;
        voffA[i] = (unsigned)(R * g.lda + C) * 2u; voffB[i] = (unsigned)(Rb * g.ldb + C) * 2u; }
    const size_t kstep = (size_t)(BK * 2);
    const size_t hstepA = (size_t)HALF * g.lda * 2, hstepB = (size_t)HALF * g.ldb * 2;
    const size_t tstepA = 2 * hstepA, tstepB = 2 * hstepB;
    const unsigned ldsw = (unsigned)wid * 1024u;
    const int aoff = lds_byte(wr * 64 + fr, fq * 8), boff = lds_byte(wc * 32 + fr, fq * 8);
#define PG8_SA(b, h) (((b) * 2 + (h)) * HTB)
#define PG8_SB(b, h) ((4 + (b) * 2 + (h)) * HTB)
#define PG8_STAGE(bufoff, gbase, voff) do { _Pragma("unroll") for (int _i = 0; _i < 2; ++_i) \
        __builtin_amdgcn_global_load_lds((const unsigned*)((const char*)(gbase) + (voff)[_i]), (PG8_LAS unsigned*)(lds + (bufoff) + ldsw + _i * 8192), 16, 0, 0); } while (0)
#define PG8_LDA(dst, b, h) do { _Pragma("unroll") for (int m = 0; m < 4; ++m) _Pragma("unroll") for (int k = 0; k < 2; ++k) dst[m][k] = *(const PG8_LAS bf16x8*)(lds + PG8_SA(b, h) + aoff + m * 2048 + k * 1024); } while (0)
#define PG8_LDB(dst, b, h) do { _Pragma("unroll") for (int n = 0; n < 2; ++n) _Pragma("unroll") for (int k = 0; k < 2; ++k) dst[n][k] = *(const PG8_LAS bf16x8*)(lds + PG8_SB(b, h) + boff + n * 2048 + k * 1024); } while (0)
#define PG8_MMA(ai, bj, At, Bt) do { __builtin_amdgcn_s_setprio(1); _Pragma("unroll") for (int m = 0; m < 4; ++m) _Pragma("unroll") for (int n = 0; n < 2; ++n) _Pragma("unroll") for (int k = 0; k < 2; ++k) \
        acc[ai][bj][m][n] = __builtin_amdgcn_mfma_f32_16x16x32_bf16(Bt[n][k], At[m][k], acc[ai][bj][m][n], 0, 0, 0); __builtin_amdgcn_s_setprio(0); } while (0)
#define PG8_WAIT_V(n) asm volatile("s_waitcnt vmcnt(" #n ")" ::: "memory")
#define PG8_WAIT_L(n) asm volatile("s_waitcnt lgkmcnt(" #n ")" ::: "memory")
#define PG8_BAR __builtin_amdgcn_s_barrier()
#define PG8_SCHED __builtin_amdgcn_sched_barrier(0)
    Unit cur, nxt; int ui = 0;
    if (!S.next(0, cur)) return;
    f32x4 acc[2][2][4][2];
#pragma unroll
    for (int a = 0; a < 2; ++a)
#pragma unroll
        for (int b = 0; b < 2; ++b)
#pragma unroll
            for (int m = 0; m < 4; ++m)
#pragma unroll
                for (int n = 0; n < 2; ++n) acc[a][b][m][n] = (f32x4){0.f, 0.f, 0.f, 0.f};
    bf16x8 At[4][2], B0[2][2], B1[2][2];
    const char* cA = (const char*)g.A + (size_t)cur.pm * tstepA + (size_t)cur.k0 * 2; const char* cB = (const char*)g.Bt + (size_t)cur.pn * tstepB + (size_t)cur.k0 * 2;
    PG8_STAGE(PG8_SB(0, 0), cB, voffB); PG8_STAGE(PG8_SB(0, 1), cB + hstepB, voffB); PG8_STAGE(PG8_SA(0, 0), cA, voffA); PG8_STAGE(PG8_SA(0, 1), cA + hstepA, voffA);
    if (wr == 1) PG8_BAR;
    PG8_WAIT_V(2); PG8_BAR;
    PG8_STAGE(PG8_SB(1, 0), cB + kstep, voffB); PG8_STAGE(PG8_SA(1, 0), cA + kstep, voffA); PG8_STAGE(PG8_SB(1, 1), cB + hstepB + kstep, voffB);
    PG8_WAIT_V(6); PG8_BAR;
    for (;;) {
        const bool has_next = S.next(ui + 1, nxt);
        const char* nA = has_next ? (const char*)g.A + (size_t)nxt.pm * tstepA + (size_t)nxt.k0 * 2 : cA; const char* nB = has_next ? (const char*)g.Bt + (size_t)nxt.pn * tstepB + (size_t)nxt.k0 * 2 : cB;
        const int nt = cur.nt;
        for (int t = 0; t < nt; t += 2) {
            const bool last = (t == nt - 2);
            const char* a1 = cA + (size_t)(t + 1) * kstep;
            const char* a2 = last ? nA : cA + (size_t)(t + 2) * kstep; const char* b2 = last ? nB : cB + (size_t)(t + 2) * kstep;
            const char* a3 = a2 + kstep; const char* b3 = b2 + kstep;
            PG8_LDB(B0, 0, 0); PG8_LDB(B1, 0, 1); PG8_SCHED; PG8_LDA(At, 0, 0); PG8_STAGE(PG8_SA(1, 1), a1 + hstepA, voffA);
            PG8_WAIT_V(8); PG8_WAIT_L(0); PG8_BAR; PG8_MMA(0, 0, At, B0); PG8_MMA(0, 1, At, B1); PG8_BAR; PG8_SCHED;
            PG8_LDA(At, 0, 1); PG8_STAGE(PG8_SB(0, 0), b2, voffB); PG8_STAGE(PG8_SB(0, 1), b2 + hstepB, voffB); PG8_STAGE(PG8_SA(0, 0), a2, voffA);
            PG8_WAIT_V(8); PG8_WAIT_L(0); PG8_BAR; PG8_MMA(1, 0, At, B0); PG8_MMA(1, 1, At, B1); PG8_BAR; PG8_SCHED;
            PG8_LDB(B0, 1, 0); PG8_LDB(B1, 1, 1); PG8_SCHED; PG8_LDA(At, 1, 0); PG8_STAGE(PG8_SA(0, 1), a2 + hstepA, voffA);
            PG8_WAIT_V(8); PG8_WAIT_L(0); PG8_BAR; PG8_MMA(0, 0, At, B0); PG8_MMA(0, 1, At, B1); PG8_BAR; PG8_SCHED;
            PG8_LDA(At, 1, 1); PG8_STAGE(PG8_SB(1, 0), b3, voffB); PG8_STAGE(PG8_SB(1, 1), b3 + hstepB, voffB); PG8_STAGE(PG8_SA(1, 0), a3, voffA);
            PG8_WAIT_V(8); PG8_WAIT_L(0); PG8_BAR; PG8_MMA(1, 0, At, B0); PG8_MMA(1, 1, At, B1); PG8_BAR; PG8_SCHED;
        }
        if (wr == 0) PG8_BAR;
        E(acc, cur, wr, wc, fr, fq);
        if (!has_next) break;
        if (!cur.keep) {
#pragma unroll
            for (int a = 0; a < 2; ++a)
#pragma unroll
                for (int b = 0; b < 2; ++b)
#pragma unroll
                    for (int m = 0; m < 4; ++m)
#pragma unroll
                        for (int n = 0; n < 2; ++n) acc[a][b][m][n] = (f32x4){0.f, 0.f, 0.f, 0.f};
        }
        cur = nxt; cA = nA; cB = nB; ++ui;
        if (wr == 1) PG8_BAR;
    }
    PG8_WAIT_V(0);
    PG8_BAR;
#undef PG8_SA
#undef PG8_SB
#undef PG8_STAGE
#undef PG8_LDA
#undef PG8_LDB
#undef PG8_MMA
#undef PG8_WAIT_V
#undef PG8_WAIT_L
#undef PG8_BAR
#undef PG8_SCHED
}
}

#define XB_TMO      128
#define XB_XCNT(j)  (256  + 64 * (j))
#define XB_XSUB(j)  (1280 + 64 * (j))
#define XB_XGEN(j)  (2304 + 64 * (j))
#define XB_TOP      3328
#define XB_TOPGEN   3392
#define XCD_BAR_WORDS 3456
#define XB_SPIN_CAP (1u << 20)

__device__ __forceinline__ unsigned xb_ld(unsigned* p)              { return __hip_atomic_load(p, __ATOMIC_RELAXED, __HIP_MEMORY_SCOPE_AGENT); }
__device__ __forceinline__ unsigned xb_add(unsigned* p, unsigned v) { return __hip_atomic_fetch_add(p, v, __ATOMIC_RELAXED, __HIP_MEMORY_SCOPE_AGENT); }
__device__ __forceinline__ unsigned xb_xcc_id() { return (unsigned)__builtin_amdgcn_s_getreg((3 << 11) | 20) & 0xFu; }
#define XB_SPIN(cond, bar) do { unsigned _sp = 0; while (cond) { __builtin_amdgcn_s_sleep(1); \
    if ((++_sp & 255u) == 0u) { if (xb_ld(&(bar)[XB_TMO])) break; if (_sp > XB_SPIN_CAP) { atomicAdd(&(bar)[XB_TMO], 1u); break; } } } } while (0)

struct XcdBarrier { unsigned* bar; unsigned x; volatile LAS unsigned* st; };

__device__ __forceinline__ XcdBarrier xcd_barrier_post(unsigned* bar, volatile LAS unsigned* st) {
    XcdBarrier b; b.bar = bar; b.x = xb_xcc_id(); b.st = st;
    if (threadIdx.x == 0) (void)xb_add(&bar[XB_XCNT(b.x)], 1u);
    return b;
}
__device__ __forceinline__ void xcd_barrier_complete(unsigned* bar, unsigned x, unsigned& nloc, unsigned& nx) {
    const unsigned G = gridDim.x * gridDim.y * gridDim.z;
    unsigned sum, cnt, mine, sp = 0u;
    for (;;) {
        sum = 0u; cnt = 0u; mine = 0u;
#pragma unroll
        for (unsigned j = 0; j < 16; ++j) { const unsigned c = xb_ld(&bar[XB_XCNT(j)]); sum += c; cnt += (c > 0u) ? 1u : 0u; mine = (j == x) ? c : mine; }
        if (sum == G) break;
        __builtin_amdgcn_s_sleep(1);
        if ((++sp & 255u) == 0u) { if (xb_ld(&bar[XB_TMO])) break; if (sp > XB_SPIN_CAP) { atomicAdd(&bar[XB_TMO], 1u); break; } }
    }
    nloc = mine > 0u ? mine : 1u; nx = cnt > 0u ? cnt : 1u;
}
__device__ __forceinline__ void xcd_barrier(const XcdBarrier& b) {
    asm volatile("s_waitcnt vmcnt(0)" ::: "memory");
    __syncthreads();
    if (threadIdx.x == 0) {
        unsigned* bar = b.bar;
        __builtin_amdgcn_s_waitcnt(0);
        unsigned nloc = b.st[0], nx = b.st[1];
        if (nloc == 0u) { xcd_barrier_complete(bar, b.x, nloc, nx); b.st[0] = nloc; b.st[1] = nx; }
        const unsigned old = xb_add(&bar[XB_XSUB(b.x)], 1u);
        const unsigned gen = old / nloc;
        if (old + 1u == (gen + 1u) * nloc) {
            __builtin_amdgcn_fence(__ATOMIC_RELEASE, "agent");
            asm volatile("s_waitcnt vmcnt(0)" ::: "memory");
            const unsigned og = xb_add(&bar[XB_TOP], 1u);
            const unsigned tg = og / nx;
            if (og + 1u == (tg + 1u) * nx) xb_add(&bar[XB_TOPGEN], 1u);
            else XB_SPIN(xb_ld(&bar[XB_TOPGEN]) == tg, bar);
            __builtin_amdgcn_fence(__ATOMIC_ACQUIRE, "agent");
            xb_add(&bar[XB_XGEN(b.x)], 1u);
            asm volatile("s_waitcnt vmcnt(0)" ::: "memory");
        } else {
            XB_SPIN(xb_ld(&bar[XB_XGEN(b.x)]) == gen, bar);
            __builtin_amdgcn_fence(__ATOMIC_ACQUIRE, "agent");
            asm volatile("s_waitcnt vmcnt(0)" ::: "memory");
        }
    }
    __syncthreads();
}

struct Args {
    const float* in[21];
    float* out; unsigned char* ws;
};

__device__ __forceinline__ void transpose_item(const float* W, int ldw, int ncols, bf16* WT, int ldd, int row_off, int col_off, LAS float* scr, int item, int lane) {
    const int nblk = ncols / 32, kb = item / nblk, nb = item % nblk, k0 = 64 * kb, n0 = 32 * nb;
#pragma unroll 8
    for (int i = 0; i < 32; ++i) { const int kk = 2 * i + (lane >> 5); scr[kk * 33 + (lane & 31)] = W[(size_t)(k0 + kk) * ldw + n0 + (lane & 31)]; }
    LDS_WAIT(); asm volatile("" ::: "memory");
    const int c = lane & 7;
#pragma unroll
    for (int j = 0; j < 4; ++j) { const int n = (lane >> 3) + 8 * j; const LAS float* s = scr + (8 * c) * 33 + n;
        v4u o; o.x = pk2(s[0 * 33], s[1 * 33]); o.y = pk2(s[2 * 33], s[3 * 33]); o.z = pk2(s[4 * 33], s[5 * 33]); o.w = pk2(s[6 * 33], s[7 * 33]);
        *(GAS v4u*)(WT + (size_t)(row_off + n0 + n) * ldd + col_off + k0 + 8 * c) = o; }
    LDS_WAIT(); asm volatile("" ::: "memory");
}

__device__ __forceinline__ void convert_weights(const Args& a, LAS unsigned char* lds, int vcu, int G) {
    const int tid = opaque_tid(), lane = tid & 63, wave = __builtin_amdgcn_readfirstlane(tid >> 6), gw = vcu * NWAVES + wave, NGW = G * NWAVES;
    LAS float* scr = (LAS float*)(lds + wave * 16384);
    constexpr int I_IN1 = 16 * 96, I_IN2 = 16 * 144, I_BA = 16 * 32, I_BB = 8 * 32, I_BC = 8 * 32, I_O = 16 * 32, I_F1 = 16 * 128, I_F2 = 64 * 32;
    constexpr int PER_LAYER = I_IN1 + I_IN2 + I_BA + I_BB + I_BC + I_O + I_F1 + I_F2;
    for (int it = gw; it < 2 * PER_LAYER; it += NGW) {
        const int l = it / PER_LAYER; int r = it - l * PER_LAYER;
        unsigned char* wl = a.ws + WS_W + (size_t)l * W_LAYER;
        const float* w_in = a.in[5] + (size_t)l * D * IN_COLS;
        if (r < I_IN1) { transpose_item(w_in, IN_COLS, 3072, (bf16*)(wl + W_IN), D, 0, 0, scr, r, lane); continue; } r -= I_IN1;
        if (r < I_IN2) { transpose_item(w_in + 3088, IN_COLS, 4608, (bf16*)(wl + W_IN), D, 3072, 0, scr, r, lane); continue; } r -= I_IN2;
        if (r < I_BA) { transpose_item(a.in[13] + (size_t)l * 1024 * 1024, 1024, 1024, (bf16*)(wl + W_BR), 2048, 0, 0, scr, r, lane); continue; } r -= I_BA;
        if (r < I_BB) { transpose_item(a.in[14] + (size_t)l * 512 * 1024, 1024, 1024, (bf16*)(wl + W_BR), 2048, 0, 1024, scr, r, lane); continue; } r -= I_BB;
        if (r < I_BC) { transpose_item(a.in[15] + (size_t)l * 512 * 1024, 1024, 1024, (bf16*)(wl + W_BR), 2048, 0, 1536, scr, r, lane); continue; } r -= I_BC;
        if (r < I_O) { transpose_item(a.in[16] + (size_t)l * 1024 * 1024, 1024, 1024, (bf16*)(wl + W_OUT), 1024, 0, 0, scr, r, lane); continue; } r -= I_O;
        if (r < I_F1) { transpose_item(a.in[18] + (size_t)l * 1024 * FF, FF, FF, (bf16*)(wl + W_FF1), 1024, 0, 0, scr, r, lane); continue; } r -= I_F1;
        transpose_item(a.in[19] + (size_t)l * FF * 1024, 1024, 1024, (bf16*)(wl + W_FF2), FF, 0, 0, scr, r, lane);
    }
}

template <int MODE>
__device__ __forceinline__ void norm_phase(LAS unsigned char* lds, int vcu, int G,
                                           const float* hp, const float* hs, const float* w, bf16* HN, float* GLOG, float* outf,
                                           const float* w_in_l, const float* w_gk2_l, const float* b_gk_l) {
    const int tid = opaque_tid(), lane = tid & 63, wave = __builtin_amdgcn_readfirstlane(tid >> 6), gw = vcu * NWAVES + wave, NGW = G * NWAVES;
    LAS float* Wg = (LAS float*)lds;
    LAS float* Wk = Wg + 16 * 1024;
    if (MODE == 1) {
        for (int idx = tid; idx < 16 * 1024; idx += 512) { const int k = idx >> 4, c = idx & 15; Wg[c * 1024 + k] = w_in_l[(size_t)k * IN_COLS + 3072 + c]; }
        for (int idx = tid; idx < 16 * 512; idx += 512) Wk[idx] = w_gk2_l[idx];
        __syncthreads();
    }
    f32x4 wv[4];
#pragma unroll
    for (int j = 0; j < 4; ++j) wv[j] = *(const f32x4*)(w + 4 * lane + 256 * j);
    for (int m = gw; m < M; m += NGW) {
        const float* xr = (m < MP) ? hp + (size_t)m * D : hs + (size_t)(m - MP) * D;
        f32x4 v[4]; float ss = 0.f;
#pragma unroll
        for (int j = 0; j < 4; ++j) { v[j] = *(const f32x4*)(xr + 4 * lane + 256 * j); ss += (v[j].x * v[j].x + v[j].y * v[j].y) + (v[j].z * v[j].z + v[j].w * v[j].w); }
        const float r = 1.0f / sqrtf(wave_sum(ss) * (1.0f / D) + EPS);
#pragma unroll
        for (int j = 0; j < 4; ++j) v[j] = v[j] * r * wv[j];
        if (MODE == 2) {
#pragma unroll
            for (int j = 0; j < 4; ++j) *(f32x4*)(outf + (size_t)m * D + 4 * lane + 256 * j) = v[j];
        } else {
#pragma unroll
            for (int j = 0; j < 4; ++j) { v2u o; o.x = pk2(v[j].x, v[j].y); o.y = pk2(v[j].z, v[j].w); *(v2u*)(HN + (size_t)m * D + 4 * lane + 256 * j) = o; }
        }
        if (MODE == 1) {
            float gl[16];
#pragma unroll
            for (int c = 0; c < 16; ++c) { float p = 0.f;
#pragma unroll
                for (int j = 0; j < 4; ++j) { const f32x4 wg = *(const LAS f32x4*)(Wg + c * 1024 + 4 * lane + 256 * j); p += (v[j].x * wg.x + v[j].y * wg.y) + (v[j].z * wg.z + v[j].w * wg.w); }
                gl[c] = wave_sum(p); if ((c & 3) == 3) asm volatile("" ::: "memory"); }
#pragma unroll
            for (int hb = 0; hb < 2; ++hb) { const int d0 = 4 * lane + 256 * hb;
                f32x4 acc = *(const f32x4*)(b_gk_l + d0);
#pragma unroll
                for (int c = 0; c < 16; ++c) { const f32x4 wk = *(const LAS f32x4*)(Wk + c * 512 + d0); acc = acc + wk * gl[c]; }
                f32x4 o;
#pragma unroll
                for (int i = 0; i < 4; ++i) { const float x = acc[i]; const float ls = (x < 0.f ? x : 0.f) - log1pf(__expf(-fabsf(x))); o[i] = ls * (1.0f / 16.0f); }
                *(f32x4*)(GLOG + (size_t)m * 512 + d0) = o; }
        }
    }
    if (MODE == 1) __syncthreads();
}

__device__ __forceinline__ void gla_seq(LAS unsigned char* lds, const bf16* PROJ, const float* GLOG, bf16* MIXOUT, const float* gn,
                                        int row0, int T, int h, const float* S0, float* Sout) {
    const int tid = opaque_tid(), lane = tid & 63, wave = __builtin_amdgcn_readfirstlane(tid >> 6);
    LAS float* qs = (LAS float*)lds;
    LAS float* ks = qs + 16 * 128;
    LAS float* as = ks + 16 * 128;
    LAS float* op = as + 16 * 128;
    const int e = tid & 255, dh = __builtin_amdgcn_readfirstlane(tid >> 8);
    float S[64];
#pragma unroll
    for (int i = 0; i < 64; ++i) S[i] = S0 ? S0[(size_t)(dh * 64 + i) * 256 + e] : 0.f;
    const int TB = T < 16 ? T : 16;
    for (int t0 = 0; t0 < T; t0 += TB) {
        __syncthreads();
        for (int idx = tid; idx < TB * 128; idx += 512) { const int t = idx >> 7, d = idx & 127; const size_t row = (size_t)(row0 + t0 + t);
            qs[idx] = bf2f(PROJ[row * NPJ + C_Q + h * 128 + d]); ks[idx] = bf2f(PROJ[row * NPJ + C_K + h * 128 + d]); as[idx] = __expf(GLOG[row * 512 + h * 128 + d]); }
        __syncthreads();
        for (int t = 0; t < TB; ++t) {
            const float v = bf2f(PROJ[(size_t)(row0 + t0 + t) * NPJ + C_V + h * 256 + e]);
            const LAS float* qp = qs + t * 128 + dh * 64; const LAS float* kp = ks + t * 128 + dh * 64; const LAS float* ap = as + t * 128 + dh * 64;
            float o = 0.f;
#pragma unroll
            for (int i4 = 0; i4 < 16; ++i4) { const f32x4 q4 = *(const LAS f32x4*)(qp + 4 * i4), k4 = *(const LAS f32x4*)(kp + 4 * i4), a4 = *(const LAS f32x4*)(ap + 4 * i4);
#pragma unroll
                for (int j = 0; j < 4; ++j) { const int i = 4 * i4 + j; S[i] = a4[j] * S[i] + k4[j] * v; o += q4[j] * S[i]; } }
            op[(t * 2 + dh) * 256 + e] = o;
        }
        __syncthreads();
#pragma unroll
        for (int tt = 0; tt < 2; ++tt) { const int t = wave * 2 + tt;
            if (t < TB) { const int e4 = lane * 4; const size_t row = (size_t)(row0 + t0 + t);
                const f32x4 o = *(const LAS f32x4*)(op + (t * 2) * 256 + e4) + *(const LAS f32x4*)(op + (t * 2 + 1) * 256 + e4);
                const float ss = wave_sum((o.x * o.x + o.y * o.y) + (o.z * o.z + o.w * o.w));
                const float r = 1.0f / sqrtf(ss * (1.0f / 256.0f) + EPS);
                const v2u gw2 = *(const v2u*)(PROJ + row * NPJ + C_GO + h * 256 + e4);
                const f32x4 g4 = *(const f32x4*)(gn + e4);
                const float g0 = bflo(gw2.x), g1 = bfhi(gw2.x), g2 = bflo(gw2.y), g3 = bfhi(gw2.y);
                v2u ow; ow.x = pk2(o.x * r * g4.x * (g0 * sigmoid_f(g0)), o.y * r * g4.y * (g1 * sigmoid_f(g1))); ow.y = pk2(o.z * r * g4.z * (g2 * sigmoid_f(g2)), o.w * r * g4.w * (g3 * sigmoid_f(g3)));
                *(v2u*)(MIXOUT + row * MIXW + h * 256 + e4) = ow; } }
    }
#pragma unroll
    for (int i = 0; i < 64; ++i) Sout[(size_t)(dh * 64 + i) * 256 + e] = S[i];
    __syncthreads();
}

typedef float f32x16 __attribute__((ext_vector_type(16)));
typedef short s16x4 __attribute__((ext_vector_type(4)));
#define MFMA32(a, b, c) __builtin_amdgcn_mfma_f32_32x32x16_bf16((a), (b), (c), 0, 0, 0)
constexpr int GL_QG = 0, GL_KG = 17408, GL_KD = 34816, GL_VV = 55296, GL_PP = 92160, GL_DEC = 101376, GL_TOT = 101888, GL_END = 110080;
constexpr int GL_SQ = 272, GL_SKD = 320, GL_SV = 576, GL_SP = 144, GL_SO = 1040;
static_assert(GL_END <= RING_BYTES && 64 * GL_SO <= GL_PP, "gla lds map");
__device__ __forceinline__ bf16x8 tr_frag(LAS unsigned char* p, int rowstride4) {
    const s16x4 lo = __builtin_amdgcn_ds_read_tr16_b64_v4i16((LAS s16x4*)p), hi = __builtin_amdgcn_ds_read_tr16_b64_v4i16((LAS s16x4*)(p + rowstride4));
    return __builtin_shufflevector(lo, hi, 0, 1, 2, 3, 4, 5, 6, 7);
}
__device__ __forceinline__ void gla_chunked(LAS unsigned char* lds, const bf16* PROJ, const float* GLOG, bf16* MIXOUT, const float* gn, int row0, int nchunks, int h, float* Sout) {
    const int tid = opaque_tid(), lane = tid & 63, w = __builtin_amdgcn_readfirstlane(tid >> 6), r = lane & 31, hh = lane >> 5;
    const int tq = (lane & 15) >> 2, tp = lane & 3, tblk = (lane >> 4) & 1;
    const int dq = tid & 31, seg = tid >> 5;
    f32x16 S[4];
#pragma unroll
    for (int b = 0; b < 4; ++b)
#pragma unroll
        for (int i = 0; i < 16; ++i) S[b][i] = 0.f;
    for (int c = 0; c < nchunks; ++c) {
        const int r0 = row0 + 64 * c;
        {
            f32x4 cs[4];
#pragma unroll
            for (int i = 0; i < 4; ++i) { cs[i] = *(const f32x4*)(GLOG + (size_t)(r0 + 4 * seg + i) * 512 + h * 128 + 4 * dq); if (i) cs[i] = cs[i] + cs[i - 1]; }
            *(LAS f32x4*)(lds + GL_TOT + (seg * 128 + 4 * dq) * 4) = cs[3];
            v2u qv[4], kv[4];
#pragma unroll
            for (int i = 0; i < 4; ++i) { const bf16* pr = PROJ + (size_t)(r0 + 4 * seg + i) * NPJ + h * 128 + 4 * dq; qv[i] = *(const v2u*)(pr + C_Q); kv[i] = *(const v2u*)(pr + C_K); }
            v4u vv[4];
#pragma unroll
            for (int i = 0; i < 4; ++i) { const int idx = tid + 512 * i, sr = idx >> 5, ch = idx & 31; vv[i] = *(const v4u*)(PROJ + (size_t)(r0 + sr) * NPJ + C_V + h * 256 + ch * 8); }
            __syncthreads();
            f32x4 pre = (f32x4){0.f, 0.f, 0.f, 0.f}, tot = (f32x4){0.f, 0.f, 0.f, 0.f};
#pragma unroll
            for (int s2 = 0; s2 < 16; ++s2) { const f32x4 tv = *(const LAS f32x4*)(lds + GL_TOT + (s2 * 128 + 4 * dq) * 4); tot = tot + tv; if (s2 < seg) pre = pre + tv; }
#pragma unroll
            for (int i = 0; i < 4; ++i) { const f32x4 b = pre + cs[i]; const int t = 4 * seg + i;
                float q4[4] = {bflo(qv[i].x), bfhi(qv[i].x), bflo(qv[i].y), bfhi(qv[i].y)}, k4[4] = {bflo(kv[i].x), bfhi(kv[i].x), bflo(kv[i].y), bfhi(kv[i].y)};
                float qg[4], kg[4], kd[4];
#pragma unroll
                for (int j = 0; j < 4; ++j) { qg[j] = q4[j] * __expf(b[j]); kg[j] = k4[j] * __expf(-b[j]); kd[j] = k4[j] * __expf(tot[j] - b[j]); }
                v2u o; o.x = pg8::cvt_pk_bf16(qg[0], qg[1]); o.y = pg8::cvt_pk_bf16(qg[2], qg[3]); *(LAS v2u*)(lds + GL_QG + t * GL_SQ + dq * 8) = o;
                o.x = pg8::cvt_pk_bf16(kg[0], kg[1]); o.y = pg8::cvt_pk_bf16(kg[2], kg[3]); *(LAS v2u*)(lds + GL_KG + t * GL_SQ + dq * 8) = o;
                o.x = pg8::cvt_pk_bf16(kd[0], kd[1]); o.y = pg8::cvt_pk_bf16(kd[2], kd[3]); *(LAS v2u*)(lds + GL_KD + t * GL_SKD + dq * 8) = o; }
            if (seg == 0) { f32x4 dc; dc.x = __expf(tot.x); dc.y = __expf(tot.y); dc.z = __expf(tot.z); dc.w = __expf(tot.w); *(LAS f32x4*)(lds + GL_DEC + dq * 16) = dc; }
#pragma unroll
            for (int i = 0; i < 4; ++i) { const int idx = tid + 512 * i, sr = idx >> 5, ch = idx & 31; *(LAS v4u*)(lds + GL_VV + sr * GL_SV + ch * 16) = vv[i]; }
        }
        __syncthreads();
        if (w < 3) {
            const int bi = w > 0 ? 1 : 0, bj = w > 1 ? 1 : 0;
            f32x16 acc;
#pragma unroll
            for (int i = 0; i < 16; ++i) acc[i] = 0.f;
#pragma unroll
            for (int ks = 0; ks < 8; ++ks) {
                const bf16x8 a = *(const LAS bf16x8*)(lds + GL_QG + (32 * bi + r) * GL_SQ + (16 * ks + 8 * hh) * 2);
                const bf16x8 b = *(const LAS bf16x8*)(lds + GL_KG + (32 * bj + r) * GL_SQ + (16 * ks + 8 * hh) * 2);
                acc = MFMA32(a, b, acc); }
#pragma unroll
            for (int i = 0; i < 16; ++i) { const int tl = (i & 3) + 8 * (i >> 2) + 4 * hh; float v = acc[i]; if (bi == bj && r > tl) v = 0.f;
                *(LAS unsigned short*)(lds + GL_PP + (32 * bi + tl) * GL_SP + (32 * bj + r) * 2) = (unsigned short)f2bf(v); }
        }
        __syncthreads();
        f32x16 o[2];
        {
            bf16x8 Bv[4];
#pragma unroll
            for (int ks = 0; ks < 4; ++ks) Bv[ks] = tr_frag(lds + GL_VV + (16 * ks + 8 * hh + tq) * GL_SV + (4 * w + 2 * tblk + (tp >> 1)) * 16 + 8 * (tp & 1), 4 * GL_SV);
#pragma unroll
            for (int rb = 0; rb < 2; ++rb) {
#pragma unroll
                for (int i = 0; i < 16; ++i) o[rb][i] = 0.f;
#pragma unroll
                for (int b = 0; b < 4; ++b)
#pragma unroll
                    for (int s2 = 0; s2 < 2; ++s2) {
                        const LAS unsigned char* ap = lds + GL_QG + (32 * rb + r) * GL_SQ + (32 * b + 16 * s2 + 4 * hh) * 2;
                        const s16x4 lo = *(const LAS s16x4*)ap, hi = *(const LAS s16x4*)(ap + 16);
                        const bf16x8 a = __builtin_shufflevector(lo, hi, 0, 1, 2, 3, 4, 5, 6, 7);
                        v4u pk; pk.x = pg8::cvt_pk_bf16(S[b][8 * s2 + 0], S[b][8 * s2 + 1]); pk.y = pg8::cvt_pk_bf16(S[b][8 * s2 + 2], S[b][8 * s2 + 3]);
                        pk.z = pg8::cvt_pk_bf16(S[b][8 * s2 + 4], S[b][8 * s2 + 5]); pk.w = pg8::cvt_pk_bf16(S[b][8 * s2 + 6], S[b][8 * s2 + 7]);
                        o[rb] = MFMA32(a, __builtin_bit_cast(bf16x8, pk), o[rb]); }
#pragma unroll
                for (int ks = 0; ks < 4; ++ks) if (ks < 2 || rb == 1) {
                    const bf16x8 a = *(const LAS bf16x8*)(lds + GL_PP + (32 * rb + r) * GL_SP + (16 * ks + 8 * hh) * 2);
                    o[rb] = MFMA32(a, Bv[ks], o[rb]); }
            }
#pragma unroll
            for (int b = 0; b < 4; ++b) {
#pragma unroll
                for (int g4 = 0; g4 < 4; ++g4) { const f32x4 dc = *(const LAS f32x4*)(lds + GL_DEC + (32 * b + 8 * g4 + 4 * hh) * 4);
#pragma unroll
                    for (int j = 0; j < 4; ++j) S[b][4 * g4 + j] *= dc[j]; }
#pragma unroll
                for (int ks = 0; ks < 4; ++ks) {
                    const bf16x8 a = tr_frag(lds + GL_KD + (16 * ks + 8 * hh + tq) * GL_SKD + (4 * b + 2 * tblk + (tp >> 1)) * 16 + 8 * (tp & 1), 4 * GL_SKD);
                    S[b] = MFMA32(a, Bv[ks], S[b]); }
            }
        }
        __syncthreads();
#pragma unroll
        for (int rb = 0; rb < 2; ++rb)
#pragma unroll
            for (int i = 0; i < 16; ++i) *(LAS float*)(lds + (32 * rb + (i & 3) + 8 * (i >> 2) + 4 * hh) * GL_SO + (32 * w + r) * 4) = o[rb][i];
        __syncthreads();
        {
            const int t = tid >> 3, sg = tid & 7, e0 = sg * 32; const size_t row = (size_t)(r0 + t);
            f32x4 ov[8]; float ss = 0.f;
#pragma unroll
            for (int i = 0; i < 8; ++i) { ov[i] = *(const LAS f32x4*)(lds + t * GL_SO + (e0 + 4 * i) * 4); ss += (ov[i].x * ov[i].x + ov[i].y * ov[i].y) + (ov[i].z * ov[i].z + ov[i].w * ov[i].w); }
            ss += __shfl_xor(ss, 1); ss += __shfl_xor(ss, 2); ss += __shfl_xor(ss, 4);
            const float rn = 1.0f / sqrtf(ss * (1.0f / 256.0f) + EPS);
#pragma unroll
            for (int i = 0; i < 4; ++i) { const v4u gw4 = *(const v4u*)(PROJ + row * NPJ + C_GO + h * 256 + e0 + 8 * i);
                const f32x4 ga = *(const f32x4*)(gn + e0 + 8 * i), gb = *(const f32x4*)(gn + e0 + 8 * i + 4);
                const float g0 = bflo(gw4.x), g1 = bfhi(gw4.x), g2 = bflo(gw4.y), g3 = bfhi(gw4.y), g4 = bflo(gw4.z), g5 = bfhi(gw4.z), g6 = bflo(gw4.w), g7 = bfhi(gw4.w);
                const f32x4 oa = ov[2 * i], ob = ov[2 * i + 1]; v4u ow;
                ow.x = pg8::cvt_pk_bf16(oa.x * rn * ga.x * (g0 * sigmoid_f(g0)), oa.y * rn * ga.y * (g1 * sigmoid_f(g1)));
                ow.y = pg8::cvt_pk_bf16(oa.z * rn * ga.z * (g2 * sigmoid_f(g2)), oa.w * rn * ga.w * (g3 * sigmoid_f(g3)));
                ow.z = pg8::cvt_pk_bf16(ob.x * rn * gb.x * (g4 * sigmoid_f(g4)), ob.y * rn * gb.y * (g5 * sigmoid_f(g5)));
                ow.w = pg8::cvt_pk_bf16(ob.z * rn * gb.z * (g6 * sigmoid_f(g6)), ob.w * rn * gb.w * (g7 * sigmoid_f(g7)));
                *(v4u*)(MIXOUT + row * MIXW + h * 256 + e0 + 8 * i) = ow; }
        }
        __syncthreads();
    }
#pragma unroll
    for (int b = 0; b < 4; ++b)
#pragma unroll
        for (int i = 0; i < 16; ++i) Sout[(size_t)(32 * b + (i & 3) + 8 * (i >> 2) + 4 * hh) * 256 + 32 * w + r] = S[b][i];
}

__device__ __forceinline__ void pool_item(LAS unsigned char* lds, const bf16* PROJ, bf16* MIXOUT, const float* wmix, const float* scale, const float* hist  ,
                                          int rowseq0, int tpos0, int nt, int g) {
    const int tid = opaque_tid();
    LAS float* pl = (LAS float*)lds;
    const int w = 2 << g;
    for (int idx = tid; idx < nt * 128; idx += 512) { const int t = idx >> 7, c = idx & 127, pos = tpos0 + t, col = C_XP + g * 128 + c;
        float sum = 0.f;
        for (int i = 0; i < w; ++i) { const int p = pos - i;
            if (p >= 0) sum += bf2f(PROJ[(size_t)(rowseq0 + p) * NPJ + col]);
            else if (hist) sum += hist[(size_t)(15 + p) * 512 + g * 128 + c]; }
        const int cnt = hist ? w : (w < pos + 1 ? w : pos + 1);
        pl[idx] = sum / (float)cnt - bf2f(PROJ[(size_t)(rowseq0 + pos) * NPJ + col]); }
    __syncthreads();
    const int j = tid & 127, tq = __builtin_amdgcn_readfirstlane(tid >> 7), tpq = nt >> 2;
    float acc[4] = {0.f, 0.f, 0.f, 0.f};
    for (int c = 0; c < 128; ++c) { const float wv = wmix[(size_t)(g * 128 + c) * 128 + j];
#pragma unroll
        for (int i = 0; i < 4; ++i) if (i < tpq) acc[i] += pl[(tq * tpq + i) * 128 + c] * wv; }
    const float sc = scale[g * 128 + j];
#pragma unroll
    for (int i = 0; i < 4; ++i) if (i < tpq) MIXOUT[(size_t)(rowseq0 + tpos0 + tq * tpq + i) * MIXW + 1024 + g * 128 + j] = (bf16)f2bf(acc[i] * sc);
    __syncthreads();
}

__device__ __forceinline__ void sg_item(LAS unsigned char* lds, const bf16* PROJ, bf16* MIXOUT, const float* ws, const float* bs, int row0, int L, int g) {
    const int tid = opaque_tid();
    LAS float* vt = (LAS float*)lds;
    LAS float* wt = vt + 128 * 128;
    for (int idx = tid; idx < L * 128; idx += 512) { const int s = idx >> 7, d = idx & 127;
        vt[idx] = bf2f(PROJ[(size_t)(row0 + s) * NPJ + C_VV + g * 128 + d]);
        wt[idx] = ws[(size_t)(g * 128 + s) * 128 + d]; }
    __syncthreads();
    const int d = tid & 127, tq = __builtin_amdgcn_readfirstlane(tid >> 7);
    for (int t = tq; t < L; t += 4) { float acc = 0.f;
        for (int s = 0; s <= t; ++s) acc += wt[t * 128 + s] * vt[s * 128 + d];
        const float u = bf2f(PROJ[(size_t)(row0 + t) * NPJ + C_U + g * 128 + d]);
        MIXOUT[(size_t)(row0 + t) * MIXW + 1536 + g * 128 + d] = (bf16)f2bf(u * (acc + bs[g * 128 + t])); }
    __syncthreads();
}


#ifndef PH
#define PH 0xFFFF
#endif
__global__ void __launch_bounds__(NWAVES * 64, 2) hybrid_fwd(Args args) {
    extern __shared__ __attribute__((aligned(16))) unsigned char lds_raw[];
    LAS unsigned char* lds = (LAS unsigned char*)lds_raw;
    volatile LAS unsigned* MISC = (volatile LAS unsigned*)(lds + MISC_OFF);
    const int G = gridDim.x, bx = blockIdx.x, vcu = (G % 8 == 0) ? (bx % 8) * (G / 8) + bx / 8 : bx;
    unsigned char* ws = args.ws;
    gu32* ctl = (gu32*)(ws + WS_CTL);
    for (int u = threadIdx.x; u < (LDS_BYTES - LDSCTL_OFF) / 4; u += NWAVES * 64) ((LAS unsigned*)(lds + LDSCTL_OFF))[u] = 0u;
    __syncthreads();
    XcdBarrier bar = xcd_barrier_post((unsigned*)(ctl + CW_BAR), MISC + 8);
#ifdef USE_CG
#define GRID_BAR() cooperative_groups::this_grid().sync()
#else
#define GRID_BAR() xcd_barrier(bar)
#endif

    bf16* HN = (bf16*)(ws + WS_HN);
    float* GLOG = (float*)(ws + WS_GLOG);
    bf16* MIX = (bf16*)(ws + WS_MIX);
    bf16* PROJ = (bf16*)(ws + WS_PROJ);
    bf16* FFH = (bf16*)(ws + WS_PROJ);
    float* H = args.out + O_Y;
    const float* xp_in = args.in[0]; const float* xs_in = args.in[1];

#if PH & 1
    convert_weights(args, lds, vcu, G);
    __syncthreads();
#endif
#if PH & 2
    norm_phase<1>(lds, vcu, G, xp_in, xs_in, args.in[4], HN, GLOG, nullptr, args.in[5], args.in[6], args.in[7]);
#endif
    GRID_BAR();

#ifdef EXP_ONELAYER
    for (int l = 0; l < 1; ++l) {
#else
    for (int l = 0; l < DEPTH; ++l) {
#endif
        unsigned char* wl = ws + WS_W + (size_t)l * W_LAYER;
#if PH & 4
        if (l > 0) {
            norm_phase<1>(lds, vcu, G, H, H + (size_t)MP * D, args.in[4] + l * D, HN, GLOG, nullptr, args.in[5] + (size_t)l * D * IN_COLS, args.in[6] + l * 16 * 512, args.in[7] + l * 512);
            GRID_BAR();
        }
#endif
#if PH & 8
        {
            pg8::Gemm g{HN, (const bf16*)(wl + W_IN), D, D}; pg8::Order S; S.init(M, NPJ, D, G, bx, 1);
            pg8::EpiProj E{PROJ, args.out + O_SGV + (size_t)l * MS * 512, H};
            pg8::gemm_phase<pg8::EpiProj>(lds, g, S, E);
        }
#endif
        GRID_BAR();
        {
            const float* gn = args.in[8] + l * 256;
            if (vcu < 32) {
#if PH & 16
                const int n = vcu >> 2, h = vcu & 3;
                gla_chunked(lds, PROJ, GLOG, MIX, gn, n * SEQ, SEQ / 64, h, args.out + O_GLAP + ((size_t)(l * NB + n) * 4 + h) * 128 * 256);
#endif
            } else {
#if PH & 32
                const float* wmix = args.in[9] + (size_t)l * 4 * 128 * 128; const float* pscale = args.in[10] + l * 512;
                const float* wsp = args.in[11] + (size_t)l * 4 * 128 * 128; const float* bsp = args.in[12] + l * 4 * 128;
                const float* spool = args.in[3] + (size_t)l * SB * 15 * 512;
                constexpr int I_GS = 512, I_PP = 4096, I_PS = 512, I_SP = 512, I_SS = 512, I_ST = 136;
                constexpr int NL = I_GS + I_PP + I_PS + I_SP + I_SS + I_ST;
                for (int it = vcu - 32; it < NL; it += G - 32) {
                    int r = it;
#ifdef EXP_MIXMASK
                    { const int kind = r < I_GS ? 0 : r < I_GS + I_PP ? 1 : r < I_GS + I_PP + I_PS ? 2 : r < I_GS + I_PP + I_PS + I_SP ? 3 : r < I_GS + I_PP + I_PS + I_SP + I_SS ? 4 : 5;
                      if (!((EXP_MIXMASK >> kind) & 1)) continue; }
#endif
                    if (r < I_GS) { const int n = r >> 2, h = r & 3; const size_t so = ((size_t)(l * SB + n) * 4 + h) * 128 * 256;
                        gla_seq(lds, PROJ, GLOG, MIX, gn, MP + n * ST, ST, h, args.in[2] + so, args.out + O_GLAS + so); continue; } r -= I_GS;
                    if (r < I_PP) { const int g = r & 3, tile = r >> 2, n = tile >> 7, tt = tile & 127;
                        pool_item(lds, PROJ, MIX, wmix, pscale, nullptr, n * SEQ, tt * 16, 16, g); continue; } r -= I_PP;
                    if (r < I_PS) { const int g = r & 3, n = r >> 2;
                        pool_item(lds, PROJ, MIX, wmix, pscale, spool + (size_t)n * 15 * 512, MP + n * ST, 0, ST, g); continue; } r -= I_PS;
                    if (r < I_SP) { const int g = r & 3, ch = r >> 2; sg_item(lds, PROJ, MIX, wsp, bsp, ch * 128, 128, g); continue; } r -= I_SP;
                    if (r < I_SS) { const int g = r & 3, n = r >> 2; sg_item(lds, PROJ, MIX, wsp, bsp, MP + n * ST, ST, g); continue; } r -= I_SS;
                    const int tid = opaque_tid();
                    if (r < NB) { const int n = r; float* o = args.out + O_POOLP + (size_t)(l * NB + n) * 15 * 512;
                        for (int idx = tid; idx < 15 * 512; idx += 512) { const int i = idx >> 9, c = idx & 511; o[idx] = bf2f(PROJ[(size_t)(n * SEQ + SEQ - 15 + i) * NPJ + C_XP + c]); } }
                    else { const int n = r - NB; float* o = args.out + O_POOLS + (size_t)(l * SB + n) * 15 * 512; const float* hs = spool + (size_t)n * 15 * 512;
                        for (int idx = tid; idx < 15 * 512; idx += 512) { const int i = idx >> 9, c = idx & 511; o[idx] = i < 7 ? hs[(size_t)(8 + i) * 512 + c] : bf2f(PROJ[(size_t)(MP + n * ST + i - 7) * NPJ + C_XP + c]); } }
                }
#endif
            }
        }
        GRID_BAR();
#ifdef EXP_COPYGATES
        {   const int tid = opaque_tid();
            for (int row = vcu; row < M; row += G) for (int c = tid; c < 1024; c += 512) H[(size_t)row * D + c] = bf2f(PROJ[(size_t)row * NPJ + C_G + c]);
        }
        GRID_BAR();
#endif
#if PH & 64
        {
#ifdef EXP_PLAIN_BRANCH
            pg8::Gemm g{MIX, (const bf16*)(wl + W_BR), MIXW, MIXW}; pg8::Order S; S.init(M, D, MIXW, G, bx, 3);
            pg8::EpiPlain E{HN};
            pg8::gemm_phase<pg8::EpiPlain>(lds, g, S, E);
#else
            pg8::Gemm g{MIX, (const bf16*)(wl + W_BR), MIXW, MIXW}; pg8::Order S; S.init(M, D, MIXW, G, bx, 3);
            pg8::EpiBranch E{PROJ, HN};
            pg8::gemm_phase<pg8::EpiBranch>(lds, g, S, E);
#endif
        }
#endif
        GRID_BAR();
#if PH & 128
        {
            pg8::Gemm g{HN, (const bf16*)(wl + W_OUT), D, D}; pg8::Order S; S.init(M, D, D, G, bx, 1);
            pg8::EpiResid E{l == 0 ? xp_in : H, l == 0 ? xs_in : H + (size_t)MP * D, H};
            pg8::gemm_phase<pg8::EpiResid>(lds, g, S, E);
        }
#endif
        GRID_BAR();
#if PH & 256
        norm_phase<0>(lds, vcu, G, H, H + (size_t)MP * D, args.in[17] + l * D, HN, nullptr, nullptr, nullptr, nullptr, nullptr);
#endif
        GRID_BAR();
#if PH & 512
        {
            pg8::Gemm g{HN, (const bf16*)(wl + W_FF1), D, D}; pg8::Order S; S.init(M, FF, D, G, bx, 1);
            pg8::EpiRelu2 E{FFH};
            pg8::gemm_phase<pg8::EpiRelu2>(lds, g, S, E);
        }
#endif
        GRID_BAR();
#if PH & 1024
        {
            pg8::Gemm g{FFH, (const bf16*)(wl + W_FF2), FF, FF}; pg8::Order S; S.init(M, D, FF, G, bx, 1);
            pg8::EpiResid E{H, H + (size_t)MP * D, H};
            pg8::gemm_phase<pg8::EpiResid>(lds, g, S, E);
        }
#endif
        GRID_BAR();
    }
#if PH & 2048
    norm_phase<2>(lds, vcu, G, H, H + (size_t)MP * D, args.in[20], nullptr, nullptr, H, nullptr, nullptr, nullptr);
#endif
}

extern "C" void kernel_launch(void* const* d_in, const int* in_sizes, int n_in, void* d_out, int out_size, void* d_ws, size_t ws_size, hipStream_t stream) {
    static int grid = 0;
    if (grid == 0) {
        if (n_in != 21 || in_sizes[0] != MP * D || (size_t)out_size != O_END || ws_size < WS_END) {
            fprintf(stderr, "kernel_launch: unexpected shapes: n_in %d in0 %d out %d ws %zu (need %zu)\n", n_in, n_in > 0 ? in_sizes[0] : -1, out_size, ws_size, (size_t)WS_END); grid = -1; return; }
        int dev = 0, cus = 0, per_cu = 0;
        if (hipGetDevice(&dev) != hipSuccess || hipDeviceGetAttribute(&cus, hipDeviceAttributeMultiprocessorCount, dev) != hipSuccess) { grid = -1; return; }
        if (hipFuncSetAttribute((const void*)hybrid_fwd, hipFuncAttributeMaxDynamicSharedMemorySize, LDS_BYTES) != hipSuccess) { fprintf(stderr, "kernel_launch: hipFuncSetAttribute failed\n"); grid = -1; return; }
        if (hipOccupancyMaxActiveBlocksPerMultiprocessor(&per_cu, (const void*)hybrid_fwd, NWAVES * 64, LDS_BYTES) != hipSuccess || per_cu < 1) {
            fprintf(stderr, "kernel_launch: occupancy query reports %d blocks per CU\n", per_cu); (void)hipGetLastError(); grid = -1; return; }
        grid = cus;
    }
    if (grid < 0) return;
    if (hipMemsetAsync((char*)d_ws + WS_CTL, 0, CTL_ZERO_BYTES, stream) != hipSuccess) { fprintf(stderr, "kernel_launch: memset failed\n"); return; }
    Args a{};
    for (int i = 0; i < 21; ++i) a.in[i] = (const float*)d_in[i];
    a.out = (float*)d_out; a.ws = (unsigned char*)d_ws;
    void* kargs[] = {&a};
    hipError_t e = hipLaunchCooperativeKernel((const void*)hybrid_fwd, dim3(grid), dim3(NWAVES * 64), kargs, LDS_BYTES, stream);
    if (e != hipSuccess) fprintf(stderr, "kernel_launch: cooperative launch failed: %s (grid %d)\n", hipGetErrorString(e), grid);
}
```

```cpp
#include <hip/hip_runtime.h>
#include <hip/hip_cooperative_groups.h>
#include <cstdio>
#include <cstdint>

constexpr int D = 1024, NB = 8, SEQ = 2048, DEPTH = 2, SB = 128, ST = 8;
constexpr int MP = NB * SEQ;
constexpr int MS = SB * ST;
constexpr int M = MP + MS;
constexpr int IN_COLS = 7696;
constexpr int NPJ = 7680;
constexpr int FF = 4096;
constexpr float EPS = 1e-6f;
constexpr int C_Q = 0, C_K = 512, C_V = 1024, C_GO = 2048, C_XP = 3072, C_U = 3584, C_VV = 4096, C_G = 4608;
constexpr int MIXW = 2048;

constexpr size_t MiB = 1u << 20;
constexpr size_t WS_CTL = 0, CTL_ZERO_BYTES = 1 * MiB;
constexpr size_t WS_W = 2 * MiB;
constexpr size_t W_LAYER = 37 * MiB, W_IN = 0, W_BR = 15 * MiB, W_OUT = 19 * MiB, W_FF1 = 21 * MiB, W_FF2 = 29 * MiB;
constexpr size_t WS_HN = 76 * MiB;
constexpr size_t WS_GLOG = 110 * MiB;
constexpr size_t WS_MIX = 144 * MiB;
constexpr size_t WS_PROJ = 212 * MiB;
constexpr size_t WS_END = 468 * MiB;
static_assert(WS_PROJ + (size_t)M * NPJ * 2 <= WS_END, "ws map");
static_assert(WS_MIX + (size_t)M * MIXW * 2 <= WS_PROJ, "ws map");
static_assert(WS_GLOG + (size_t)M * 512 * 4 <= WS_MIX, "ws map");
static_assert(WS_HN + (size_t)M * D * 2 <= WS_GLOG, "ws map");
static_assert(WS_W + 2 * W_LAYER <= WS_HN, "ws map");
constexpr int CW_BAR = 4096;

constexpr size_t O_Y = 0;
constexpr size_t O_GLAP = (size_t)M * D;
constexpr size_t O_GLAS = O_GLAP + (size_t)DEPTH * NB * 4 * 128 * 256;
constexpr size_t O_POOLP = O_GLAS + (size_t)DEPTH * SB * 4 * 128 * 256;
constexpr size_t O_POOLS = O_POOLP + (size_t)DEPTH * NB * 15 * 512;
constexpr size_t O_SGV = O_POOLS + (size_t)DEPTH * SB * 15 * 512;
constexpr size_t O_END = O_SGV + (size_t)DEPTH * SB * ST * 512;
static_assert(O_END == 56614912, "output size");

constexpr int RING_BYTES = 131072;
constexpr int LDSCTL_OFF = RING_BYTES, MISC_OFF = LDSCTL_OFF + 320;
constexpr int LDS_BYTES = 147456;
constexpr int NWAVES = 8;

#define GAS __attribute__((address_space(1)))
#define LAS __attribute__((address_space(3)))
typedef unsigned short bf16;
typedef unsigned v4u __attribute__((ext_vector_type(4)));
typedef unsigned v2u __attribute__((ext_vector_type(2)));
typedef float f32x4 __attribute__((ext_vector_type(4)));
typedef short bf16x8 __attribute__((ext_vector_type(8)));
typedef GAS unsigned gu32;
#define RLX_AGENT __ATOMIC_RELAXED, __HIP_MEMORY_SCOPE_AGENT
#define LDS_WAIT() asm volatile("s_waitcnt lgkmcnt(0)" ::: "memory")

__device__ __forceinline__ unsigned f2bf(float f) { unsigned u = __builtin_bit_cast(unsigned, f); return (u + 0x7fffu + ((u >> 16) & 1u)) >> 16; }
__device__ __forceinline__ unsigned pk2(float lo, float hi) { return f2bf(lo) | (f2bf(hi) << 16); }
__device__ __forceinline__ float bf2f(unsigned short x) { return __builtin_bit_cast(float, (unsigned)x << 16); }
__device__ __forceinline__ float bflo(unsigned w) { return __builtin_bit_cast(float, w << 16); }
__device__ __forceinline__ float bfhi(unsigned w) { return __builtin_bit_cast(float, w & 0xffff0000u); }
__device__ __forceinline__ float sigmoid_f(float x) { return __builtin_amdgcn_rcpf(1.0f + __builtin_amdgcn_exp2f(-1.4426950409f * x)); }
__device__ __forceinline__ float gelu_tanh(float x) { const float z = 1.5957691216f * x * (1.0f + 0.044715f * x * x); return x * sigmoid_f(z); }
__device__ __forceinline__ int opaque_tid() { int t = threadIdx.x; asm volatile("" : "+v"(t)); return t; }
__device__ __forceinline__ float wave_sum(float v) {
#pragma unroll
    for (int o = 1; o < 64; o <<= 1) v += __shfl_xor(v, o);
    return v;
}

namespace pg8 {
#define PG8_LAS __attribute__((address_space(3)))
typedef unsigned short bf16_t;
typedef unsigned u32x4 __attribute__((ext_vector_type(4)));
constexpr int BM = 256, BK = 64, HALF = 128, HTB = HALF * BK * 2, STAGE_BYTES = 8 * HTB, NXCD = 8, WGM = 8;

__host__ __device__ __forceinline__ int lds_byte(int r, int c) { const int st = (r >> 4) * 2 + (c >> 5), rr = r & 15, cc = c & 31, ob = rr * 64 + cc * 2; return st * 1024 + (ob ^ (((ob >> 9) & 1) << 5)); }
__host__ __device__ __forceinline__ void stage_rc(int b, int& R, int& C) { const int st = b / 1024, sb = b % 1024, swz = sb ^ (((sb >> 9) & 1) << 5); R = (st >> 1) * 16 + swz / 64; C = (st & 1) * 32 + (swz % 64) / 2; }
__host__ __device__ __forceinline__ int perm32(int rho) { const int n = rho >> 4, i = rho & 15; return 8 * (i >> 2) + 4 * n + (i & 3); }

struct Unit { int pm, pn, k0, nt, sub, keep; };
struct Gemm { const bf16_t* A; const bf16_t* Bt; int lda, ldb; };

struct Order {
    int nM, nN, nwg, G, c, nsub, ntk;
    __device__ void init(int M_, int N_, int K_, int G_, int c_, int nsub_) { nM = M_ / BM; nN = N_ / BM; nwg = nM * nN; G = G_; c = c_; nsub = nsub_; ntk = K_ / BK; }
    __device__ bool next(int i, Unit& u) const {
        const int ti = i / nsub, sub = i - ti * nsub;
        const long L = (long)ti * G + c; if (L >= nwg) return false;
        int wgid = (int)L; { const int q = nwg / NXCD, r = nwg % NXCD, xcd = wgid % NXCD, off = wgid / NXCD; wgid = (xcd < r ? xcd * (q + 1) : r * (q + 1) + (xcd - r) * q) + off; }
        const int nig = WGM * nN, gid = wgid / nig, fm = gid * WGM, gsz = (nM - fm) < WGM ? (nM - fm) : WGM;
        u.pm = fm + ((wgid % nig) % gsz); u.pn = (wgid % nig) / gsz; u.sub = sub;
        if (nsub == 1) { u.k0 = 0; u.nt = ntk; u.keep = 0; }
        else { u.k0 = sub == 0 ? 0 : (sub == 1 ? 1024 : 1536); u.nt = sub == 0 ? 16 : 8; u.keep = sub < 2 ? 1 : 0; }
        return true;
    }
};

typedef __bf16 bf16x2_t __attribute__((ext_vector_type(2)));
typedef float f32x2_t __attribute__((ext_vector_type(2)));
__device__ __forceinline__ unsigned cvt_pk_bf16(float lo, float hi) { const f32x2_t v = {lo, hi}; const bf16x2_t b = __builtin_convertvector(v, bf16x2_t); return __builtin_bit_cast(unsigned, b); }

typedef f32x4 acc_t[2][2][4][2];

template <int ACT> __device__ __forceinline__ float act_f(float x) {
    if (ACT == 1) return x * 0.08838834764831845f;
    if (ACT == 2) return gelu_tanh(x);
    if (ACT == 3) return sigmoid_f(x);
    if (ACT == 4) { const float r = x > 0.f ? x : 0.f; return r * r; }
    return x;
}
template <int ACT> __device__ __forceinline__ void store_bf16_tile(const acc_t& acc, bf16_t* O, int ldc, int row0, int col0, float* sgv  , int sgcol0) {
#pragma unroll
    for (int ai = 0; ai < 2; ++ai)
#pragma unroll
        for (int m = 0; m < 4; ++m) { const int row = row0 + ai * HALF + m * 16; bf16_t* rowp = O + (size_t)row * ldc + col0;
#pragma unroll
            for (int bj = 0; bj < 2; ++bj) { f32x4 v0 = acc[ai][bj][m][0], v1 = acc[ai][bj][m][1];
#pragma unroll
                for (int j = 0; j < 4; ++j) { v0[j] = act_f<ACT>(v0[j]); v1[j] = act_f<ACT>(v1[j]); }
                u32x4 w; w.x = cvt_pk_bf16(v0[0], v0[1]); w.y = cvt_pk_bf16(v0[2], v0[3]); w.z = cvt_pk_bf16(v1[0], v1[1]); w.w = cvt_pk_bf16(v1[2], v1[3]);
                *(u32x4*)(rowp + bj * HALF) = w;
                if (ACT == 2 && sgv) { float* sp = sgv + (size_t)(row - MP) * 512 + sgcol0 + bj * HALF; *(f32x4*)sp = v0; *(f32x4*)(sp + 4) = v1; }
                if (ACT == 3 && sgv) { float* sp = sgv + (size_t)row * D + sgcol0 + bj * HALF; *(f32x4*)sp = v0; *(f32x4*)(sp + 4) = v1; } } }
}

struct EpiProj {
    static constexpr bool PERM = true;
    bf16_t* O; float* sgv; float* dbg;
    __device__ __forceinline__ void operator()(acc_t& acc, const Unit& u, int wr, int wc, int fr, int fq) const {
        const int row0 = u.pm * BM + wr * 64 + fr, col0 = u.pn * BM + wc * 32 + 8 * fq, pn = u.pn;
        if (pn < 2) store_bf16_tile<1>(acc, O, NPJ, row0, col0, nullptr, 0);
        else if (pn < 14) store_bf16_tile<0>(acc, O, NPJ, row0, col0, nullptr, 0);
        else if (pn < 18) store_bf16_tile<2>(acc, O, NPJ, row0, col0, (pn >= 16 && u.pm >= MP / BM) ? sgv : nullptr, col0 - C_VV);
#ifdef EXP_GATEOUT
        else store_bf16_tile<3>(acc, O, NPJ, row0, col0, (pn >= 26) ? dbg : nullptr, col0 - C_G - 2048);
#else
        else store_bf16_tile<3>(acc, O, NPJ, row0, col0, nullptr, 0);
#endif
    }
};
struct EpiPlain {
    static constexpr bool PERM = true;
    bf16_t* O;
    __device__ __forceinline__ void operator()(acc_t& acc, const Unit& u, int wr, int wc, int fr, int fq) const {
        if (u.keep) return;
        store_bf16_tile<0>(acc, O, D, u.pm * BM + wr * 64 + fr, u.pn * BM + wc * 32 + 8 * fq, nullptr, 0);
    }
};
struct EpiRelu2 {
    static constexpr bool PERM = true;
    bf16_t* O;
    __device__ __forceinline__ void operator()(acc_t& acc, const Unit& u, int wr, int wc, int fr, int fq) const {
        store_bf16_tile<4>(acc, O, FF, u.pm * BM + wr * 64 + fr, u.pn * BM + wc * 32 + 8 * fq, nullptr, 0);
    }
};
struct EpiBranch {
    static constexpr bool PERM = true;
    const bf16_t* P; bf16_t* O;
    __device__ __forceinline__ void operator()(acc_t& acc, const Unit& u, int wr, int wc, int fr, int fq) const {
        const int row0 = u.pm * BM + wr * 64 + fr, col0 = u.pn * BM + wc * 32 + 8 * fq, sub = u.sub;
#pragma unroll
        for (int ai = 0; ai < 2; ++ai)
#pragma unroll
            for (int m = 0; m < 4; ++m) { const int row = row0 + ai * HALF + m * 16; const bf16_t* gp = P + (size_t)row * NPJ + C_G + col0;
#pragma unroll
                for (int bj = 0; bj < 2; ++bj) {
#ifdef EXP_NOLOAD
                    const u32x4 g1 = (u32x4){0x3f003f00u, 0x3f003f00u, 0x3f003f00u, 0x3f003f00u};
#elif defined(EXP_SC1)
                    u32x4 g1; { const unsigned long long* q = (const unsigned long long*)(gp + sub * 1024 + bj * HALF);
                        const unsigned long long q0 = __hip_atomic_load(q, __ATOMIC_RELAXED, __HIP_MEMORY_SCOPE_SYSTEM), q1 = __hip_atomic_load(q + 1, __ATOMIC_RELAXED, __HIP_MEMORY_SCOPE_SYSTEM);
                        g1.x = (unsigned)q0; g1.y = (unsigned)(q0 >> 32); g1.z = (unsigned)q1; g1.w = (unsigned)(q1 >> 32); }
#elif defined(EXP_DEADLOAD)
                    const u32x4 g1_ = *(const u32x4*)(gp + sub * 1024 + bj * HALF);
#else
                    const u32x4 g1 = *(const u32x4*)(gp + sub * 1024 + bj * HALF);
#endif
#ifdef EXP_DEADLOAD
                    u32x4 g1 = g1_; asm volatile("" : "+v"(g1.x), "+v"(g1.y), "+v"(g1.z), "+v"(g1.w)); g1 = (u32x4){0x3f003f00u, 0x3f003f00u, 0x3f003f00u, 0x3f003f00u};
#endif
                    float f[8];
                    f[0] = bflo(g1.x); f[1] = bfhi(g1.x); f[2] = bflo(g1.y); f[3] = bfhi(g1.y); f[4] = bflo(g1.z); f[5] = bfhi(g1.z); f[6] = bflo(g1.w); f[7] = bfhi(g1.w);
#pragma unroll
                    for (int j = 0; j < 8; ++j) f[j] = f[j] > 1e-30f ? f[j] : 1e-30f;
#ifndef EXP_NODIV
                    if (sub < 2) {
                        const u32x4 g2 = *(const u32x4*)(gp + (sub + 1) * 1024 + bj * HALF);
                        float d[8];
                        d[0] = bflo(g2.x); d[1] = bfhi(g2.x); d[2] = bflo(g2.y); d[3] = bfhi(g2.y); d[4] = bflo(g2.z); d[5] = bfhi(g2.z); d[6] = bflo(g2.w); d[7] = bfhi(g2.w);
#pragma unroll
                        for (int j = 0; j < 8; ++j) { d[j] = d[j] > 1e-30f ? d[j] : 1e-30f; f[j] = f[j] / d[j]; }
                    }
#endif
                    f32x4 v0 = acc[ai][bj][m][0], v1 = acc[ai][bj][m][1];
#pragma unroll
                    for (int j = 0; j < 4; ++j) { v0[j] *= f[j]; v1[j] *= f[4 + j]; }
                    acc[ai][bj][m][0] = v0; acc[ai][bj][m][1] = v1;
                    if (sub == 2) { u32x4 w; w.x = cvt_pk_bf16(v0[0], v0[1]); w.y = cvt_pk_bf16(v0[2], v0[3]); w.z = cvt_pk_bf16(v1[0], v1[1]); w.w = cvt_pk_bf16(v1[2], v1[3]);
                        *(u32x4*)(O + (size_t)row * D + col0 + bj * HALF) = w; }
                }
                asm volatile("" ::: "memory"); }
    }
};
struct EpiResid {
    static constexpr bool PERM = false;
    const float* bp; const float* bs; float* out;
    __device__ __forceinline__ void operator()(acc_t& acc, const Unit& u, int wr, int wc, int fr, int fq) const {
        const int row0 = u.pm * BM + wr * 64 + fr, col0 = u.pn * BM + wc * 32 + 4 * fq;
        const bool smp = u.pm >= MP / BM;
#pragma unroll
        for (int ai = 0; ai < 2; ++ai)
#pragma unroll
            for (int m = 0; m < 4; ++m) { const int row = row0 + ai * HALF + m * 16;
                const float* b = smp ? bs + (size_t)(row - MP) * D + col0 : bp + (size_t)row * D + col0; float* o = out + (size_t)row * D + col0;
#pragma unroll
                for (int bj = 0; bj < 2; ++bj)
#pragma unroll
                    for (int n = 0; n < 2; ++n) { const f32x4 bv = *(const f32x4*)(b + bj * HALF + n * 16); *(f32x4*)(o + bj * HALF + n * 16) = bv + acc[ai][bj][m][n]; }
                if (m & 1) asm volatile("" ::: "memory"); }
    }
};

template <class Epi>
__device__ __forceinline__ void gemm_phase(PG8_LAS unsigned char* lds, const Gemm g, const Order& S, const Epi& E) {
    int tid_ = threadIdx.x; asm volatile("" : "+v"(tid_));
    const int tid = tid_, wid = __builtin_amdgcn_readfirstlane(tid >> 6), lane = tid & 63, wr = wid >> 2, wc = wid & 3, fr = lane & 15, fq = lane >> 4;
    unsigned voffA[2], voffB[2];
#pragma unroll
    for (int i = 0; i < 2; ++i) { int R, C; stage_rc(tid * 16 + i * 8192, R, C); const int Rb = Epi::PERM ? ((R & ~31) + perm32(R & 31)) : R;
        voffA[i] = (unsigned)(R * g.lda + C) * 2u; voffB[i] = (unsigned)(Rb * g.ldb + C) * 2u; }
    const size_t kstep = (size_t)(BK * 2);
    const size_t hstepA = (size_t)HALF * g.lda * 2, hstepB = (size_t)HALF * g.ldb * 2;
    const size_t tstepA = 2 * hstepA, tstepB = 2 * hstepB;
    const unsigned ldsw = (unsigned)wid * 1024u;
    const int aoff = lds_byte(wr * 64 + fr, fq * 8), boff = lds_byte(wc * 32 + fr, fq * 8);
#define PG8_SA(b, h) (((b) * 2 + (h)) * HTB)
#define PG8_SB(b, h) ((4 + (b) * 2 + (h)) * HTB)
#define PG8_STAGE(bufoff, gbase, voff) do { _Pragma("unroll") for (int _i = 0; _i < 2; ++_i) \
        __builtin_amdgcn_global_load_lds((const unsigned*)((const char*)(gbase) + (voff)[_i]), (PG8_LAS unsigned*)(lds + (bufoff) + ldsw + _i * 8192), 16, 0, 0); } while (0)
#define PG8_LDA(dst, b, h) do { _Pragma("unroll") for (int m = 0; m < 4; ++m) _Pragma("unroll") for (int k = 0; k < 2; ++k) dst[m][k] = *(const PG8_LAS bf16x8*)(lds + PG8_SA(b, h) + aoff + m * 2048 + k * 1024); } while (0)
#define PG8_LDB(dst, b, h) do { _Pragma("unroll") for (int n = 0; n < 2; ++n) _Pragma("unroll") for (int k = 0; k < 2; ++k) dst[n][k] = *(const PG8_LAS bf16x8*)(lds + PG8_SB(b, h) + boff + n * 2048 + k * 1024); } while (0)
#define PG8_MMA(ai, bj, At, Bt) do { __builtin_amdgcn_s_setprio(1); _Pragma("unroll") for (int m = 0; m < 4; ++m) _Pragma("unroll") for (int n = 0; n < 2; ++n) _Pragma("unroll") for (int k = 0; k < 2; ++k) \
        acc[ai][bj][m][n] = __builtin_amdgcn_mfma_f32_16x16x32_bf16(Bt[n][k], At[m][k], acc[ai][bj][m][n], 0, 0, 0); __builtin_amdgcn_s_setprio(0); } while (0)
#define PG8_WAIT_V(n) asm volatile("s_waitcnt vmcnt(" #n ")" ::: "memory")
#define PG8_WAIT_L(n) asm volatile("s_waitcnt lgkmcnt(" #n ")" ::: "memory")
#define PG8_BAR __builtin_amdgcn_s_barrier()
#define PG8_SCHED __builtin_amdgcn_sched_barrier(0)
    Unit cur, nxt; int ui = 0;
    if (!S.next(0, cur)) return;
    f32x4 acc[2][2][4][2];
#pragma unroll
    for (int a = 0; a < 2; ++a)
#pragma unroll
        for (int b = 0; b < 2; ++b)
#pragma unroll
            for (int m = 0; m < 4; ++m)
#pragma unroll
                for (int n = 0; n < 2; ++n) acc[a][b][m][n] = (f32x4){0.f, 0.f, 0.f, 0.f};
    bf16x8 At[4][2], B0[2][2], B1[2][2];
    const char* cA = (const char*)g.A + (size_t)cur.pm * tstepA + (size_t)cur.k0 * 2; const char* cB = (const char*)g.Bt + (size_t)cur.pn * tstepB + (size_t)cur.k0 * 2;
    PG8_STAGE(PG8_SB(0, 0), cB, voffB); PG8_STAGE(PG8_SB(0, 1), cB + hstepB, voffB); PG8_STAGE(PG8_SA(0, 0), cA, voffA); PG8_STAGE(PG8_SA(0, 1), cA + hstepA, voffA);
    if (wr == 1) PG8_BAR;
    PG8_WAIT_V(2); PG8_BAR;
    PG8_STAGE(PG8_SB(1, 0), cB + kstep, voffB); PG8_STAGE(PG8_SA(1, 0), cA + kstep, voffA); PG8_STAGE(PG8_SB(1, 1), cB + hstepB + kstep, voffB);
    PG8_WAIT_V(6); PG8_BAR;
    for (;;) {
        const bool has_next = S.next(ui + 1, nxt);
        const char* nA = has_next ? (const char*)g.A + (size_t)nxt.pm * tstepA + (size_t)nxt.k0 * 2 : cA; const char* nB = has_next ? (const char*)g.Bt + (size_t)nxt.pn * tstepB + (size_t)nxt.k0 * 2 : cB;
        const int nt = cur.nt;
        for (int t = 0; t < nt; t += 2) {
            const bool last = (t == nt - 2);
            const char* a1 = cA + (size_t)(t + 1) * kstep;
            const char* a2 = last ? nA : cA + (size_t)(t + 2) * kstep; const char* b2 = last ? nB : cB + (size_t)(t + 2) * kstep;
            const char* a3 = a2 + kstep; const char* b3 = b2 + kstep;
            PG8_LDB(B0, 0, 0); PG8_LDB(B1, 0, 1); PG8_SCHED; PG8_LDA(At, 0, 0); PG8_STAGE(PG8_SA(1, 1), a1 + hstepA, voffA);
            PG8_WAIT_V(8); PG8_WAIT_L(0); PG8_BAR; PG8_MMA(0, 0, At, B0); PG8_MMA(0, 1, At, B1); PG8_BAR; PG8_SCHED;
            PG8_LDA(At, 0, 1); PG8_STAGE(PG8_SB(0, 0), b2, voffB); PG8_STAGE(PG8_SB(0, 1), b2 + hstepB, voffB); PG8_STAGE(PG8_SA(0, 0), a2, voffA);
            PG8_WAIT_V(8); PG8_WAIT_L(0); PG8_BAR; PG8_MMA(1, 0, At, B0); PG8_MMA(1, 1, At, B1); PG8_BAR; PG8_SCHED;
            PG8_LDB(B0, 1, 0); PG8_LDB(B1, 1, 1); PG8_SCHED; PG8_LDA(At, 1, 0); PG8_STAGE(PG8_SA(0, 1), a2 + hstepA, voffA);
            PG8_WAIT_V(8); PG8_WAIT_L(0); PG8_BAR; PG8_MMA(0, 0, At, B0); PG8_MMA(0, 1, At, B1); PG8_BAR; PG8_SCHED;
            PG8_LDA(At, 1, 1); PG8_STAGE(PG8_SB(1, 0), b3, voffB); PG8_STAGE(PG8_SB(1, 1), b3 + hstepB, voffB); PG8_STAGE(PG8_SA(1, 0), a3, voffA);
            PG8_WAIT_V(8); PG8_WAIT_L(0); PG8_BAR; PG8_MMA(1, 0, At, B0); PG8_MMA(1, 1, At, B1); PG8_BAR; PG8_SCHED;
        }
        if (wr == 0) PG8_BAR;
        E(acc, cur, wr, wc, fr, fq);
        if (!has_next) break;
        if (!cur.keep) {
#pragma unroll
            for (int a = 0; a < 2; ++a)
#pragma unroll
                for (int b = 0; b < 2; ++b)
#pragma unroll
                    for (int m = 0; m < 4; ++m)
#pragma unroll
                        for (int n = 0; n < 2; ++n) acc[a][b][m][n] = (f32x4){0.f, 0.f, 0.f, 0.f};
        }
        cur = nxt; cA = nA; cB = nB; ++ui;
        if (wr == 1) PG8_BAR;
    }
    PG8_WAIT_V(0);
    PG8_BAR;
#undef PG8_SA
#undef PG8_SB
#undef PG8_STAGE
#undef PG8_LDA
#undef PG8_LDB
#undef PG8_MMA
#undef PG8_WAIT_V
#undef PG8_WAIT_L
#undef PG8_BAR
#undef PG8_SCHED
}
}

#define XB_TMO      128
#define XB_XCNT(j)  (256  + 64 * (j))
#define XB_XSUB(j)  (1280 + 64 * (j))
#define XB_XGEN(j)  (2304 + 64 * (j))
#define XB_TOP      3328
#define XB_TOPGEN   3392
#define XCD_BAR_WORDS 3456
#define XB_SPIN_CAP (1u << 20)

__device__ __forceinline__ unsigned xb_ld(unsigned* p)              { return __hip_atomic_load(p, __ATOMIC_RELAXED, __HIP_MEMORY_SCOPE_AGENT); }
__device__ __forceinline__ unsigned xb_add(unsigned* p, unsigned v) { return __hip_atomic_fetch_add(p, v, __ATOMIC_RELAXED, __HIP_MEMORY_SCOPE_AGENT); }
__device__ __forceinline__ unsigned xb_xcc_id() { return (unsigned)__builtin_amdgcn_s_getreg((3 << 11) | 20) & 0xFu; }
#define XB_SPIN(cond, bar) do { unsigned _sp = 0; while (cond) { __builtin_amdgcn_s_sleep(1); \
    if ((++_sp & 255u) == 0u) { if (xb_ld(&(bar)[XB_TMO])) break; if (_sp > XB_SPIN_CAP) { atomicAdd(&(bar)[XB_TMO], 1u); break; } } } } while (0)

struct XcdBarrier { unsigned* bar; unsigned x; volatile LAS unsigned* st; };

__device__ __forceinline__ XcdBarrier xcd_barrier_post(unsigned* bar, volatile LAS unsigned* st) {
    XcdBarrier b; b.bar = bar; b.x = xb_xcc_id(); b.st = st;
    if (threadIdx.x == 0) (void)xb_add(&bar[XB_XCNT(b.x)], 1u);
    return b;
}
__device__ __forceinline__ void xcd_barrier_complete(unsigned* bar, unsigned x, unsigned& nloc, unsigned& nx) {
    const unsigned G = gridDim.x * gridDim.y * gridDim.z;
    unsigned sum, cnt, mine, sp = 0u;
    for (;;) {
        sum = 0u; cnt = 0u; mine = 0u;
#pragma unroll
        for (unsigned j = 0; j < 16; ++j) { const unsigned c = xb_ld(&bar[XB_XCNT(j)]); sum += c; cnt += (c > 0u) ? 1u : 0u; mine = (j == x) ? c : mine; }
        if (sum == G) break;
        __builtin_amdgcn_s_sleep(1);
        if ((++sp & 255u) == 0u) { if (xb_ld(&bar[XB_TMO])) break; if (sp > XB_SPIN_CAP) { atomicAdd(&bar[XB_TMO], 1u); break; } }
    }
    nloc = mine > 0u ? mine : 1u; nx = cnt > 0u ? cnt : 1u;
}
__device__ __forceinline__ void xcd_barrier(const XcdBarrier& b) {
    asm volatile("s_waitcnt vmcnt(0)" ::: "memory");
    __syncthreads();
    if (threadIdx.x == 0) {
        unsigned* bar = b.bar;
        __builtin_amdgcn_s_waitcnt(0);
        unsigned nloc = b.st[0], nx = b.st[1];
        if (nloc == 0u) { xcd_barrier_complete(bar, b.x, nloc, nx); b.st[0] = nloc; b.st[1] = nx; }
        const unsigned old = xb_add(&bar[XB_XSUB(b.x)], 1u);
        const unsigned gen = old / nloc;
        if (old + 1u == (gen + 1u) * nloc) {
            __builtin_amdgcn_fence(__ATOMIC_RELEASE, "agent");
            asm volatile("s_waitcnt vmcnt(0)" ::: "memory");
            const unsigned og = xb_add(&bar[XB_TOP], 1u);
            const unsigned tg = og / nx;
            if (og + 1u == (tg + 1u) * nx) xb_add(&bar[XB_TOPGEN], 1u);
            else XB_SPIN(xb_ld(&bar[XB_TOPGEN]) == tg, bar);
            __builtin_amdgcn_fence(__ATOMIC_ACQUIRE, "agent");
            xb_add(&bar[XB_XGEN(b.x)], 1u);
            asm volatile("s_waitcnt vmcnt(0)" ::: "memory");
        } else {
            XB_SPIN(xb_ld(&bar[XB_XGEN(b.x)]) == gen, bar);
            __builtin_amdgcn_fence(__ATOMIC_ACQUIRE, "agent");
            asm volatile("s_waitcnt vmcnt(0)" ::: "memory");
        }
    }
    __syncthreads();
}

struct Args {
    const float* in[21];
    float* out; unsigned char* ws;
};

__device__ __forceinline__ void transpose_item(const float* W, int ldw, int ncols, bf16* WT, int ldd, int row_off, int col_off, LAS float* scr, int item, int lane) {
    const int nblk = ncols / 32, kb = item / nblk, nb = item % nblk, k0 = 64 * kb, n0 = 32 * nb;
#pragma unroll 8
    for (int i = 0; i < 32; ++i) { const int kk = 2 * i + (lane >> 5); scr[kk * 33 + (lane & 31)] = W[(size_t)(k0 + kk) * ldw + n0 + (lane & 31)]; }
    LDS_WAIT(); asm volatile("" ::: "memory");
    const int c = lane & 7;
#pragma unroll
    for (int j = 0; j < 4; ++j) { const int n = (lane >> 3) + 8 * j; const LAS float* s = scr + (8 * c) * 33 + n;
        v4u o; o.x = pk2(s[0 * 33], s[1 * 33]); o.y = pk2(s[2 * 33], s[3 * 33]); o.z = pk2(s[4 * 33], s[5 * 33]); o.w = pk2(s[6 * 33], s[7 * 33]);
        *(GAS v4u*)(WT + (size_t)(row_off + n0 + n) * ldd + col_off + k0 + 8 * c) = o; }
    LDS_WAIT(); asm volatile("" ::: "memory");
}

__device__ __forceinline__ void convert_weights(const Args& a, LAS unsigned char* lds, int vcu, int G) {
    const int tid = opaque_tid(), lane = tid & 63, wave = __builtin_amdgcn_readfirstlane(tid >> 6), gw = vcu * NWAVES + wave, NGW = G * NWAVES;
    LAS float* scr = (LAS float*)(lds + wave * 16384);
    constexpr int I_IN1 = 16 * 96, I_IN2 = 16 * 144, I_BA = 16 * 32, I_BB = 8 * 32, I_BC = 8 * 32, I_O = 16 * 32, I_F1 = 16 * 128, I_F2 = 64 * 32;
    constexpr int PER_LAYER = I_IN1 + I_IN2 + I_BA + I_BB + I_BC + I_O + I_F1 + I_F2;
    for (int it = gw; it < 2 * PER_LAYER; it += NGW) {
        const int l = it / PER_LAYER; int r = it - l * PER_LAYER;
        unsigned char* wl = a.ws + WS_W + (size_t)l * W_LAYER;
        const float* w_in = a.in[5] + (size_t)l * D * IN_COLS;
        if (r < I_IN1) { transpose_item(w_in, IN_COLS, 3072, (bf16*)(wl + W_IN), D, 0, 0, scr, r, lane); continue; } r -= I_IN1;
        if (r < I_IN2) { transpose_item(w_in + 3088, IN_COLS, 4608, (bf16*)(wl + W_IN), D, 3072, 0, scr, r, lane); continue; } r -= I_IN2;
        if (r < I_BA) { transpose_item(a.in[13] + (size_t)l * 1024 * 1024, 1024, 1024, (bf16*)(wl + W_BR), 2048, 0, 0, scr, r, lane); continue; } r -= I_BA;
        if (r < I_BB) { transpose_item(a.in[14] + (size_t)l * 512 * 1024, 1024, 1024, (bf16*)(wl + W_BR), 2048, 0, 1024, scr, r, lane); continue; } r -= I_BB;
        if (r < I_BC) { transpose_item(a.in[15] + (size_t)l * 512 * 1024, 1024, 1024, (bf16*)(wl + W_BR), 2048, 0, 1536, scr, r, lane); continue; } r -= I_BC;
        if (r < I_O) { transpose_item(a.in[16] + (size_t)l * 1024 * 1024, 1024, 1024, (bf16*)(wl + W_OUT), 1024, 0, 0, scr, r, lane); continue; } r -= I_O;
        if (r < I_F1) { transpose_item(a.in[18] + (size_t)l * 1024 * FF, FF, FF, (bf16*)(wl + W_FF1), 1024, 0, 0, scr, r, lane); continue; } r -= I_F1;
        transpose_item(a.in[19] + (size_t)l * FF * 1024, 1024, 1024, (bf16*)(wl + W_FF2), FF, 0, 0, scr, r, lane);
    }
}

template <int MODE>
__device__ __forceinline__ void norm_phase(LAS unsigned char* lds, int vcu, int G,
                                           const float* hp, const float* hs, const float* w, bf16* HN, float* GLOG, float* outf,
                                           const float* w_in_l, const float* w_gk2_l, const float* b_gk_l) {
    const int tid = opaque_tid(), lane = tid & 63, wave = __builtin_amdgcn_readfirstlane(tid >> 6), gw = vcu * NWAVES + wave, NGW = G * NWAVES;
    LAS float* Wg = (LAS float*)lds;
    LAS float* Wk = Wg + 16 * 1024;
    if (MODE == 1) {
        for (int idx = tid; idx < 16 * 1024; idx += 512) { const int k = idx >> 4, c = idx & 15; Wg[c * 1024 + k] = w_in_l[(size_t)k * IN_COLS + 3072 + c]; }
        for (int idx = tid; idx < 16 * 512; idx += 512) Wk[idx] = w_gk2_l[idx];
        __syncthreads();
    }
    f32x4 wv[4];
#pragma unroll
    for (int j = 0; j < 4; ++j) wv[j] = *(const f32x4*)(w + 4 * lane + 256 * j);
    for (int m = gw; m < M; m += NGW) {
        const float* xr = (m < MP) ? hp + (size_t)m * D : hs + (size_t)(m - MP) * D;
        f32x4 v[4]; float ss = 0.f;
#pragma unroll
        for (int j = 0; j < 4; ++j) { v[j] = *(const f32x4*)(xr + 4 * lane + 256 * j); ss += (v[j].x * v[j].x + v[j].y * v[j].y) + (v[j].z * v[j].z + v[j].w * v[j].w); }
        const float r = 1.0f / sqrtf(wave_sum(ss) * (1.0f / D) + EPS);
#pragma unroll
        for (int j = 0; j < 4; ++j) v[j] = v[j] * r * wv[j];
        if (MODE == 2) {
#pragma unroll
            for (int j = 0; j < 4; ++j) *(f32x4*)(outf + (size_t)m * D + 4 * lane + 256 * j) = v[j];
        } else {
#pragma unroll
            for (int j = 0; j < 4; ++j) { v2u o; o.x = pk2(v[j].x, v[j].y); o.y = pk2(v[j].z, v[j].w); *(v2u*)(HN + (size_t)m * D + 4 * lane + 256 * j) = o; }
        }
        if (MODE == 1) {
            float gl[16];
#pragma unroll
            for (int c = 0; c < 16; ++c) { float p = 0.f;
#pragma unroll
                for (int j = 0; j < 4; ++j) { const f32x4 wg = *(const LAS f32x4*)(Wg + c * 1024 + 4 * lane + 256 * j); p += (v[j].x * wg.x + v[j].y * wg.y) + (v[j].z * wg.z + v[j].w * wg.w); }
                gl[c] = wave_sum(p); if ((c & 3) == 3) asm volatile("" ::: "memory"); }
#pragma unroll
            for (int hb = 0; hb < 2; ++hb) { const int d0 = 4 * lane + 256 * hb;
                f32x4 acc = *(const f32x4*)(b_gk_l + d0);
#pragma unroll
                for (int c = 0; c < 16; ++c) { const f32x4 wk = *(const LAS f32x4*)(Wk + c * 512 + d0); acc = acc + wk * gl[c]; }
                f32x4 o;
#pragma unroll
                for (int i = 0; i < 4; ++i) { const float x = acc[i]; const float ls = (x < 0.f ? x : 0.f) - log1pf(__expf(-fabsf(x))); o[i] = ls * (1.0f / 16.0f); }
                *(f32x4*)(GLOG + (size_t)m * 512 + d0) = o; }
        }
    }
    if (MODE == 1) __syncthreads();
}

__device__ __forceinline__ void gla_seq(LAS unsigned char* lds, const bf16* PROJ, const float* GLOG, bf16* MIXOUT, const float* gn,
                                        int row0, int T, int h, const float* S0, float* Sout) {
    const int tid = opaque_tid(), lane = tid & 63, wave = __builtin_amdgcn_readfirstlane(tid >> 6);
    LAS float* qs = (LAS float*)lds;
    LAS float* ks = qs + 16 * 128;
    LAS float* as = ks + 16 * 128;
    LAS float* op = as + 16 * 128;
    const int e = tid & 255, dh = __builtin_amdgcn_readfirstlane(tid >> 8);
    float S[64];
#pragma unroll
    for (int i = 0; i < 64; ++i) S[i] = S0 ? S0[(size_t)(dh * 64 + i) * 256 + e] : 0.f;
    const int TB = T < 16 ? T : 16;
    for (int t0 = 0; t0 < T; t0 += TB) {
        __syncthreads();
        for (int idx = tid; idx < TB * 128; idx += 512) { const int t = idx >> 7, d = idx & 127; const size_t row = (size_t)(row0 + t0 + t);
            qs[idx] = bf2f(PROJ[row * NPJ + C_Q + h * 128 + d]); ks[idx] = bf2f(PROJ[row * NPJ + C_K + h * 128 + d]); as[idx] = __expf(GLOG[row * 512 + h * 128 + d]); }
        __syncthreads();
        for (int t = 0; t < TB; ++t) {
            const float v = bf2f(PROJ[(size_t)(row0 + t0 + t) * NPJ + C_V + h * 256 + e]);
            const LAS float* qp = qs + t * 128 + dh * 64; const LAS float* kp = ks + t * 128 + dh * 64; const LAS float* ap = as + t * 128 + dh * 64;
            float o = 0.f;
#pragma unroll
            for (int i4 = 0; i4 < 16; ++i4) { const f32x4 q4 = *(const LAS f32x4*)(qp + 4 * i4), k4 = *(const LAS f32x4*)(kp + 4 * i4), a4 = *(const LAS f32x4*)(ap + 4 * i4);
#pragma unroll
                for (int j = 0; j < 4; ++j) { const int i = 4 * i4 + j; S[i] = a4[j] * S[i] + k4[j] * v; o += q4[j] * S[i]; } }
            op[(t * 2 + dh) * 256 + e] = o;
        }
        __syncthreads();
#pragma unroll
        for (int tt = 0; tt < 2; ++tt) { const int t = wave * 2 + tt;
            if (t < TB) { const int e4 = lane * 4; const size_t row = (size_t)(row0 + t0 + t);
                const f32x4 o = *(const LAS f32x4*)(op + (t * 2) * 256 + e4) + *(const LAS f32x4*)(op + (t * 2 + 1) * 256 + e4);
                const float ss = wave_sum((o.x * o.x + o.y * o.y) + (o.z * o.z + o.w * o.w));
                const float r = 1.0f / sqrtf(ss * (1.0f / 256.0f) + EPS);
                const v2u gw2 = *(const v2u*)(PROJ + row * NPJ + C_GO + h * 256 + e4);
                const f32x4 g4 = *(const f32x4*)(gn + e4);
                const float g0 = bflo(gw2.x), g1 = bfhi(gw2.x), g2 = bflo(gw2.y), g3 = bfhi(gw2.y);
                v2u ow; ow.x = pk2(o.x * r * g4.x * (g0 * sigmoid_f(g0)), o.y * r * g4.y * (g1 * sigmoid_f(g1))); ow.y = pk2(o.z * r * g4.z * (g2 * sigmoid_f(g2)), o.w * r * g4.w * (g3 * sigmoid_f(g3)));
                *(v2u*)(MIXOUT + row * MIXW + h * 256 + e4) = ow; } }
    }
#pragma unroll
    for (int i = 0; i < 64; ++i) Sout[(size_t)(dh * 64 + i) * 256 + e] = S[i];
    __syncthreads();
}

typedef float f32x16 __attribute__((ext_vector_type(16)));
typedef short s16x4 __attribute__((ext_vector_type(4)));
#define MFMA32(a, b, c) __builtin_amdgcn_mfma_f32_32x32x16_bf16((a), (b), (c), 0, 0, 0)
constexpr int GL_QG = 0, GL_KG = 17408, GL_KD = 34816, GL_VV = 55296, GL_PP = 92160, GL_DEC = 101376, GL_TOT = 101888, GL_END = 110080;
constexpr int GL_SQ = 272, GL_SKD = 320, GL_SV = 576, GL_SP = 144, GL_SO = 1040;
static_assert(GL_END <= RING_BYTES && 64 * GL_SO <= GL_PP, "gla lds map");
__device__ __forceinline__ bf16x8 tr_frag(LAS unsigned char* p, int rowstride4) {
    const s16x4 lo = __builtin_amdgcn_ds_read_tr16_b64_v4i16((LAS s16x4*)p), hi = __builtin_amdgcn_ds_read_tr16_b64_v4i16((LAS s16x4*)(p + rowstride4));
    return __builtin_shufflevector(lo, hi, 0, 1, 2, 3, 4, 5, 6, 7);
}
__device__ __forceinline__ void gla_chunked(LAS unsigned char* lds, const bf16* PROJ, const float* GLOG, bf16* MIXOUT, const float* gn, int row0, int nchunks, int h, float* Sout) {
    const int tid = opaque_tid(), lane = tid & 63, w = __builtin_amdgcn_readfirstlane(tid >> 6), r = lane & 31, hh = lane >> 5;
    const int tq = (lane & 15) >> 2, tp = lane & 3, tblk = (lane >> 4) & 1;
    const int dq = tid & 31, seg = tid >> 5;
    f32x16 S[4];
#pragma unroll
    for (int b = 0; b < 4; ++b)
#pragma unroll
        for (int i = 0; i < 16; ++i) S[b][i] = 0.f;
    for (int c = 0; c < nchunks; ++c) {
        const int r0 = row0 + 64 * c;
        {
            f32x4 cs[4];
#pragma unroll
            for (int i = 0; i < 4; ++i) { cs[i] = *(const f32x4*)(GLOG + (size_t)(r0 + 4 * seg + i) * 512 + h * 128 + 4 * dq); if (i) cs[i] = cs[i] + cs[i - 1]; }
            *(LAS f32x4*)(lds + GL_TOT + (seg * 128 + 4 * dq) * 4) = cs[3];
            v2u qv[4], kv[4];
#pragma unroll
            for (int i = 0; i < 4; ++i) { const bf16* pr = PROJ + (size_t)(r0 + 4 * seg + i) * NPJ + h * 128 + 4 * dq; qv[i] = *(const v2u*)(pr + C_Q); kv[i] = *(const v2u*)(pr + C_K); }
            v4u vv[4];
#pragma unroll
            for (int i = 0; i < 4; ++i) { const int idx = tid + 512 * i, sr = idx >> 5, ch = idx & 31; vv[i] = *(const v4u*)(PROJ + (size_t)(r0 + sr) * NPJ + C_V + h * 256 + ch * 8); }
            __syncthreads();
            f32x4 pre = (f32x4){0.f, 0.f, 0.f, 0.f}, tot = (f32x4){0.f, 0.f, 0.f, 0.f};
#pragma unroll
            for (int s2 = 0; s2 < 16; ++s2) { const f32x4 tv = *(const LAS f32x4*)(lds + GL_TOT + (s2 * 128 + 4 * dq) * 4); tot = tot + tv; if (s2 < seg) pre = pre + tv; }
#pragma unroll
            for (int i = 0; i < 4; ++i) { const f32x4 b = pre + cs[i]; const int t = 4 * seg + i;
                float q4[4] = {bflo(qv[i].x), bfhi(qv[i].x), bflo(qv[i].y), bfhi(qv[i].y)}, k4[4] = {bflo(kv[i].x), bfhi(kv[i].x), bflo(kv[i].y), bfhi(kv[i].y)};
                float qg[4], kg[4], kd[4];
#pragma unroll
                for (int j = 0; j < 4; ++j) { qg[j] = q4[j] * __expf(b[j]); kg[j] = k4[j] * __expf(-b[j]); kd[j] = k4[j] * __expf(tot[j] - b[j]); }
                v2u o; o.x = pg8::cvt_pk_bf16(qg[0], qg[1]); o.y = pg8::cvt_pk_bf16(qg[2], qg[3]); *(LAS v2u*)(lds + GL_QG + t * GL_SQ + dq * 8) = o;
                o.x = pg8::cvt_pk_bf16(kg[0], kg[1]); o.y = pg8::cvt_pk_bf16(kg[2], kg[3]); *(LAS v2u*)(lds + GL_KG + t * GL_SQ + dq * 8) = o;
                o.x = pg8::cvt_pk_bf16(kd[0], kd[1]); o.y = pg8::cvt_pk_bf16(kd[2], kd[3]); *(LAS v2u*)(lds + GL_KD + t * GL_SKD + dq * 8) = o; }
            if (seg == 0) { f32x4 dc; dc.x = __expf(tot.x); dc.y = __expf(tot.y); dc.z = __expf(tot.z); dc.w = __expf(tot.w); *(LAS f32x4*)(lds + GL_DEC + dq * 16) = dc; }
#pragma unroll
            for (int i = 0; i < 4; ++i) { const int idx = tid + 512 * i, sr = idx >> 5, ch = idx & 31; *(LAS v4u*)(lds + GL_VV + sr * GL_SV + ch * 16) = vv[i]; }
        }
        __syncthreads();
        if (w < 3) {
            const int bi = w > 0 ? 1 : 0, bj = w > 1 ? 1 : 0;
            f32x16 acc;
#pragma unroll
            for (int i = 0; i < 16; ++i) acc[i] = 0.f;
#pragma unroll
            for (int ks = 0; ks < 8; ++ks) {
                const bf16x8 a = *(const LAS bf16x8*)(lds + GL_QG + (32 * bi + r) * GL_SQ + (16 * ks + 8 * hh) * 2);
                const bf16x8 b = *(const LAS bf16x8*)(lds + GL_KG + (32 * bj + r) * GL_SQ + (16 * ks + 8 * hh) * 2);
                acc = MFMA32(a, b, acc); }
#pragma unroll
            for (int i = 0; i < 16; ++i) { const int tl = (i & 3) + 8 * (i >> 2) + 4 * hh; float v = acc[i]; if (bi == bj && r > tl) v = 0.f;
                *(LAS unsigned short*)(lds + GL_PP + (32 * bi + tl) * GL_SP + (32 * bj + r) * 2) = (unsigned short)f2bf(v); }
        }
        __syncthreads();
        f32x16 o[2];
        {
            bf16x8 Bv[4];
#pragma unroll
            for (int ks = 0; ks < 4; ++ks) Bv[ks] = tr_frag(lds + GL_VV + (16 * ks + 8 * hh + tq) * GL_SV + (4 * w + 2 * tblk + (tp >> 1)) * 16 + 8 * (tp & 1), 4 * GL_SV);
#pragma unroll
            for (int rb = 0; rb < 2; ++rb) {
#pragma unroll
                for (int i = 0; i < 16; ++i) o[rb][i] = 0.f;
#pragma unroll
                for (int b = 0; b < 4; ++b)
#pragma unroll
                    for (int s2 = 0; s2 < 2; ++s2) {
                        const LAS unsigned char* ap = lds + GL_QG + (32 * rb + r) * GL_SQ + (32 * b + 16 * s2 + 4 * hh) * 2;
                        const s16x4 lo = *(const LAS s16x4*)ap, hi = *(const LAS s16x4*)(ap + 16);
                        const bf16x8 a = __builtin_shufflevector(lo, hi, 0, 1, 2, 3, 4, 5, 6, 7);
                        v4u pk; pk.x = pg8::cvt_pk_bf16(S[b][8 * s2 + 0], S[b][8 * s2 + 1]); pk.y = pg8::cvt_pk_bf16(S[b][8 * s2 + 2], S[b][8 * s2 + 3]);
                        pk.z = pg8::cvt_pk_bf16(S[b][8 * s2 + 4], S[b][8 * s2 + 5]); pk.w = pg8::cvt_pk_bf16(S[b][8 * s2 + 6], S[b][8 * s2 + 7]);
                        o[rb] = MFMA32(a, __builtin_bit_cast(bf16x8, pk), o[rb]); }
#pragma unroll
                for (int ks = 0; ks < 4; ++ks) if (ks < 2 || rb == 1) {
                    const bf16x8 a = *(const LAS bf16x8*)(lds + GL_PP + (32 * rb + r) * GL_SP + (16 * ks + 8 * hh) * 2);
                    o[rb] = MFMA32(a, Bv[ks], o[rb]); }
            }
#pragma unroll
            for (int b = 0; b < 4; ++b) {
#pragma unroll
                for (int g4 = 0; g4 < 4; ++g4) { const f32x4 dc = *(const LAS f32x4*)(lds + GL_DEC + (32 * b + 8 * g4 + 4 * hh) * 4);
#pragma unroll
                    for (int j = 0; j < 4; ++j) S[b][4 * g4 + j] *= dc[j]; }
#pragma unroll
                for (int ks = 0; ks < 4; ++ks) {
                    const bf16x8 a = tr_frag(lds + GL_KD + (16 * ks + 8 * hh + tq) * GL_SKD + (4 * b + 2 * tblk + (tp >> 1)) * 16 + 8 * (tp & 1), 4 * GL_SKD);
                    S[b] = MFMA32(a, Bv[ks], S[b]); }
            }
        }
        __syncthreads();
#pragma unroll
        for (int rb = 0; rb < 2; ++rb)
#pragma unroll
            for (int i = 0; i < 16; ++i) *(LAS float*)(lds + (32 * rb + (i & 3) + 8 * (i >> 2) + 4 * hh) * GL_SO + (32 * w + r) * 4) = o[rb][i];
        __syncthreads();
        {
            const int t = tid >> 3, sg = tid & 7, e0 = sg * 32; const size_t row = (size_t)(r0 + t);
            f32x4 ov[8]; float ss = 0.f;
#pragma unroll
            for (int i = 0; i < 8; ++i) { ov[i] = *(const LAS f32x4*)(lds + t * GL_SO + (e0 + 4 * i) * 4); ss += (ov[i].x * ov[i].x + ov[i].y * ov[i].y) + (ov[i].z * ov[i].z + ov[i].w * ov[i].w); }
            ss += __shfl_xor(ss, 1); ss += __shfl_xor(ss, 2); ss += __shfl_xor(ss, 4);
            const float rn = 1.0f / sqrtf(ss * (1.0f / 256.0f) + EPS);
#pragma unroll
            for (int i = 0; i < 4; ++i) { const v4u gw4 = *(const v4u*)(PROJ + row * NPJ + C_GO + h * 256 + e0 + 8 * i);
                const f32x4 ga = *(const f32x4*)(gn + e0 + 8 * i), gb = *(const f32x4*)(gn + e0 + 8 * i + 4);
                const float g0 = bflo(gw4.x), g1 = bfhi(gw4.x), g2 = bflo(gw4.y), g3 = bfhi(gw4.y), g4 = bflo(gw4.z), g5 = bfhi(gw4.z), g6 = bflo(gw4.w), g7 = bfhi(gw4.w);
                const f32x4 oa = ov[2 * i], ob = ov[2 * i + 1]; v4u ow;
                ow.x = pg8::cvt_pk_bf16(oa.x * rn * ga.x * (g0 * sigmoid_f(g0)), oa.y * rn * ga.y * (g1 * sigmoid_f(g1)));
                ow.y = pg8::cvt_pk_bf16(oa.z * rn * ga.z * (g2 * sigmoid_f(g2)), oa.w * rn * ga.w * (g3 * sigmoid_f(g3)));
                ow.z = pg8::cvt_pk_bf16(ob.x * rn * gb.x * (g4 * sigmoid_f(g4)), ob.y * rn * gb.y * (g5 * sigmoid_f(g5)));
                ow.w = pg8::cvt_pk_bf16(ob.z * rn * gb.z * (g6 * sigmoid_f(g6)), ob.w * rn * gb.w * (g7 * sigmoid_f(g7)));
                *(v4u*)(MIXOUT + row * MIXW + h * 256 + e0 + 8 * i) = ow; }
        }
        __syncthreads();
    }
#pragma unroll
    for (int b = 0; b < 4; ++b)
#pragma unroll
        for (int i = 0; i < 16; ++i) Sout[(size_t)(32 * b + (i & 3) + 8 * (i >> 2) + 4 * hh) * 256 + 32 * w + r] = S[b][i];
}

__device__ __forceinline__ void gla_sample(LAS unsigned char* lds, const bf16* PROJ, const float* GLOG, bf16* MIXOUT, const float* gn, int r0, int h, const float* S0, float* Sout) {
    const int tid = opaque_tid(), lane = tid & 63, w = __builtin_amdgcn_readfirstlane(tid >> 6), r = lane & 31, hh = lane >> 5;
    const int tq = (lane & 15) >> 2, tp = lane & 3, tblk = (lane >> 4) & 1;
    if (tid < 32) {
        const int dq = tid; f32x4 b = (f32x4){0.f, 0.f, 0.f, 0.f}, bs[8];
#pragma unroll
        for (int t = 0; t < 8; ++t) { b = b + *(const f32x4*)(GLOG + (size_t)(r0 + t) * 512 + h * 128 + 4 * dq); bs[t] = b; }
#pragma unroll
        for (int t = 0; t < 8; ++t) { const bf16* pr = PROJ + (size_t)(r0 + t) * NPJ + h * 128 + 4 * dq; const v2u qv = *(const v2u*)(pr + C_Q), kv = *(const v2u*)(pr + C_K);
            const float q4[4] = {bflo(qv.x), bfhi(qv.x), bflo(qv.y), bfhi(qv.y)}, k4[4] = {bflo(kv.x), bfhi(kv.x), bflo(kv.y), bfhi(kv.y)};
            float qg[4], kg[4], kd[4];
#pragma unroll
            for (int j = 0; j < 4; ++j) { qg[j] = q4[j] * __expf(bs[t][j]); kg[j] = k4[j] * __expf(-bs[t][j]); kd[j] = k4[j] * __expf(b[j] - bs[t][j]); }
            v2u o; o.x = pg8::cvt_pk_bf16(qg[0], qg[1]); o.y = pg8::cvt_pk_bf16(qg[2], qg[3]); *(LAS v2u*)(lds + GL_QG + t * GL_SQ + dq * 8) = o;
            o.x = pg8::cvt_pk_bf16(kg[0], kg[1]); o.y = pg8::cvt_pk_bf16(kg[2], kg[3]); *(LAS v2u*)(lds + GL_KG + t * GL_SQ + dq * 8) = o;
            o.x = pg8::cvt_pk_bf16(kd[0], kd[1]); o.y = pg8::cvt_pk_bf16(kd[2], kd[3]); *(LAS v2u*)(lds + GL_KD + t * GL_SKD + dq * 8) = o; }
        f32x4 dc; dc.x = __expf(b.x); dc.y = __expf(b.y); dc.z = __expf(b.z); dc.w = __expf(b.w); *(LAS f32x4*)(lds + GL_DEC + dq * 16) = dc;
    } else if (tid >= 256) {
        const int idx = tid - 256, sr = idx >> 5, ch = idx & 31;
        *(LAS v4u*)(lds + GL_VV + sr * GL_SV + ch * 16) = *(const v4u*)(PROJ + (size_t)(r0 + sr) * NPJ + C_V + h * 256 + ch * 8);
    } else if (tid >= 64) {
        const v4u z = (v4u){0u, 0u, 0u, 0u};
        for (int idx = tid - 64; idx < 256 + 128; idx += 192) {
            if (idx < 256) *(LAS v4u*)(lds + GL_VV + (8 + (idx >> 5)) * GL_SV + (idx & 31) * 16) = z;
            else { const int k2 = idx - 256; *(LAS v4u*)(lds + GL_KD + (8 + (k2 >> 4)) * GL_SKD + (k2 & 15) * 16) = z; } }
    }
    asm volatile("" ::: "memory");
    int lane_off = 4 * hh * 256 + 32 * w + r; asm volatile("" : "+v"(lane_off));
    const float* s0p = S0 + lane_off; float* sop = Sout + lane_off;
    f32x16 S[4];
#pragma unroll
    for (int b = 0; b < 4; ++b) {
#pragma unroll
        for (int i = 0; i < 16; ++i) S[b][i] = s0p[(32 * b + (i & 3) + 8 * (i >> 2)) * 256];
        asm volatile("" ::: "memory"); }
    __syncthreads();
    if (w == 0) {
        f32x16 acc;
#pragma unroll
        for (int i = 0; i < 16; ++i) acc[i] = 0.f;
#pragma unroll
        for (int ks = 0; ks < 8; ++ks) {
            const bf16x8 a = *(const LAS bf16x8*)(lds + GL_QG + r * GL_SQ + (16 * ks + 8 * hh) * 2);
            const bf16x8 b = *(const LAS bf16x8*)(lds + GL_KG + r * GL_SQ + (16 * ks + 8 * hh) * 2);
            acc = MFMA32(a, b, acc); }
#pragma unroll
        for (int i = 0; i < 16; ++i) { const int tl = (i & 3) + 8 * (i >> 2) + 4 * hh; float v = acc[i]; if (r > tl || tl >= 8) v = 0.f;
            if (r < 16) *(LAS unsigned short*)(lds + GL_PP + tl * GL_SP + r * 2) = (unsigned short)f2bf(v); }
    }
    __syncthreads();
    f32x16 o;
    {
        const bf16x8 Bv = tr_frag(lds + GL_VV + (8 * hh + tq) * GL_SV + (4 * w + 2 * tblk + (tp >> 1)) * 16 + 8 * (tp & 1), 4 * GL_SV);
#pragma unroll
        for (int i = 0; i < 16; ++i) o[i] = 0.f;
#pragma unroll
        for (int b = 0; b < 4; ++b)
#pragma unroll
            for (int s2 = 0; s2 < 2; ++s2) {
                const LAS unsigned char* ap = lds + GL_QG + r * GL_SQ + (32 * b + 16 * s2 + 4 * hh) * 2;
                const s16x4 lo = *(const LAS s16x4*)ap, hi = *(const LAS s16x4*)(ap + 16);
                const bf16x8 a = __builtin_shufflevector(lo, hi, 0, 1, 2, 3, 4, 5, 6, 7);
                v4u pk; pk.x = pg8::cvt_pk_bf16(S[b][8 * s2 + 0], S[b][8 * s2 + 1]); pk.y = pg8::cvt_pk_bf16(S[b][8 * s2 + 2], S[b][8 * s2 + 3]);
                pk.z = pg8::cvt_pk_bf16(S[b][8 * s2 + 4], S[b][8 * s2 + 5]); pk.w = pg8::cvt_pk_bf16(S[b][8 * s2 + 6], S[b][8 * s2 + 7]);
                o = MFMA32(a, __builtin_bit_cast(bf16x8, pk), o); }
        { const bf16x8 a = *(const LAS bf16x8*)(lds + GL_PP + r * GL_SP + (8 * hh) * 2); o = MFMA32(a, Bv, o); }
#pragma unroll
        for (int b = 0; b < 4; ++b) {
#pragma unroll
            for (int g4 = 0; g4 < 4; ++g4) { const f32x4 dc = *(const LAS f32x4*)(lds + GL_DEC + (32 * b + 8 * g4 + 4 * hh) * 4);
#pragma unroll
                for (int j = 0; j < 4; ++j) S[b][4 * g4 + j] *= dc[j]; }
            const bf16x8 a = tr_frag(lds + GL_KD + (8 * hh + tq) * GL_SKD + (4 * b + 2 * tblk + (tp >> 1)) * 16 + 8 * (tp & 1), 4 * GL_SKD);
            S[b] = MFMA32(a, Bv, S[b]); }
    }
    __syncthreads();
#pragma unroll
    for (int i = 0; i < 4; ++i) *(LAS float*)(lds + (i + 4 * hh) * GL_SO + (32 * w + r) * 4) = o[i];
    __syncthreads();
    if (tid < 64) {
        const int t = tid >> 3, sg = tid & 7, e0 = sg * 32; const size_t row = (size_t)(r0 + t);
        f32x4 ov[8]; float ss = 0.f;
#pragma unroll
        for (int i = 0; i < 8; ++i) { ov[i] = *(const LAS f32x4*)(lds + t * GL_SO + (e0 + 4 * i) * 4); ss += (ov[i].x * ov[i].x + ov[i].y * ov[i].y) + (ov[i].z * ov[i].z + ov[i].w * ov[i].w); }
        ss += __shfl_xor(ss, 1); ss += __shfl_xor(ss, 2); ss += __shfl_xor(ss, 4);
        const float rn = 1.0f / sqrtf(ss * (1.0f / 256.0f) + EPS);
#pragma unroll
        for (int i = 0; i < 4; ++i) { const v4u gw4 = *(const v4u*)(PROJ + row * NPJ + C_GO + h * 256 + e0 + 8 * i);
            const f32x4 ga = *(const f32x4*)(gn + e0 + 8 * i), gb = *(const f32x4*)(gn + e0 + 8 * i + 4);
            const float g0 = bflo(gw4.x), g1 = bfhi(gw4.x), g2 = bflo(gw4.y), g3 = bfhi(gw4.y), g4 = bflo(gw4.z), g5 = bfhi(gw4.z), g6 = bflo(gw4.w), g7 = bfhi(gw4.w);
            const f32x4 oa = ov[2 * i], ob = ov[2 * i + 1]; v4u ow;
            ow.x = pg8::cvt_pk_bf16(oa.x * rn * ga.x * (g0 * sigmoid_f(g0)), oa.y * rn * ga.y * (g1 * sigmoid_f(g1)));
            ow.y = pg8::cvt_pk_bf16(oa.z * rn * ga.z * (g2 * sigmoid_f(g2)), oa.w * rn * ga.w * (g3 * sigmoid_f(g3)));
            ow.z = pg8::cvt_pk_bf16(ob.x * rn * gb.x * (g4 * sigmoid_f(g4)), ob.y * rn * gb.y * (g5 * sigmoid_f(g5)));
            ow.w = pg8::cvt_pk_bf16(ob.z * rn * gb.z * (g6 * sigmoid_f(g6)), ob.w * rn * gb.w * (g7 * sigmoid_f(g7)));
            *(v4u*)(MIXOUT + row * MIXW + h * 256 + e0 + 8 * i) = ow; }
    }
#pragma unroll
    for (int b = 0; b < 4; ++b) {
#pragma unroll
        for (int i = 0; i < 16; ++i) sop[(32 * b + (i & 3) + 8 * (i >> 2)) * 256] = S[b][i];
        asm volatile("" ::: "memory"); }
    __syncthreads();
}

constexpr int PL_W = 0, PL_A = 40960, PL_SW = 320, PL_SA = 272;
__device__ __forceinline__ void mat128_to_lds(LAS unsigned char* lds, int off, int stride, const float* src, bool tril) {
    const int tid = opaque_tid();
#pragma unroll
    for (int i = 0; i < 8; ++i) { const int idx = tid + 512 * i, row = idx >> 5, c4 = idx & 31; f32x4 v = *(const f32x4*)(src + row * 128 + 4 * c4);
        if (tril) { if (4 * c4 + 0 > row) v.x = 0.f; if (4 * c4 + 1 > row) v.y = 0.f; if (4 * c4 + 2 > row) v.z = 0.f; if (4 * c4 + 3 > row) v.w = 0.f; }
        v2u o; o.x = pg8::cvt_pk_bf16(v.x, v.y); o.y = pg8::cvt_pk_bf16(v.z, v.w); *(LAS v2u*)(lds + off + row * stride + c4 * 8) = o; }
}
template <int G>
__device__ __forceinline__ void pool_tile(LAS unsigned char* lds, const bf16* PROJ, bf16* MIXOUT, const float* scale_g, const float* hist_l, int row0, int pos0, bool sample, int seq0) {
    const int tid = opaque_tid(), lane = tid & 63, w = __builtin_amdgcn_readfirstlane(tid >> 6), r = lane & 31, hh = lane >> 5;
    const int tq = (lane & 15) >> 2, tp = lane & 3, tblk = (lane >> 4) & 1;
    const int c = tid & 127, tqr = tid >> 7, col = C_XP + G * 128 + c;
    constexpr int WIN = 2 << G;
    if (!sample) {
        float P[32]; P[0] = 0.f; float xs[31];
#pragma unroll
        for (int i = 0; i < 31; ++i) { const int p = pos0 + 16 * tqr - 15 + i; xs[i] = p >= 0 ? bf2f(PROJ[(size_t)(row0 - pos0 + p) * NPJ + col]) : 0.f; P[i + 1] = P[i] + xs[i]; }
#pragma unroll
        for (int tt = 0; tt < 16; ++tt) { const int pos = pos0 + 16 * tqr + tt; const int cnt = WIN < pos + 1 ? WIN : pos + 1;
            const float pooled = (P[16 + tt] - P[16 + tt - WIN]) / (float)cnt - xs[15 + tt];
            *(LAS unsigned short*)(lds + PL_A + (16 * tqr + tt) * PL_SA + c * 2) = (unsigned short)f2bf(pooled); }
    } else {
#pragma unroll
        for (int sq = 0; sq < 2; ++sq) { const int seq = seq0 + 2 * tqr + sq;
            float P[24]; P[0] = 0.f; float xs[23];
#pragma unroll
            for (int i = 0; i < 23; ++i) { xs[i] = i < 15 ? hist_l[((size_t)seq * 15 + i) * 512 + G * 128 + c] : bf2f(PROJ[(size_t)(MP + seq * ST + i - 15) * NPJ + col]); P[i + 1] = P[i] + xs[i]; }
#pragma unroll
            for (int tt = 0; tt < 8; ++tt) { const float pooled = (P[16 + tt] - P[16 + tt - WIN]) * (1.0f / (float)WIN) - xs[15 + tt];
                *(LAS unsigned short*)(lds + PL_A + (16 * tqr + 8 * sq + tt) * PL_SA + c * 2) = (unsigned short)f2bf(pooled); } }
    }
    __syncthreads();
    {
        const int rb = w & 1, cb = w >> 1; f32x16 acc;
#pragma unroll
        for (int i = 0; i < 16; ++i) acc[i] = 0.f;
#pragma unroll
        for (int ks = 0; ks < 8; ++ks) {
            const bf16x8 a = *(const LAS bf16x8*)(lds + PL_A + (32 * rb + r) * PL_SA + (16 * ks + 8 * hh) * 2);
            const bf16x8 b = tr_frag(lds + PL_W + (16 * ks + 8 * hh + tq) * PL_SW + (4 * cb + 2 * tblk + (tp >> 1)) * 16 + 8 * (tp & 1), 4 * PL_SW);
            acc = MFMA32(a, b, acc); }
        const float sc = scale_g[32 * cb + r];
#pragma unroll
        for (int i = 0; i < 16; ++i) { const int t = 32 * rb + (i & 3) + 8 * (i >> 2) + 4 * hh;
            MIXOUT[(size_t)(row0 + t) * MIXW + 1024 + G * 128 + 32 * cb + r] = (bf16)f2bf(acc[i] * sc); }
    }
    __syncthreads();
}
constexpr int SG_WT = 0, SG_VI = 34816, SG_SW = 272, SG_SV = 320;
__device__ __forceinline__ void sg_chunk(LAS unsigned char* lds, const bf16* PROJ, bf16* MIXOUT, const float* bs_g, int row0, int g) {
    const int tid = opaque_tid(), lane = tid & 63, w = __builtin_amdgcn_readfirstlane(tid >> 6), r = lane & 31, hh = lane >> 5;
    const int tq = (lane & 15) >> 2, tp = lane & 3, tblk = (lane >> 4) & 1;
#pragma unroll
    for (int i = 0; i < 4; ++i) { const int idx = tid + 512 * i, sr = idx >> 4, ch = idx & 15;
        *(LAS v4u*)(lds + SG_VI + sr * SG_SV + ch * 16) = *(const v4u*)(PROJ + (size_t)(row0 + sr) * NPJ + C_VV + g * 128 + ch * 8); }
    __syncthreads();
    const int dj = w & 3, pair = w >> 2;
#pragma unroll
    for (int pass = 0; pass < 2; ++pass) {
        const int bi = pass == 0 ? pair : 3 - pair, nks = 2 * (bi + 1);
        f32x16 acc;
#pragma unroll
        for (int i = 0; i < 16; ++i) acc[i] = 0.f;
#pragma unroll
        for (int ks = 0; ks < 8; ++ks) if (ks < nks) {
            const bf16x8 a = *(const LAS bf16x8*)(lds + SG_WT + (32 * bi + r) * SG_SW + (16 * ks + 8 * hh) * 2);
            const bf16x8 b = tr_frag(lds + SG_VI + (16 * ks + 8 * hh + tq) * SG_SV + (4 * dj + 2 * tblk + (tp >> 1)) * 16 + 8 * (tp & 1), 4 * SG_SV);
            acc = MFMA32(a, b, acc); }
#pragma unroll
        for (int i = 0; i < 16; ++i) { const int t = 32 * bi + (i & 3) + 8 * (i >> 2) + 4 * hh, d = 32 * dj + r;
            const float u = bf2f(PROJ[(size_t)(row0 + t) * NPJ + C_U + g * 128 + d]);
            MIXOUT[(size_t)(row0 + t) * MIXW + 1536 + g * 128 + d] = (bf16)f2bf(u * (acc[i] + bs_g[t])); }
    }
    __syncthreads();
}

__device__ __forceinline__ void pool_item(LAS unsigned char* lds, const bf16* PROJ, bf16* MIXOUT, const float* wmix, const float* scale, const float* hist  ,
                                          int rowseq0, int tpos0, int nt, int g) {
    const int tid = opaque_tid();
    LAS float* pl = (LAS float*)lds;
    const int w = 2 << g;
    for (int idx = tid; idx < nt * 128; idx += 512) { const int t = idx >> 7, c = idx & 127, pos = tpos0 + t, col = C_XP + g * 128 + c;
        float sum = 0.f;
        for (int i = 0; i < w; ++i) { const int p = pos - i;
            if (p >= 0) sum += bf2f(PROJ[(size_t)(rowseq0 + p) * NPJ + col]);
            else if (hist) sum += hist[(size_t)(15 + p) * 512 + g * 128 + c]; }
        const int cnt = hist ? w : (w < pos + 1 ? w : pos + 1);
        pl[idx] = sum / (float)cnt - bf2f(PROJ[(size_t)(rowseq0 + pos) * NPJ + col]); }
    __syncthreads();
    const int j = tid & 127, tq = __builtin_amdgcn_readfirstlane(tid >> 7), tpq = nt >> 2;
    float acc[4] = {0.f, 0.f, 0.f, 0.f};
    for (int c = 0; c < 128; ++c) { const float wv = wmix[(size_t)(g * 128 + c) * 128 + j];
#pragma unroll
        for (int i = 0; i < 4; ++i) if (i < tpq) acc[i] += pl[(tq * tpq + i) * 128 + c] * wv; }
    const float sc = scale[g * 128 + j];
#pragma unroll
    for (int i = 0; i < 4; ++i) if (i < tpq) MIXOUT[(size_t)(rowseq0 + tpos0 + tq * tpq + i) * MIXW + 1024 + g * 128 + j] = (bf16)f2bf(acc[i] * sc);
    __syncthreads();
}

__device__ __forceinline__ void sg_item(LAS unsigned char* lds, const bf16* PROJ, bf16* MIXOUT, const float* ws, const float* bs, int row0, int L, int g) {
    const int tid = opaque_tid();
    LAS float* vt = (LAS float*)lds;
    LAS float* wt = vt + 128 * 128;
    for (int idx = tid; idx < L * 128; idx += 512) { const int s = idx >> 7, d = idx & 127;
        vt[idx] = bf2f(PROJ[(size_t)(row0 + s) * NPJ + C_VV + g * 128 + d]);
        wt[idx] = ws[(size_t)(g * 128 + s) * 128 + d]; }
    __syncthreads();
    const int d = tid & 127, tq = __builtin_amdgcn_readfirstlane(tid >> 7);
    for (int t = tq; t < L; t += 4) { float acc = 0.f;
        for (int s = 0; s <= t; ++s) acc += wt[t * 128 + s] * vt[s * 128 + d];
        const float u = bf2f(PROJ[(size_t)(row0 + t) * NPJ + C_U + g * 128 + d]);
        MIXOUT[(size_t)(row0 + t) * MIXW + 1536 + g * 128 + d] = (bf16)f2bf(u * (acc + bs[g * 128 + t])); }
    __syncthreads();
}


#ifndef PH
#define PH 0xFFFF
#endif
#ifndef REP_GLAP
#define REP_GLAP 1
#endif
#ifndef REP_LIGHT
#define REP_LIGHT 1
#endif
#ifndef REP_PROJ
#define REP_PROJ 1
#endif
#ifndef REP_MIX
#define REP_MIX 1
#endif
#ifndef REP_BRANCH
#define REP_BRANCH 1
#endif
#ifndef REP_NORM2
#define REP_NORM2 1
#endif
#ifndef REP_FFN1
#define REP_FFN1 1
#endif
__global__ void __launch_bounds__(NWAVES * 64, 2) hybrid_fwd(Args args) {
    extern __shared__ __attribute__((aligned(16))) unsigned char lds_raw[];
    LAS unsigned char* lds = (LAS unsigned char*)lds_raw;
    volatile LAS unsigned* MISC = (volatile LAS unsigned*)(lds + MISC_OFF);
    const int G = gridDim.x, bx = blockIdx.x, vcu = (G % 8 == 0) ? (bx % 8) * (G / 8) + bx / 8 : bx;
    unsigned char* ws = args.ws;
    gu32* ctl = (gu32*)(ws + WS_CTL);
    for (int u = threadIdx.x; u < (LDS_BYTES - LDSCTL_OFF) / 4; u += NWAVES * 64) ((LAS unsigned*)(lds + LDSCTL_OFF))[u] = 0u;
    __syncthreads();
    XcdBarrier bar = xcd_barrier_post((unsigned*)(ctl + CW_BAR), MISC + 8);
#ifdef USE_CG
#define GRID_BAR() cooperative_groups::this_grid().sync()
#else
#define GRID_BAR() xcd_barrier(bar)
#endif

    bf16* HN = (bf16*)(ws + WS_HN);
    float* GLOG = (float*)(ws + WS_GLOG);
    bf16* MIX = (bf16*)(ws + WS_MIX);
    bf16* PROJ = (bf16*)(ws + WS_PROJ);
    bf16* FFH = (bf16*)(ws + WS_PROJ);
    float* H = args.out + O_Y;
    const float* xp_in = args.in[0]; const float* xs_in = args.in[1];

#if PH & 1
    convert_weights(args, lds, vcu, G);
    __syncthreads();
#endif
#if PH & 2
    norm_phase<1>(lds, vcu, G, xp_in, xs_in, args.in[4], HN, GLOG, nullptr, args.in[5], args.in[6], args.in[7]);
#endif
    GRID_BAR();

#ifdef EXP_ONELAYER
    for (int l = 0; l < 1; ++l) {
#else
    for (int l = 0; l < DEPTH; ++l) {
#endif
        unsigned char* wl = ws + WS_W + (size_t)l * W_LAYER;
#if PH & 4
        if (l > 0) {
            norm_phase<1>(lds, vcu, G, H, H + (size_t)MP * D, args.in[4] + l * D, HN, GLOG, nullptr, args.in[5] + (size_t)l * D * IN_COLS, args.in[6] + l * 16 * 512, args.in[7] + l * 512);
            GRID_BAR();
        }
#endif
        for (int rep_ = 0; rep_ < REP_PROJ; ++rep_) {
#if PH & 8
        {
            pg8::Gemm g{HN, (const bf16*)(wl + W_IN), D, D}; pg8::Order S; S.init(M, NPJ, D, G, bx, 1);
            pg8::EpiProj E{PROJ, args.out + O_SGV + (size_t)l * MS * 512, H};
            pg8::gemm_phase<pg8::EpiProj>(lds, g, S, E);
        }
#endif
        GRID_BAR();
        }
        for (int rep_ = 0; rep_ < REP_MIX; ++rep_) {
        {
            const float* gn = args.in[8] + l * 256;
            if (vcu < 32) {
#if PH & 16
                const int n = vcu >> 2, h = vcu & 3;
                for (int rg_ = 0; rg_ < REP_GLAP; ++rg_)
                gla_chunked(lds, PROJ, GLOG, MIX, gn, n * SEQ, SEQ / 64, h, args.out + O_GLAP + ((size_t)(l * NB + n) * 4 + h) * 128 * 256);
#endif
            } else {
#if PH & 32
                const float* wmix = args.in[9] + (size_t)l * 4 * 128 * 128; const float* pscale = args.in[10] + l * 512;
                const float* wsp = args.in[11] + (size_t)l * 4 * 128 * 128; const float* bsp = args.in[12] + l * 4 * 128;
                const float* spool = args.in[3] + (size_t)l * SB * 15 * 512;
                for (int rl_ = 0; rl_ < REP_LIGHT; ++rl_) {
                const int j = vcu - 32, NJ = G - 32, g = j & 3, jj = j >> 2, NJJ = NJ >> 2;
                for (int it = j; it < SB * 4; it += NJ) { const int n = it >> 2, h = it & 3; const size_t so = ((size_t)(l * SB + n) * 4 + h) * 128 * 256;
#ifndef SKIP_GS
                    gla_sample(lds, PROJ, GLOG, MIX, gn, MP + n * ST, h, args.in[2] + so, args.out + O_GLAS + so); }
#else
 }
#endif
                mat128_to_lds(lds, PL_W, PL_SW, wmix + (size_t)g * 128 * 128, false);
                for (int tile = jj; tile < 256 + 16; tile += NJJ) {
                    const bool smp = tile >= 256; const int st = tile - 256;
                    const int row0 = smp ? MP + st * 64 : (tile >> 5) * SEQ + (tile & 31) * 64, pos0 = smp ? 0 : (tile & 31) * 64;
#ifndef SKIP_PL
                    if (g == 0) pool_tile<0>(lds, PROJ, MIX, pscale, spool, row0, pos0, smp, st * 8);
                    else if (g == 1) pool_tile<1>(lds, PROJ, MIX, pscale + 128, spool, row0, pos0, smp, st * 8);
                    else if (g == 2) pool_tile<2>(lds, PROJ, MIX, pscale + 256, spool, row0, pos0, smp, st * 8);
                    else pool_tile<3>(lds, PROJ, MIX, pscale + 384, spool, row0, pos0, smp, st * 8);
#endif
                }
                mat128_to_lds(lds, SG_WT, SG_SW, wsp + (size_t)g * 128 * 128, true);
#ifndef SKIP_SG
                for (int ch = jj; ch < 128; ch += NJJ) sg_chunk(lds, PROJ, MIX, bsp + g * 128, ch * 128, g);
#endif
                for (int it = j; it < 512 + 136; it += NJ) {
                    int r = it;
                    if (r < 512) { const int g2 = r & 3, n = r >> 2; sg_item(lds, PROJ, MIX, wsp, bsp, MP + n * ST, ST, g2); continue; } r -= 512;
                    const int tid = opaque_tid();
                    if (r < NB) { const int n = r; float* o = args.out + O_POOLP + (size_t)(l * NB + n) * 15 * 512;
                        for (int idx = tid; idx < 15 * 512; idx += 512) { const int i = idx >> 9, c = idx & 511; o[idx] = bf2f(PROJ[(size_t)(n * SEQ + SEQ - 15 + i) * NPJ + C_XP + c]); } }
                    else { const int n = r - NB; float* o = args.out + O_POOLS + (size_t)(l * SB + n) * 15 * 512; const float* hs = spool + (size_t)n * 15 * 512;
                        for (int idx = tid; idx < 15 * 512; idx += 512) { const int i = idx >> 9, c = idx & 511; o[idx] = i < 7 ? hs[(size_t)(8 + i) * 512 + c] : bf2f(PROJ[(size_t)(MP + n * ST + i - 7) * NPJ + C_XP + c]); } }
                }
                }
#endif
            }
        }
        GRID_BAR();
        }
#ifdef EXP_COPYGATES
        {   const int tid = opaque_tid();
            for (int row = vcu; row < M; row += G) for (int c = tid; c < 1024; c += 512) H[(size_t)row * D + c] = bf2f(PROJ[(size_t)row * NPJ + C_G + c]);
        }
        GRID_BAR();
#endif
        for (int rep_ = 0; rep_ < REP_BRANCH; ++rep_) {
#if PH & 64
        {
#ifdef EXP_PLAIN_BRANCH
            pg8::Gemm g{MIX, (const bf16*)(wl + W_BR), MIXW, MIXW}; pg8::Order S; S.init(M, D, MIXW, G, bx, 3);
            pg8::EpiPlain E{HN};
            pg8::gemm_phase<pg8::EpiPlain>(lds, g, S, E);
#else
            pg8::Gemm g{MIX, (const bf16*)(wl + W_BR), MIXW, MIXW}; pg8::Order S; S.init(M, D, MIXW, G, bx, 3);
            pg8::EpiBranch E{PROJ, HN};
            pg8::gemm_phase<pg8::EpiBranch>(lds, g, S, E);
#endif
        }
#endif
        GRID_BAR();
        }
#if PH & 128
        {
            pg8::Gemm g{HN, (const bf16*)(wl + W_OUT), D, D}; pg8::Order S; S.init(M, D, D, G, bx, 1);
            pg8::EpiResid E{l == 0 ? xp_in : H, l == 0 ? xs_in : H + (size_t)MP * D, H};
            pg8::gemm_phase<pg8::EpiResid>(lds, g, S, E);
        }
#endif
        GRID_BAR();
        for (int rep_ = 0; rep_ < REP_NORM2; ++rep_) {
#if PH & 256
        norm_phase<0>(lds, vcu, G, H, H + (size_t)MP * D, args.in[17] + l * D, HN, nullptr, nullptr, nullptr, nullptr, nullptr);
#endif
        GRID_BAR();
        }
        for (int rep_ = 0; rep_ < REP_FFN1; ++rep_) {
#if PH & 512
        {
            pg8::Gemm g{HN, (const bf16*)(wl + W_FF1), D, D}; pg8::Order S; S.init(M, FF, D, G, bx, 1);
            pg8::EpiRelu2 E{FFH};
            pg8::gemm_phase<pg8::EpiRelu2>(lds, g, S, E);
        }
#endif
        GRID_BAR();
        }
#if PH & 1024
        {
            pg8::Gemm g{FFH, (const bf16*)(wl + W_FF2), FF, FF}; pg8::Order S; S.init(M, D, FF, G, bx, 1);
            pg8::EpiResid E{H, H + (size_t)MP * D, H};
            pg8::gemm_phase<pg8::EpiResid>(lds, g, S, E);
        }
#endif
        GRID_BAR();
    }
#if PH & 2048
    norm_phase<2>(lds, vcu, G, H, H + (size_t)MP * D, args.in[20], nullptr, nullptr, H, nullptr, nullptr, nullptr);
#endif
}

extern "C" void kernel_launch(void* const* d_in, const int* in_sizes, int n_in, void* d_out, int out_size, void* d_ws, size_t ws_size, hipStream_t stream) {
    static int grid = 0;
    if (grid == 0) {
        if (n_in != 21 || in_sizes[0] != MP * D || (size_t)out_size != O_END || ws_size < WS_END) {
            fprintf(stderr, "kernel_launch: unexpected shapes: n_in %d in0 %d out %d ws %zu (need %zu)\n", n_in, n_in > 0 ? in_sizes[0] : -1, out_size, ws_size, (size_t)WS_END); grid = -1; return; }
        int dev = 0, cus = 0, per_cu = 0;
        if (hipGetDevice(&dev) != hipSuccess || hipDeviceGetAttribute(&cus, hipDeviceAttributeMultiprocessorCount, dev) != hipSuccess) { grid = -1; return; }
        if (hipFuncSetAttribute((const void*)hybrid_fwd, hipFuncAttributeMaxDynamicSharedMemorySize, LDS_BYTES) != hipSuccess) { fprintf(stderr, "kernel_launch: hipFuncSetAttribute failed\n"); grid = -1; return; }
        if (hipOccupancyMaxActiveBlocksPerMultiprocessor(&per_cu, (const void*)hybrid_fwd, NWAVES * 64, LDS_BYTES) != hipSuccess || per_cu < 1) {
            fprintf(stderr, "kernel_launch: occupancy query reports %d blocks per CU\n", per_cu); (void)hipGetLastError(); grid = -1; return; }
        grid = cus;
    }
    if (grid < 0) return;
    if (hipMemsetAsync((char*)d_ws + WS_CTL, 0, CTL_ZERO_BYTES, stream) != hipSuccess) { fprintf(stderr, "kernel_launch: memset failed\n"); return; }
    Args a{};
    for (int i = 0; i < 21; ++i) a.in[i] = (const float*)d_in[i];
    a.out = (float*)d_out; a.ws = (unsigned char*)d_ws;
    void* kargs[] = {&a};
    hipError_t e = hipLaunchCooperativeKernel((const void*)hybrid_fwd, dim3(grid), dim3(NWAVES * 64), kargs, LDS_BYTES, stream);
    if (e != hipSuccess) fprintf(stderr, "kernel_launch: cooperative launch failed: %s (grid %d)\n", hipGetErrorString(e), grid);
}
```

```cpp
#include <hip/hip_runtime.h>
#include <hip/hip_cooperative_groups.h>
#include <cstdio>
#include <cstdint>

constexpr int D = 1024, NB = 8, SEQ = 2048, DEPTH = 2, SB = 128, ST = 8;
constexpr int MP = NB * SEQ;
constexpr int MS = SB * ST;
constexpr int M = MP + MS;
constexpr int IN_COLS = 7696;
constexpr int NPJ = 7680;
constexpr int FF = 4096;
constexpr float EPS = 1e-6f;
constexpr int C_Q = 0, C_K = 512, C_V = 1024, C_GO = 2048, C_XP = 3072, C_U = 3584, C_VV = 4096, C_G = 4608;
constexpr int MIXW = 2048;

constexpr size_t MiB = 1u << 20;
constexpr size_t WS_CTL = 0, CTL_ZERO_BYTES = 1 * MiB;
constexpr size_t WS_W = 2 * MiB;
constexpr size_t W_LAYER = 37 * MiB, W_IN = 0, W_BR = 15 * MiB, W_OUT = 19 * MiB, W_FF1 = 21 * MiB, W_FF2 = 29 * MiB;
constexpr size_t WS_HN = 76 * MiB;
constexpr size_t WS_GLOG = 110 * MiB;
constexpr size_t WS_MIX = 144 * MiB;
constexpr size_t WS_PROJ = 212 * MiB;
constexpr size_t WS_FFHS = 468 * MiB;
constexpr size_t WS_SLAB = 476 * MiB;
constexpr size_t WS_END = 492 * MiB;
static_assert(WS_PROJ + (size_t)M * NPJ * 2 <= WS_FFHS, "ws map");
static_assert(WS_MIX + (size_t)M * MIXW * 2 <= WS_PROJ, "ws map");
static_assert(WS_GLOG + (size_t)M * 512 * 4 <= WS_MIX, "ws map");
static_assert(WS_HN + (size_t)M * D * 2 <= WS_GLOG, "ws map");
static_assert(WS_W + 2 * W_LAYER <= WS_HN, "ws map");
constexpr int CW_BAR = 4096, CW_BAR2 = 8192;

constexpr size_t O_Y = 0;
constexpr size_t O_GLAP = (size_t)M * D;
constexpr size_t O_GLAS = O_GLAP + (size_t)DEPTH * NB * 4 * 128 * 256;
constexpr size_t O_POOLP = O_GLAS + (size_t)DEPTH * SB * 4 * 128 * 256;
constexpr size_t O_POOLS = O_POOLP + (size_t)DEPTH * NB * 15 * 512;
constexpr size_t O_SGV = O_POOLS + (size_t)DEPTH * SB * 15 * 512;
constexpr size_t O_END = O_SGV + (size_t)DEPTH * SB * ST * 512;
static_assert(O_END == 56614912, "output size");

constexpr int RING_BYTES = 131072;
constexpr int LDSCTL_OFF = RING_BYTES, MISC_OFF = LDSCTL_OFF + 320;
constexpr int LDS_BYTES = 147456;
constexpr int NWAVES = 8;

#define GAS __attribute__((address_space(1)))
#define LAS __attribute__((address_space(3)))
typedef unsigned short bf16;
typedef unsigned v4u __attribute__((ext_vector_type(4)));
typedef unsigned v2u __attribute__((ext_vector_type(2)));
typedef float f32x4 __attribute__((ext_vector_type(4)));
typedef short bf16x8 __attribute__((ext_vector_type(8)));
typedef GAS unsigned gu32;
#define RLX_AGENT __ATOMIC_RELAXED, __HIP_MEMORY_SCOPE_AGENT
#define LDS_WAIT() asm volatile("s_waitcnt lgkmcnt(0)" ::: "memory")
#define LDS_BARRIER() do { asm volatile("s_waitcnt lgkmcnt(0)" ::: "memory"); __builtin_amdgcn_s_barrier(); asm volatile("" ::: "memory"); } while (0)

__device__ __forceinline__ unsigned f2bf(float f) { unsigned u = __builtin_bit_cast(unsigned, f); return (u + 0x7fffu + ((u >> 16) & 1u)) >> 16; }
__device__ __forceinline__ unsigned pk2(float lo, float hi) { return f2bf(lo) | (f2bf(hi) << 16); }
__device__ __forceinline__ float bf2f(unsigned short x) { return __builtin_bit_cast(float, (unsigned)x << 16); }
__device__ __forceinline__ float bflo(unsigned w) { return __builtin_bit_cast(float, w << 16); }
__device__ __forceinline__ float bfhi(unsigned w) { return __builtin_bit_cast(float, w & 0xffff0000u); }
__device__ __forceinline__ float sigmoid_f(float x) { return __builtin_amdgcn_rcpf(1.0f + __builtin_amdgcn_exp2f(-1.4426950409f * x)); }
__device__ __forceinline__ float gelu_tanh(float x) { const float z = 1.5957691216f * x * (1.0f + 0.044715f * x * x); return x * sigmoid_f(z); }
__device__ __forceinline__ int opaque_tid() { int t = threadIdx.x; asm volatile("" : "+v"(t)); return t; }
__device__ __forceinline__ float wave_sum(float v) {
#pragma unroll
    for (int o = 1; o < 64; o <<= 1) v += __shfl_xor(v, o);
    return v;
}

namespace pg8 {
#define PG8_LAS __attribute__((address_space(3)))
typedef unsigned short bf16_t;
typedef unsigned u32x4 __attribute__((ext_vector_type(4)));
constexpr int BM = 256, BK = 64, HALF = 128, HTB = HALF * BK * 2, STAGE_BYTES = 8 * HTB, NXCD = 8, WGM = 8;

__host__ __device__ __forceinline__ int lds_byte(int r, int c) { const int st = (r >> 4) * 2 + (c >> 5), rr = r & 15, cc = c & 31, ob = rr * 64 + cc * 2; return st * 1024 + (ob ^ (((ob >> 9) & 1) << 5)); }
__host__ __device__ __forceinline__ void stage_rc(int b, int& R, int& C) { const int st = b / 1024, sb = b % 1024, swz = sb ^ (((sb >> 9) & 1) << 5); R = (st >> 1) * 16 + swz / 64; C = (st & 1) * 32 + (swz % 64) / 2; }
__host__ __device__ __forceinline__ int perm32(int rho) { const int n = rho >> 4, i = rho & 15; return 8 * (i >> 2) + 4 * n + (i & 3); }

struct Unit { int pm, pn, k0, nt, sub, keep; };
struct Gemm { const bf16_t* A; const bf16_t* Bt; int lda, ldb; };

struct Order {
    int nM, nN, nwg, G, c, nsub, ntk, pm_off, ksplit;
    __device__ void init(int M_, int N_, int K_, int G_, int c_, int nsub_, int pm_off_ = 0, int ksplit_ = 1) { nM = M_ / BM; nN = N_ / BM; nwg = nM * nN; G = G_; c = c_; nsub = nsub_; ntk = K_ / BK; pm_off = pm_off_; ksplit = ksplit_; }
    __device__ bool next(int i, Unit& u) const {
        const int ti = i / nsub, sub = i - ti * nsub;
        long L = (long)ti * G + c; if (L >= (long)nwg * ksplit) return false;
        const int ksr = (int)(L % ksplit); L /= ksplit;
        int wgid = (int)L; { const int q = nwg / NXCD, r = nwg % NXCD, xcd = wgid % NXCD, off = wgid / NXCD; wgid = (xcd < r ? xcd * (q + 1) : r * (q + 1) + (xcd - r) * q) + off; }
        const int nig = WGM * nN, gid = wgid / nig, fm = gid * WGM, gsz = (nM - fm) < WGM ? (nM - fm) : WGM;
        u.pm = pm_off + fm + ((wgid % nig) % gsz); u.pn = (wgid % nig) / gsz; u.sub = sub;
        if (ksplit > 1) { u.nt = ntk / ksplit; u.k0 = ksr * u.nt * BK; u.keep = 0; u.sub = ksr; }
        else if (nsub == 1) { u.k0 = 0; u.nt = ntk; u.keep = 0; }
        else { u.k0 = sub == 0 ? 0 : (sub == 1 ? 1024 : 1536); u.nt = sub == 0 ? 16 : 8; u.keep = sub < 2 ? 1 : 0; }
        return true;
    }
};

typedef __bf16 bf16x2_t __attribute__((ext_vector_type(2)));
typedef float f32x2_t __attribute__((ext_vector_type(2)));
__device__ __forceinline__ unsigned cvt_pk_bf16(float lo, float hi) { const f32x2_t v = {lo, hi}; const bf16x2_t b = __builtin_convertvector(v, bf16x2_t); return __builtin_bit_cast(unsigned, b); }

typedef f32x4 acc_t[2][2][4][2];

template <int ACT> __device__ __forceinline__ float act_f(float x) {
    if (ACT == 1) return x * 0.08838834764831845f;
    if (ACT == 2) return gelu_tanh(x);
    if (ACT == 3) return sigmoid_f(x);
    if (ACT == 4) { const float r = x > 0.f ? x : 0.f; return r * r; }
    return x;
}
template <int ACT> __device__ __forceinline__ void store_bf16_tile(const acc_t& acc, bf16_t* O, int ldc, int row0, int col0, float* sgv  , int sgcol0) {
#pragma unroll
    for (int ai = 0; ai < 2; ++ai)
#pragma unroll
        for (int m = 0; m < 4; ++m) { const int row = row0 + ai * HALF + m * 16; bf16_t* rowp = O + (size_t)row * ldc + col0;
#pragma unroll
            for (int bj = 0; bj < 2; ++bj) { f32x4 v0 = acc[ai][bj][m][0], v1 = acc[ai][bj][m][1];
#pragma unroll
                for (int j = 0; j < 4; ++j) { v0[j] = act_f<ACT>(v0[j]); v1[j] = act_f<ACT>(v1[j]); }
                u32x4 w; w.x = cvt_pk_bf16(v0[0], v0[1]); w.y = cvt_pk_bf16(v0[2], v0[3]); w.z = cvt_pk_bf16(v1[0], v1[1]); w.w = cvt_pk_bf16(v1[2], v1[3]);
                *(u32x4*)(rowp + bj * HALF) = w;
                if (ACT == 2 && sgv) { float* sp = sgv + (size_t)(row - MP) * 512 + sgcol0 + bj * HALF; *(f32x4*)sp = v0; *(f32x4*)(sp + 4) = v1; }
                if (ACT == 3 && sgv) { float* sp = sgv + (size_t)row * D + sgcol0 + bj * HALF; *(f32x4*)sp = v0; *(f32x4*)(sp + 4) = v1; } } }
}

struct EpiProj {
    static constexpr bool PERM = true;
    bf16_t* O; float* sgv; float* dbg;
    __device__ __forceinline__ void operator()(acc_t& acc, const Unit& u, int wr, int wc, int fr, int fq) const {
        const int row0 = u.pm * BM + wr * 64 + fr, col0 = u.pn * BM + wc * 32 + 8 * fq, pn = u.pn;
        if (pn < 2) store_bf16_tile<1>(acc, O, NPJ, row0, col0, nullptr, 0);
        else if (pn < 14) store_bf16_tile<0>(acc, O, NPJ, row0, col0, nullptr, 0);
        else if (pn < 18) store_bf16_tile<2>(acc, O, NPJ, row0, col0, (pn >= 16 && u.pm >= MP / BM) ? sgv : nullptr, col0 - C_VV);
#ifdef EXP_GATEOUT
        else store_bf16_tile<3>(acc, O, NPJ, row0, col0, (pn >= 26) ? dbg : nullptr, col0 - C_G - 2048);
#else
        else store_bf16_tile<3>(acc, O, NPJ, row0, col0, nullptr, 0);
#endif
    }
};
struct EpiPlain {
    static constexpr bool PERM = true;
    bf16_t* O;
    __device__ __forceinline__ void operator()(acc_t& acc, const Unit& u, int wr, int wc, int fr, int fq) const {
        if (u.keep) return;
        store_bf16_tile<0>(acc, O, D, u.pm * BM + wr * 64 + fr, u.pn * BM + wc * 32 + 8 * fq, nullptr, 0);
    }
};
struct EpiRelu2 {
    static constexpr bool PERM = true;
    bf16_t* O;
    __device__ __forceinline__ void operator()(acc_t& acc, const Unit& u, int wr, int wc, int fr, int fq) const {
        store_bf16_tile<4>(acc, O, FF, u.pm * BM + wr * 64 + fr, u.pn * BM + wc * 32 + 8 * fq, nullptr, 0);
    }
};
struct EpiBranch {
    static constexpr bool PERM = true;
    const bf16_t* P; bf16_t* O;
    __device__ __forceinline__ void operator()(acc_t& acc, const Unit& u, int wr, int wc, int fr, int fq) const {
        const int row0 = u.pm * BM + wr * 64 + fr, col0 = u.pn * BM + wc * 32 + 8 * fq, sub = u.sub;
#pragma unroll
        for (int ai = 0; ai < 2; ++ai)
#pragma unroll
            for (int m = 0; m < 4; ++m) { const int row = row0 + ai * HALF + m * 16; const bf16_t* gp = P + (size_t)row * NPJ + C_G + col0;
#pragma unroll
                for (int bj = 0; bj < 2; ++bj) {
#ifdef EXP_NOLOAD
                    const u32x4 g1 = (u32x4){0x3f003f00u, 0x3f003f00u, 0x3f003f00u, 0x3f003f00u};
#elif defined(EXP_SC1)
                    u32x4 g1; { const unsigned long long* q = (const unsigned long long*)(gp + sub * 1024 + bj * HALF);
                        const unsigned long long q0 = __hip_atomic_load(q, __ATOMIC_RELAXED, __HIP_MEMORY_SCOPE_SYSTEM), q1 = __hip_atomic_load(q + 1, __ATOMIC_RELAXED, __HIP_MEMORY_SCOPE_SYSTEM);
                        g1.x = (unsigned)q0; g1.y = (unsigned)(q0 >> 32); g1.z = (unsigned)q1; g1.w = (unsigned)(q1 >> 32); }
#elif defined(EXP_DEADLOAD)
                    const u32x4 g1_ = *(const u32x4*)(gp + sub * 1024 + bj * HALF);
#else
                    const u32x4 g1 = *(const u32x4*)(gp + sub * 1024 + bj * HALF);
#endif
#ifdef EXP_DEADLOAD
                    u32x4 g1 = g1_; asm volatile("" : "+v"(g1.x), "+v"(g1.y), "+v"(g1.z), "+v"(g1.w)); g1 = (u32x4){0x3f003f00u, 0x3f003f00u, 0x3f003f00u, 0x3f003f00u};
#endif
                    float f[8];
                    f[0] = bflo(g1.x); f[1] = bfhi(g1.x); f[2] = bflo(g1.y); f[3] = bfhi(g1.y); f[4] = bflo(g1.z); f[5] = bfhi(g1.z); f[6] = bflo(g1.w); f[7] = bfhi(g1.w);
#pragma unroll
                    for (int j = 0; j < 8; ++j) f[j] = f[j] > 1e-30f ? f[j] : 1e-30f;
#ifndef EXP_NODIV
                    if (sub < 2) {
                        const u32x4 g2 = *(const u32x4*)(gp + (sub + 1) * 1024 + bj * HALF);
                        float d[8];
                        d[0] = bflo(g2.x); d[1] = bfhi(g2.x); d[2] = bflo(g2.y); d[3] = bfhi(g2.y); d[4] = bflo(g2.z); d[5] = bfhi(g2.z); d[6] = bflo(g2.w); d[7] = bfhi(g2.w);
#pragma unroll
                        for (int j = 0; j < 8; ++j) { d[j] = d[j] > 1e-30f ? d[j] : 1e-30f; f[j] = f[j] / d[j]; }
                    }
#endif
                    f32x4 v0 = acc[ai][bj][m][0], v1 = acc[ai][bj][m][1];
#pragma unroll
                    for (int j = 0; j < 4; ++j) { v0[j] *= f[j]; v1[j] *= f[4 + j]; }
                    acc[ai][bj][m][0] = v0; acc[ai][bj][m][1] = v1;
                    if (sub == 2) { u32x4 w; w.x = cvt_pk_bf16(v0[0], v0[1]); w.y = cvt_pk_bf16(v0[2], v0[3]); w.z = cvt_pk_bf16(v1[0], v1[1]); w.w = cvt_pk_bf16(v1[2], v1[3]);
                        *(u32x4*)(O + (size_t)row * D + col0 + bj * HALF) = w; }
                }
                asm volatile("" ::: "memory"); }
    }
};
struct EpiResid {
    static constexpr bool PERM = false;
    const float* bp; const float* bs; float* out;
    __device__ __forceinline__ void operator()(acc_t& acc, const Unit& u, int wr, int wc, int fr, int fq) const {
        const int row0 = u.pm * BM + wr * 64 + fr, col0 = u.pn * BM + wc * 32 + 4 * fq;
        const bool smp = u.pm >= MP / BM;
#pragma unroll
        for (int ai = 0; ai < 2; ++ai)
#pragma unroll
            for (int m = 0; m < 4; ++m) { const int row = row0 + ai * HALF + m * 16;
                const float* b = smp ? bs + (size_t)(row - MP) * D + col0 : bp + (size_t)row * D + col0; float* o = out + (size_t)row * D + col0;
#pragma unroll
                for (int bj = 0; bj < 2; ++bj)
#pragma unroll
                    for (int n = 0; n < 2; ++n) { const f32x4 bv = *(const f32x4*)(b + bj * HALF + n * 16); *(f32x4*)(o + bj * HALF + n * 16) = bv + acc[ai][bj][m][n]; }
                if (m & 1) asm volatile("" ::: "memory"); }
    }
};

struct EpiSlab {
    static constexpr bool PERM = false;
    float* slab;
    __device__ __forceinline__ void operator()(acc_t& acc, const Unit& u, int wr, int wc, int fr, int fq) const {
        const int row0 = u.pm * BM + wr * 64 + fr - MP, col0 = u.pn * BM + wc * 32 + 4 * fq;
        float* base = slab + (size_t)u.sub * MS * D;
#pragma unroll
        for (int ai = 0; ai < 2; ++ai)
#pragma unroll
            for (int m = 0; m < 4; ++m) { float* o = base + (size_t)(row0 + ai * HALF + m * 16) * D + col0;
#pragma unroll
                for (int bj = 0; bj < 2; ++bj)
#pragma unroll
                    for (int n = 0; n < 2; ++n) *(f32x4*)(o + bj * HALF + n * 16) = acc[ai][bj][m][n]; }
    }
};

template <class Epi>
__device__ __forceinline__ void gemm_phase(PG8_LAS unsigned char* lds, const Gemm g, const Order& S, const Epi& E) {
    int tid_ = threadIdx.x; asm volatile("" : "+v"(tid_));
    const int tid = tid_, wid = __builtin_amdgcn_readfirstlane(tid >> 6), lane = tid & 63, wr = wid >> 2, wc = wid & 3, fr = lane & 15, fq = lane >> 4;
    unsigned voffA[2], voffB[2];
#pragma unroll
    for (int i = 0; i < 2; ++i) { int R, C; stage_rc(tid * 16 + i * 8192, R, C); const int Rb = Epi::PERM ? ((R & ~31) + perm32(R & 31)) : R;
        voffA[i] = (unsigned)(R * g.lda + C) * 2u; voffB[i] = (unsigned)(Rb * g.ldb + C) * 2u; }
    const size_t kstep = (size_t)(BK * 2);
    const size_t hstepA = (size_t)HALF * g.lda * 2, hstepB = (size_t)HALF * g.ldb * 2;
    const size_t tstepA = 2 * hstepA, tstepB = 2 * hstepB;
    const unsigned ldsw = (unsigned)wid * 1024u;
    const int aoff = lds_byte(wr * 64 + fr, fq * 8), boff = lds_byte(wc * 32 + fr, fq * 8);
#define PG8_SA(b, h) (((b) * 2 + (h)) * HTB)
#define PG8_SB(b, h) ((4 + (b) * 2 + (h)) * HTB)
#define PG8_STAGE(bufoff, gbase, voff) do { _Pragma("unroll") for (int _i = 0; _i < 2; ++_i) \
        __builtin_amdgcn_global_load_lds((const unsigned*)((const char*)(gbase) + (voff)[_i]), (PG8_LAS unsigned*)(lds + (bufoff) + ldsw + _i * 8192), 16, 0, 0); } while (0)
#define PG8_LDA(dst, b, h) do { _Pragma("unroll") for (int m = 0; m < 4; ++m) _Pragma("unroll") for (int k = 0; k < 2; ++k) dst[m][k] = *(const PG8_LAS bf16x8*)(lds + PG8_SA(b, h) + aoff + m * 2048 + k * 1024); } while (0)
#define PG8_LDB(dst, b, h) do { _Pragma("unroll") for (int n = 0; n < 2; ++n) _Pragma("unroll") for (int k = 0; k < 2; ++k) dst[n][k] = *(const PG8_LAS bf16x8*)(lds + PG8_SB(b, h) + boff + n * 2048 + k * 1024); } while (0)
#define PG8_MMA(ai, bj, At, Bt) do { __builtin_amdgcn_s_setprio(1); _Pragma("unroll") for (int m = 0; m < 4; ++m) _Pragma("unroll") for (int n = 0; n < 2; ++n) _Pragma("unroll") for (int k = 0; k < 2; ++k) \
        acc[ai][bj][m][n] = __builtin_amdgcn_mfma_f32_16x16x32_bf16(Bt[n][k], At[m][k], acc[ai][bj][m][n], 0, 0, 0); __builtin_amdgcn_s_setprio(0); } while (0)
#define PG8_WAIT_V(n) asm volatile("s_waitcnt vmcnt(" #n ")" ::: "memory")
#define PG8_WAIT_L(n) asm volatile("s_waitcnt lgkmcnt(" #n ")" ::: "memory")
#define PG8_BAR __builtin_amdgcn_s_barrier()
#define PG8_SCHED __builtin_amdgcn_sched_barrier(0)
    Unit cur, nxt; int ui = 0;
    if (!S.next(0, cur)) return;
    f32x4 acc[2][2][4][2];
#pragma unroll
    for (int a = 0; a < 2; ++a)
#pragma unroll
        for (int b = 0; b < 2; ++b)
#pragma unroll
            for (int m = 0; m < 4; ++m)
#pragma unroll
                for (int n = 0; n < 2; ++n) acc[a][b][m][n] = (f32x4){0.f, 0.f, 0.f, 0.f};
    bf16x8 At[4][2], B0[2][2], B1[2][2];
    const char* cA = (const char*)g.A + (size_t)cur.pm * tstepA + (size_t)cur.k0 * 2; const char* cB = (const char*)g.Bt + (size_t)cur.pn * tstepB + (size_t)cur.k0 * 2;
    PG8_STAGE(PG8_SB(0, 0), cB, voffB); PG8_STAGE(PG8_SB(0, 1), cB + hstepB, voffB); PG8_STAGE(PG8_SA(0, 0), cA, voffA); PG8_STAGE(PG8_SA(0, 1), cA + hstepA, voffA);
    if (wr == 1) PG8_BAR;
    PG8_WAIT_V(2); PG8_BAR;
    PG8_STAGE(PG8_SB(1, 0), cB + kstep, voffB); PG8_STAGE(PG8_SA(1, 0), cA + kstep, voffA); PG8_STAGE(PG8_SB(1, 1), cB + hstepB + kstep, voffB);
    PG8_WAIT_V(6); PG8_BAR;
    for (;;) {
        const bool has_next = S.next(ui + 1, nxt);
        const char* nA = has_next ? (const char*)g.A + (size_t)nxt.pm * tstepA + (size_t)nxt.k0 * 2 : cA; const char* nB = has_next ? (const char*)g.Bt + (size_t)nxt.pn * tstepB + (size_t)nxt.k0 * 2 : cB;
        const int nt = cur.nt;
        for (int t = 0; t < nt; t += 2) {
            const bool last = (t == nt - 2);
            const char* a1 = cA + (size_t)(t + 1) * kstep;
            const char* a2 = last ? nA : cA + (size_t)(t + 2) * kstep; const char* b2 = last ? nB : cB + (size_t)(t + 2) * kstep;
            const char* a3 = a2 + kstep; const char* b3 = b2 + kstep;
            PG8_LDB(B0, 0, 0); PG8_LDB(B1, 0, 1); PG8_SCHED; PG8_LDA(At, 0, 0); PG8_STAGE(PG8_SA(1, 1), a1 + hstepA, voffA);
            PG8_WAIT_V(8); PG8_WAIT_L(0); PG8_BAR; PG8_MMA(0, 0, At, B0); PG8_MMA(0, 1, At, B1); PG8_BAR; PG8_SCHED;
            PG8_LDA(At, 0, 1); PG8_STAGE(PG8_SB(0, 0), b2, voffB); PG8_STAGE(PG8_SB(0, 1), b2 + hstepB, voffB); PG8_STAGE(PG8_SA(0, 0), a2, voffA);
            PG8_WAIT_V(8); PG8_WAIT_L(0); PG8_BAR; PG8_MMA(1, 0, At, B0); PG8_MMA(1, 1, At, B1); PG8_BAR; PG8_SCHED;
            PG8_LDB(B0, 1, 0); PG8_LDB(B1, 1, 1); PG8_SCHED; PG8_LDA(At, 1, 0); PG8_STAGE(PG8_SA(0, 1), a2 + hstepA, voffA);
            PG8_WAIT_V(8); PG8_WAIT_L(0); PG8_BAR; PG8_MMA(0, 0, At, B0); PG8_MMA(0, 1, At, B1); PG8_BAR; PG8_SCHED;
            PG8_LDA(At, 1, 1); PG8_STAGE(PG8_SB(1, 0), b3, voffB); PG8_STAGE(PG8_SB(1, 1), b3 + hstepB, voffB); PG8_STAGE(PG8_SA(1, 0), a3, voffA);
            PG8_WAIT_V(8); PG8_WAIT_L(0); PG8_BAR; PG8_MMA(1, 0, At, B0); PG8_MMA(1, 1, At, B1); PG8_BAR; PG8_SCHED;
        }
        if (wr == 0) PG8_BAR;
        E(acc, cur, wr, wc, fr, fq);
        if (!has_next) break;
        if (!cur.keep) {
#pragma unroll
            for (int a = 0; a < 2; ++a)
#pragma unroll
                for (int b = 0; b < 2; ++b)
#pragma unroll
                    for (int m = 0; m < 4; ++m)
#pragma unroll
                        for (int n = 0; n < 2; ++n) acc[a][b][m][n] = (f32x4){0.f, 0.f, 0.f, 0.f};
        }
        cur = nxt; cA = nA; cB = nB; ++ui;
        if (wr == 1) PG8_BAR;
    }
    PG8_WAIT_V(0);
    PG8_BAR;
#undef PG8_SA
#undef PG8_SB
#undef PG8_STAGE
#undef PG8_LDA
#undef PG8_LDB
#undef PG8_MMA
#undef PG8_WAIT_V
#undef PG8_WAIT_L
#undef PG8_BAR
#undef PG8_SCHED
}
}

#define XB_TMO      128
#define XB_XCNT(j)  (256  + 64 * (j))
#define XB_XSUB(j)  (1280 + 64 * (j))
#define XB_XGEN(j)  (2304 + 64 * (j))
#define XB_TOP      3328
#define XB_TOPGEN   3392
#define XCD_BAR_WORDS 3456
#define XB_SPIN_CAP (1u << 20)

__device__ __forceinline__ unsigned xb_ld(unsigned* p)              { return __hip_atomic_load(p, __ATOMIC_RELAXED, __HIP_MEMORY_SCOPE_AGENT); }
__device__ __forceinline__ unsigned xb_add(unsigned* p, unsigned v) { return __hip_atomic_fetch_add(p, v, __ATOMIC_RELAXED, __HIP_MEMORY_SCOPE_AGENT); }
__device__ __forceinline__ unsigned xb_xcc_id() { return (unsigned)__builtin_amdgcn_s_getreg((3 << 11) | 20) & 0xFu; }
#define XB_SPIN(cond, bar) do { unsigned _sp = 0; while (cond) { __builtin_amdgcn_s_sleep(1); \
    if ((++_sp & 255u) == 0u) { if (xb_ld(&(bar)[XB_TMO])) break; if (_sp > XB_SPIN_CAP) { atomicAdd(&(bar)[XB_TMO], 1u); break; } } } } while (0)

struct XcdBarrier { unsigned* bar; unsigned x; volatile LAS unsigned* st; unsigned np; };

__device__ __forceinline__ XcdBarrier xcd_barrier_post(unsigned* bar, volatile LAS unsigned* st, unsigned np, bool member) {
    XcdBarrier b; b.bar = bar; b.x = 0; b.st = st; b.np = np;
    if (member && threadIdx.x == 0) (void)xb_add(&bar[XB_XCNT(xb_xcc_id())], 1u);
    return b;
}
__device__ __forceinline__ void xcd_barrier_complete(unsigned* bar, unsigned x, unsigned G, unsigned& nloc, unsigned& nx) {
    unsigned sum, cnt, mine, sp = 0u;
    for (;;) {
        sum = 0u; cnt = 0u; mine = 0u;
#pragma unroll
        for (unsigned j = 0; j < 16; ++j) { const unsigned c = xb_ld(&bar[XB_XCNT(j)]); sum += c; cnt += (c > 0u) ? 1u : 0u; mine = (j == x) ? c : mine; }
        if (sum == G) break;
        __builtin_amdgcn_s_sleep(1);
        if ((++sp & 255u) == 0u) { if (xb_ld(&bar[XB_TMO])) break; if (sp > XB_SPIN_CAP) { atomicAdd(&bar[XB_TMO], 1u); break; } }
    }
    nloc = mine > 0u ? mine : 1u; nx = cnt > 0u ? cnt : 1u;
}
__device__ __forceinline__ void xcd_barrier(const XcdBarrier& b) {
    asm volatile("s_waitcnt vmcnt(0)" ::: "memory");
    __syncthreads();
    if (threadIdx.x == 0) {
        unsigned* bar = b.bar;
        unsigned xo = 0; asm volatile("s_mov_b32 %0, 0" : "=s"(xo));
        bar += xo;
        const unsigned bx_ = xb_xcc_id();
        __builtin_amdgcn_s_waitcnt(0);
        unsigned nloc = b.st[0], nx = b.st[1];
        if (nloc == 0u) { xcd_barrier_complete(bar, bx_, b.np, nloc, nx); b.st[0] = nloc; b.st[1] = nx; }
        const unsigned old = xb_add(&bar[XB_XSUB(bx_)], 1u);
        const unsigned gen = old / nloc;
        if (old + 1u == (gen + 1u) * nloc) {
            __builtin_amdgcn_fence(__ATOMIC_RELEASE, "agent");
            asm volatile("s_waitcnt vmcnt(0)" ::: "memory");
            const unsigned og = xb_add(&bar[XB_TOP], 1u);
            const unsigned tg = og / nx;
            if (og + 1u == (tg + 1u) * nx) xb_add(&bar[XB_TOPGEN], 1u);
            else XB_SPIN(xb_ld(&bar[XB_TOPGEN]) == tg, bar);
            __builtin_amdgcn_fence(__ATOMIC_ACQUIRE, "agent");
            xb_add(&bar[XB_XGEN(bx_)], 1u);
            asm volatile("s_waitcnt vmcnt(0)" ::: "memory");
        } else {
            XB_SPIN(xb_ld(&bar[XB_XGEN(bx_)]) == gen, bar);
            __builtin_amdgcn_fence(__ATOMIC_ACQUIRE, "agent");
            asm volatile("s_waitcnt vmcnt(0)" ::: "memory");
        }
    }
    __syncthreads();
}

struct Args {
    const float* in[21];
    float* out; unsigned char* ws;
};

__device__ __forceinline__ void transpose_item(const float* W, int ldw, int ncols, bf16* WT, int ldd, int row_off, int col_off, LAS float* scr, int item, int lane) {
    const int nblk = ncols / 32, kb = item / nblk, nb = item % nblk, k0 = 64 * kb, n0 = 32 * nb;
#pragma unroll 8
    for (int i = 0; i < 32; ++i) { const int kk = 2 * i + (lane >> 5); scr[kk * 33 + (lane & 31)] = W[(size_t)(k0 + kk) * ldw + n0 + (lane & 31)]; }
    LDS_WAIT(); asm volatile("" ::: "memory");
    const int c = lane & 7;
#pragma unroll
    for (int j = 0; j < 4; ++j) { const int n = (lane >> 3) + 8 * j; const LAS float* s = scr + (8 * c) * 33 + n;
        v4u o; o.x = pk2(s[0 * 33], s[1 * 33]); o.y = pk2(s[2 * 33], s[3 * 33]); o.z = pk2(s[4 * 33], s[5 * 33]); o.w = pk2(s[6 * 33], s[7 * 33]);
        *(GAS v4u*)(WT + (size_t)(row_off + n0 + n) * ldd + col_off + k0 + 8 * c) = o; }
    LDS_WAIT(); asm volatile("" ::: "memory");
}

__device__ __forceinline__ void convert_weights(const Args& a, LAS unsigned char* lds, int vcu, int G) {
    const int tid = opaque_tid(), lane = tid & 63, wave = __builtin_amdgcn_readfirstlane(tid >> 6), gw = vcu * NWAVES + wave, NGW = G * NWAVES;
    LAS float* scr = (LAS float*)(lds + wave * 16384);
    constexpr int I_IN1 = 16 * 96, I_IN2 = 16 * 144, I_BA = 16 * 32, I_BB = 8 * 32, I_BC = 8 * 32, I_O = 16 * 32, I_F1 = 16 * 128, I_F2 = 64 * 32;
    constexpr int PER_LAYER = I_IN1 + I_IN2 + I_BA + I_BB + I_BC + I_O + I_F1 + I_F2;
    for (int it = gw; it < 2 * PER_LAYER; it += NGW) {
        const int l = it / PER_LAYER; int r = it - l * PER_LAYER;
        unsigned char* wl = a.ws + WS_W + (size_t)l * W_LAYER;
        const float* w_in = a.in[5] + (size_t)l * D * IN_COLS;
        if (r < I_IN1) { transpose_item(w_in, IN_COLS, 3072, (bf16*)(wl + W_IN), D, 0, 0, scr, r, lane); continue; } r -= I_IN1;
        if (r < I_IN2) { transpose_item(w_in + 3088, IN_COLS, 4608, (bf16*)(wl + W_IN), D, 3072, 0, scr, r, lane); continue; } r -= I_IN2;
        if (r < I_BA) { transpose_item(a.in[13] + (size_t)l * 1024 * 1024, 1024, 1024, (bf16*)(wl + W_BR), 2048, 0, 0, scr, r, lane); continue; } r -= I_BA;
        if (r < I_BB) { transpose_item(a.in[14] + (size_t)l * 512 * 1024, 1024, 1024, (bf16*)(wl + W_BR), 2048, 0, 1024, scr, r, lane); continue; } r -= I_BB;
        if (r < I_BC) { transpose_item(a.in[15] + (size_t)l * 512 * 1024, 1024, 1024, (bf16*)(wl + W_BR), 2048, 0, 1536, scr, r, lane); continue; } r -= I_BC;
        if (r < I_O) { transpose_item(a.in[16] + (size_t)l * 1024 * 1024, 1024, 1024, (bf16*)(wl + W_OUT), 1024, 0, 0, scr, r, lane); continue; } r -= I_O;
        if (r < I_F1) { transpose_item(a.in[18] + (size_t)l * 1024 * FF, FF, FF, (bf16*)(wl + W_FF1), 1024, 0, 0, scr, r, lane); continue; } r -= I_F1;
        transpose_item(a.in[19] + (size_t)l * FF * 1024, 1024, 1024, (bf16*)(wl + W_FF2), FF, 0, 0, scr, r, lane);
    }
}

template <int MODE>
__device__ __forceinline__ void norm_phase(LAS unsigned char* lds, int vcu, int G,
                                           const float* hp, const float* hs, const float* w, bf16* HN, float* GLOG, float* outf,
                                           const float* w_in_l, const float* w_gk2_l, const float* b_gk_l, int mlo = 0, int mhi = M) {
    const int tid = opaque_tid(), lane = tid & 63, wave = __builtin_amdgcn_readfirstlane(tid >> 6), gw = vcu * NWAVES + wave, NGW = G * NWAVES;
    LAS float* Wg = (LAS float*)lds;
    LAS float* Wk = Wg + 16 * 1024;
    if (MODE == 1) {
        for (int idx = tid; idx < 16 * 1024; idx += 512) { const int k = idx >> 4, c = idx & 15; Wg[c * 1024 + k] = w_in_l[(size_t)k * IN_COLS + 3072 + c]; }
        for (int idx = tid; idx < 16 * 512; idx += 512) Wk[idx] = w_gk2_l[idx];
        __syncthreads();
    }
    f32x4 wv[4];
#pragma unroll
    for (int j = 0; j < 4; ++j) wv[j] = *(const f32x4*)(w + 4 * lane + 256 * j);
    for (int m = mlo + gw; m < mhi; m += NGW) {
        const float* xr = (m < MP) ? hp + (size_t)m * D : hs + (size_t)(m - MP) * D;
        f32x4 v[4]; float ss = 0.f;
#pragma unroll
        for (int j = 0; j < 4; ++j) { v[j] = *(const f32x4*)(xr + 4 * lane + 256 * j); ss += (v[j].x * v[j].x + v[j].y * v[j].y) + (v[j].z * v[j].z + v[j].w * v[j].w); }
        const float r = 1.0f / sqrtf(wave_sum(ss) * (1.0f / D) + EPS);
#pragma unroll
        for (int j = 0; j < 4; ++j) v[j] = v[j] * r * wv[j];
        if (MODE == 2) {
#pragma unroll
            for (int j = 0; j < 4; ++j) *(f32x4*)(outf + (size_t)m * D + 4 * lane + 256 * j) = v[j];
        } else {
#pragma unroll
            for (int j = 0; j < 4; ++j) { v2u o; o.x = pk2(v[j].x, v[j].y); o.y = pk2(v[j].z, v[j].w); *(v2u*)(HN + (size_t)m * D + 4 * lane + 256 * j) = o; }
        }
        if (MODE == 1) {
            float gl[16];
#pragma unroll
            for (int c = 0; c < 16; ++c) { float p = 0.f;
#pragma unroll
                for (int j = 0; j < 4; ++j) { const f32x4 wg = *(const LAS f32x4*)(Wg + c * 1024 + 4 * lane + 256 * j); p += (v[j].x * wg.x + v[j].y * wg.y) + (v[j].z * wg.z + v[j].w * wg.w); }
                gl[c] = wave_sum(p); if ((c & 3) == 3) asm volatile("" ::: "memory"); }
#pragma unroll
            for (int hb = 0; hb < 2; ++hb) { const int d0 = 4 * lane + 256 * hb;
                f32x4 acc = *(const f32x4*)(b_gk_l + d0);
#pragma unroll
                for (int c = 0; c < 16; ++c) { const f32x4 wk = *(const LAS f32x4*)(Wk + c * 512 + d0); acc = acc + wk * gl[c]; }
                f32x4 o;
#pragma unroll
                for (int i = 0; i < 4; ++i) { const float x = acc[i]; const float ls = (x < 0.f ? x : 0.f) - log1pf(__expf(-fabsf(x))); o[i] = ls * (1.0f / 16.0f); }
                *(f32x4*)(GLOG + (size_t)m * 512 + d0) = o; }
        }
    }
    if (MODE == 1) __syncthreads();
}

__device__ __forceinline__ void gla_seq(LAS unsigned char* lds, const bf16* PROJ, const float* GLOG, bf16* MIXOUT, const float* gn,
                                        int row0, int T, int h, const float* S0, float* Sout) {
    const int tid = opaque_tid(), lane = tid & 63, wave = __builtin_amdgcn_readfirstlane(tid >> 6);
    LAS float* qs = (LAS float*)lds;
    LAS float* ks = qs + 16 * 128;
    LAS float* as = ks + 16 * 128;
    LAS float* op = as + 16 * 128;
    const int e = tid & 255, dh = __builtin_amdgcn_readfirstlane(tid >> 8);
    float S[64];
#pragma unroll
    for (int i = 0; i < 64; ++i) S[i] = S0 ? S0[(size_t)(dh * 64 + i) * 256 + e] : 0.f;
    const int TB = T < 16 ? T : 16;
    for (int t0 = 0; t0 < T; t0 += TB) {
        __syncthreads();
        for (int idx = tid; idx < TB * 128; idx += 512) { const int t = idx >> 7, d = idx & 127; const size_t row = (size_t)(row0 + t0 + t);
            qs[idx] = bf2f(PROJ[row * NPJ + C_Q + h * 128 + d]); ks[idx] = bf2f(PROJ[row * NPJ + C_K + h * 128 + d]); as[idx] = __expf(GLOG[row * 512 + h * 128 + d]); }
        __syncthreads();
        for (int t = 0; t < TB; ++t) {
            const float v = bf2f(PROJ[(size_t)(row0 + t0 + t) * NPJ + C_V + h * 256 + e]);
            const LAS float* qp = qs + t * 128 + dh * 64; const LAS float* kp = ks + t * 128 + dh * 64; const LAS float* ap = as + t * 128 + dh * 64;
            float o = 0.f;
#pragma unroll
            for (int i4 = 0; i4 < 16; ++i4) { const f32x4 q4 = *(const LAS f32x4*)(qp + 4 * i4), k4 = *(const LAS f32x4*)(kp + 4 * i4), a4 = *(const LAS f32x4*)(ap + 4 * i4);
#pragma unroll
                for (int j = 0; j < 4; ++j) { const int i = 4 * i4 + j; S[i] = a4[j] * S[i] + k4[j] * v; o += q4[j] * S[i]; } }
            op[(t * 2 + dh) * 256 + e] = o;
        }
        __syncthreads();
#pragma unroll
        for (int tt = 0; tt < 2; ++tt) { const int t = wave * 2 + tt;
            if (t < TB) { const int e4 = lane * 4; const size_t row = (size_t)(row0 + t0 + t);
                const f32x4 o = *(const LAS f32x4*)(op + (t * 2) * 256 + e4) + *(const LAS f32x4*)(op + (t * 2 + 1) * 256 + e4);
                const float ss = wave_sum((o.x * o.x + o.y * o.y) + (o.z * o.z + o.w * o.w));
                const float r = 1.0f / sqrtf(ss * (1.0f / 256.0f) + EPS);
                const v2u gw2 = *(const v2u*)(PROJ + row * NPJ + C_GO + h * 256 + e4);
                const f32x4 g4 = *(const f32x4*)(gn + e4);
                const float g0 = bflo(gw2.x), g1 = bfhi(gw2.x), g2 = bflo(gw2.y), g3 = bfhi(gw2.y);
                v2u ow; ow.x = pk2(o.x * r * g4.x * (g0 * sigmoid_f(g0)), o.y * r * g4.y * (g1 * sigmoid_f(g1))); ow.y = pk2(o.z * r * g4.z * (g2 * sigmoid_f(g2)), o.w * r * g4.w * (g3 * sigmoid_f(g3)));
                *(v2u*)(MIXOUT + row * MIXW + h * 256 + e4) = ow; } }
    }
#pragma unroll
    for (int i = 0; i < 64; ++i) Sout[(size_t)(dh * 64 + i) * 256 + e] = S[i];
    __syncthreads();
}

typedef float f32x16 __attribute__((ext_vector_type(16)));
typedef short s16x4 __attribute__((ext_vector_type(4)));
#define MFMA32(a, b, c) __builtin_amdgcn_mfma_f32_32x32x16_bf16((a), (b), (c), 0, 0, 0)
constexpr int GL_QG = 0, GL_KG = 17408, GL_KD = 34816, GL_VV = 55296, GL_PP = 92160, GL_DEC = 101376, GL_TOT = 101888, GL_END = 110080;
constexpr int GL_SQ = 272, GL_SKD = 320, GL_SV = 576, GL_SP = 144, GL_SO = 1040;
static_assert(GL_END <= RING_BYTES && 64 * GL_SO <= GL_PP, "gla lds map");
__device__ __forceinline__ bf16x8 tr_frag(LAS unsigned char* p, int rowstride4) {
    const s16x4 lo = __builtin_amdgcn_ds_read_tr16_b64_v4i16((LAS s16x4*)p), hi = __builtin_amdgcn_ds_read_tr16_b64_v4i16((LAS s16x4*)(p + rowstride4));
    return __builtin_shufflevector(lo, hi, 0, 1, 2, 3, 4, 5, 6, 7);
}
template <bool FULL>
__device__ __forceinline__ void gla_chunked(LAS unsigned char* lds, const bf16* PROJ, const float* GLOG, bf16* MIXOUT, const float* gn, int row0, int nchunks, int h,
                                            int nprev, const float* Sloc_prev, const float* Dlog_prev, float* Sout, float* Dlog_out) {
    const int tid = opaque_tid(), lane = tid & 63, w = __builtin_amdgcn_readfirstlane(tid >> 6), r = lane & 31, hh = lane >> 5;
    const int tq = (lane & 15) >> 2, tp = lane & 3, tblk = (lane >> 4) & 1;
    const int dq = tid & 31, seg = tid >> 5;
    f32x16 S[4];
#pragma unroll
    for (int b = 0; b < 4; ++b)
#pragma unroll
        for (int i = 0; i < 16; ++i) S[b][i] = 0.f;
    for (int pi = 0; pi < nprev; ++pi) {
        int lo_ = 4 * hh * 256 + 32 * w + r; asm volatile("" : "+v"(lo_));
        const float* sp = Sloc_prev + (size_t)pi * 128 * 256 + lo_; const float* dp = Dlog_prev + pi * 128 + 4 * hh;
#pragma unroll
        for (int b = 0; b < 4; ++b) {
#pragma unroll
            for (int i = 0; i < 16; ++i) { const int dr = 32 * b + (i & 3) + 8 * (i >> 2); S[b][i] = __expf(dp[dr]) * S[b][i] + sp[dr * 256]; }
            asm volatile("" ::: "memory"); }
    }
    f32x4 dsum = (f32x4){0.f, 0.f, 0.f, 0.f};
    f32x4 gr[4]; v2u qv[4], kv[4]; v4u vv[4];
#define GLA_LOAD_RAW(R0) do { _Pragma("unroll") for (int i = 0; i < 4; ++i) { gr[i] = *(const f32x4*)(GLOG + (size_t)((R0) + 4 * seg + i) * 512 + h * 128 + 4 * dq); \
        const bf16* pr = PROJ + (size_t)((R0) + 4 * seg + i) * NPJ + h * 128 + 4 * dq; qv[i] = *(const v2u*)(pr + C_Q); kv[i] = *(const v2u*)(pr + C_K); } } while (0)
#define GLA_LOAD_V(R0) do { _Pragma("unroll") for (int i = 0; i < 4; ++i) { \
        const int idx = tid + 512 * i, sr = idx >> 5, ch = idx & 31; vv[i] = *(const v4u*)(PROJ + (size_t)((R0) + sr) * NPJ + C_V + h * 256 + ch * 8); } } while (0)
    GLA_LOAD_RAW(row0); GLA_LOAD_V(row0);
    for (int c = 0; c < nchunks; ++c) {
        const int r0 = row0 + 64 * c;
        {
            f32x4 cs[4];
#pragma unroll
            for (int i = 0; i < 4; ++i) { cs[i] = gr[i]; if (i) cs[i] = cs[i] + cs[i - 1]; }
            *(LAS f32x4*)(lds + GL_TOT + (seg * 128 + 4 * dq) * 4) = cs[3];
            LDS_BARRIER();
            f32x4 pre = (f32x4){0.f, 0.f, 0.f, 0.f}, tot = (f32x4){0.f, 0.f, 0.f, 0.f};
#pragma unroll
            for (int s2 = 0; s2 < 16; ++s2) { const f32x4 tv = *(const LAS f32x4*)(lds + GL_TOT + (s2 * 128 + 4 * dq) * 4); tot = tot + tv; if (s2 < seg) pre = pre + tv; }
#pragma unroll
            for (int i = 0; i < 4; ++i) { const f32x4 b = pre + cs[i]; const int t = 4 * seg + i;
                float q4[4] = {bflo(qv[i].x), bfhi(qv[i].x), bflo(qv[i].y), bfhi(qv[i].y)}, k4[4] = {bflo(kv[i].x), bfhi(kv[i].x), bflo(kv[i].y), bfhi(kv[i].y)};
                float qg[4], kg[4], kd[4];
#pragma unroll
                for (int j = 0; j < 4; ++j) { qg[j] = q4[j] * __expf(b[j]); kg[j] = k4[j] * __expf(-b[j]); kd[j] = k4[j] * __expf(tot[j] - b[j]); }
                v2u o;
                if (FULL) { o.x = pg8::cvt_pk_bf16(qg[0], qg[1]); o.y = pg8::cvt_pk_bf16(qg[2], qg[3]); *(LAS v2u*)(lds + GL_QG + t * GL_SQ + dq * 8) = o;
                            o.x = pg8::cvt_pk_bf16(kg[0], kg[1]); o.y = pg8::cvt_pk_bf16(kg[2], kg[3]); *(LAS v2u*)(lds + GL_KG + t * GL_SQ + dq * 8) = o; }
                o.x = pg8::cvt_pk_bf16(kd[0], kd[1]); o.y = pg8::cvt_pk_bf16(kd[2], kd[3]); *(LAS v2u*)(lds + GL_KD + t * GL_SKD + dq * 8) = o; }
            dsum = dsum + tot;
            if (seg == 0) { f32x4 dc; dc.x = __expf(tot.x); dc.y = __expf(tot.y); dc.z = __expf(tot.z); dc.w = __expf(tot.w); *(LAS f32x4*)(lds + GL_DEC + dq * 16) = dc; }
#pragma unroll
            for (int i = 0; i < 4; ++i) { const int idx = tid + 512 * i, sr = idx >> 5, ch = idx & 31; *(LAS v4u*)(lds + GL_VV + sr * GL_SV + ch * 16) = vv[i]; }
            if (c + 1 < nchunks) GLA_LOAD_RAW(r0 + 64);
        }
        LDS_BARRIER();
        if (FULL && w < 3) {
            const int bi = w > 0 ? 1 : 0, bj = w > 1 ? 1 : 0;
            f32x16 acc;
#pragma unroll
            for (int i = 0; i < 16; ++i) acc[i] = 0.f;
#pragma unroll
            for (int ks = 0; ks < 8; ++ks) {
                const bf16x8 a = *(const LAS bf16x8*)(lds + GL_QG + (32 * bi + r) * GL_SQ + (16 * ks + 8 * hh) * 2);
                const bf16x8 b = *(const LAS bf16x8*)(lds + GL_KG + (32 * bj + r) * GL_SQ + (16 * ks + 8 * hh) * 2);
                acc = MFMA32(a, b, acc); }
            int pbase = GL_PP + (32 * bi + 4 * hh) * GL_SP + (32 * bj + r) * 2; asm volatile("" : "+v"(pbase));
#pragma unroll
            for (int i = 0; i < 16; ++i) { const int tl = (i & 3) + 8 * (i >> 2) + 4 * hh; float v = acc[i]; if (bi == bj && r > tl) v = 0.f;
                *(LAS unsigned short*)(lds + pbase + ((i & 3) + 8 * (i >> 2)) * GL_SP) = (unsigned short)f2bf(v); }
        }
        if (FULL) LDS_BARRIER();
        f32x16 o[2];
        {
            bf16x8 Bv[4];
#pragma unroll
            for (int ks = 0; ks < 4; ++ks) Bv[ks] = tr_frag(lds + GL_VV + (16 * ks + 8 * hh + tq) * GL_SV + (4 * w + 2 * tblk + (tp >> 1)) * 16 + 8 * (tp & 1), 4 * GL_SV);
#pragma unroll
            for (int rb = 0; rb < (FULL ? 2 : 0); ++rb) {
#pragma unroll
                for (int i = 0; i < 16; ++i) o[rb][i] = 0.f;
#pragma unroll
                for (int b = 0; b < 4; ++b)
#pragma unroll
                    for (int s2 = 0; s2 < 2; ++s2) {
                        const LAS unsigned char* ap = lds + GL_QG + (32 * rb + r) * GL_SQ + (32 * b + 16 * s2 + 4 * hh) * 2;
                        const s16x4 lo = *(const LAS s16x4*)ap, hi = *(const LAS s16x4*)(ap + 16);
                        const bf16x8 a = __builtin_shufflevector(lo, hi, 0, 1, 2, 3, 4, 5, 6, 7);
                        v4u pk; pk.x = pg8::cvt_pk_bf16(S[b][8 * s2 + 0], S[b][8 * s2 + 1]); pk.y = pg8::cvt_pk_bf16(S[b][8 * s2 + 2], S[b][8 * s2 + 3]);
                        pk.z = pg8::cvt_pk_bf16(S[b][8 * s2 + 4], S[b][8 * s2 + 5]); pk.w = pg8::cvt_pk_bf16(S[b][8 * s2 + 6], S[b][8 * s2 + 7]);
                        o[rb] = MFMA32(a, __builtin_bit_cast(bf16x8, pk), o[rb]); if (s2) asm volatile("" ::: "memory"); }
#pragma unroll
                for (int ks = 0; ks < 4; ++ks) if (ks < 2 || rb == 1) {
                    const bf16x8 a = *(const LAS bf16x8*)(lds + GL_PP + (32 * rb + r) * GL_SP + (16 * ks + 8 * hh) * 2);
                    o[rb] = MFMA32(a, Bv[ks], o[rb]); }
            }
#pragma unroll
            for (int b = 0; b < 4; ++b) {
#pragma unroll
                for (int g4 = 0; g4 < 4; ++g4) { const f32x4 dc = *(const LAS f32x4*)(lds + GL_DEC + (32 * b + 8 * g4 + 4 * hh) * 4);
#pragma unroll
                    for (int j = 0; j < 4; ++j) S[b][4 * g4 + j] *= dc[j]; }
#pragma unroll
                for (int ks = 0; ks < 4; ++ks) {
                    const bf16x8 a = tr_frag(lds + GL_KD + (16 * ks + 8 * hh + tq) * GL_SKD + (4 * b + 2 * tblk + (tp >> 1)) * 16 + 8 * (tp & 1), 4 * GL_SKD);
                    S[b] = MFMA32(a, Bv[ks], S[b]); }
                asm volatile("" ::: "memory");
            }
        }
        LDS_BARRIER();
        if (!FULL) { if (c + 1 < nchunks) GLA_LOAD_V(r0 + 64); }
        if (FULL) {
        v4u gpre[4];
#pragma unroll
        for (int i = 0; i < 4; ++i) gpre[i] = *(const v4u*)(PROJ + (size_t)(r0 + (tid >> 3)) * NPJ + C_GO + h * 256 + (tid & 7) * 32 + 8 * i);
        int obase = 4 * hh * GL_SO + (32 * w + r) * 4; asm volatile("" : "+v"(obase));
#pragma unroll
        for (int rb = 0; rb < 2; ++rb)
#pragma unroll
            for (int i = 0; i < 16; ++i) *(LAS float*)(lds + obase + (32 * rb + (i & 3) + 8 * (i >> 2)) * GL_SO) = o[rb][i];
        if (c + 1 < nchunks) GLA_LOAD_V(r0 + 64);
        LDS_BARRIER();
        {
            const int t = tid >> 3, sg = tid & 7, e0 = sg * 32; const size_t row = (size_t)(r0 + t);
            int e0g = e0; asm volatile("" : "+v"(e0g));
            f32x4 ov[8]; float ss = 0.f;
#pragma unroll
            for (int i = 0; i < 8; ++i) { ov[i] = *(const LAS f32x4*)(lds + t * GL_SO + (e0 + 4 * i) * 4); ss += (ov[i].x * ov[i].x + ov[i].y * ov[i].y) + (ov[i].z * ov[i].z + ov[i].w * ov[i].w); }
            ss += __shfl_xor(ss, 1); ss += __shfl_xor(ss, 2); ss += __shfl_xor(ss, 4);
            const float rn = 1.0f / sqrtf(ss * (1.0f / 256.0f) + EPS);
#pragma unroll
            for (int i = 0; i < 4; ++i) { const v4u gw4 = gpre[i];
                const f32x4 ga = *(const f32x4*)(gn + e0g + 8 * i), gb = *(const f32x4*)(gn + e0g + 8 * i + 4);
                const float g0 = bflo(gw4.x), g1 = bfhi(gw4.x), g2 = bflo(gw4.y), g3 = bfhi(gw4.y), g4 = bflo(gw4.z), g5 = bfhi(gw4.z), g6 = bflo(gw4.w), g7 = bfhi(gw4.w);
                const f32x4 oa = ov[2 * i], ob = ov[2 * i + 1]; v4u ow;
                ow.x = pg8::cvt_pk_bf16(oa.x * rn * ga.x * (g0 * sigmoid_f(g0)), oa.y * rn * ga.y * (g1 * sigmoid_f(g1)));
                ow.y = pg8::cvt_pk_bf16(oa.z * rn * ga.z * (g2 * sigmoid_f(g2)), oa.w * rn * ga.w * (g3 * sigmoid_f(g3)));
                ow.z = pg8::cvt_pk_bf16(ob.x * rn * gb.x * (g4 * sigmoid_f(g4)), ob.y * rn * gb.y * (g5 * sigmoid_f(g5)));
                ow.w = pg8::cvt_pk_bf16(ob.z * rn * gb.z * (g6 * sigmoid_f(g6)), ob.w * rn * gb.w * (g7 * sigmoid_f(g7)));
                *(v4u*)(MIXOUT + row * MIXW + h * 256 + e0 + 8 * i) = ow; }
        }
        LDS_BARRIER();
        }
    }
    if (Sout) {
        int lo_ = 4 * hh * 256 + 32 * w + r; asm volatile("" : "+v"(lo_)); float* sop = Sout + lo_;
#pragma unroll
        for (int b = 0; b < 4; ++b) {
#pragma unroll
            for (int i = 0; i < 16; ++i) sop[(32 * b + (i & 3) + 8 * (i >> 2)) * 256] = S[b][i];
            asm volatile("" ::: "memory"); }
    }
    if (Dlog_out && seg == 0) *(f32x4*)(Dlog_out + 4 * dq) = dsum;
#undef GLA_LOAD_RAW
#undef GLA_LOAD_V
}

__device__ __forceinline__ void gla_sample(LAS unsigned char* lds, const bf16* PROJ, const float* GLOG, bf16* MIXOUT, const float* gn, int r0, int h, const float* S0, float* Sout) {
    const int tid = opaque_tid(), lane = tid & 63, w = __builtin_amdgcn_readfirstlane(tid >> 6), r = lane & 31, hh = lane >> 5;
    const int tq = (lane & 15) >> 2, tp = lane & 3, tblk = (lane >> 4) & 1;
    if (tid < 32) {
        const int dq = tid; f32x4 b = (f32x4){0.f, 0.f, 0.f, 0.f}, bs[8];
#pragma unroll
        for (int t = 0; t < 8; ++t) { b = b + *(const f32x4*)(GLOG + (size_t)(r0 + t) * 512 + h * 128 + 4 * dq); bs[t] = b; }
#pragma unroll
        for (int t = 0; t < 8; ++t) { const bf16* pr = PROJ + (size_t)(r0 + t) * NPJ + h * 128 + 4 * dq; const v2u qv = *(const v2u*)(pr + C_Q), kv = *(const v2u*)(pr + C_K);
            const float q4[4] = {bflo(qv.x), bfhi(qv.x), bflo(qv.y), bfhi(qv.y)}, k4[4] = {bflo(kv.x), bfhi(kv.x), bflo(kv.y), bfhi(kv.y)};
            float qg[4], kg[4], kd[4];
#pragma unroll
            for (int j = 0; j < 4; ++j) { qg[j] = q4[j] * __expf(bs[t][j]); kg[j] = k4[j] * __expf(-bs[t][j]); kd[j] = k4[j] * __expf(b[j] - bs[t][j]); }
            v2u o; o.x = pg8::cvt_pk_bf16(qg[0], qg[1]); o.y = pg8::cvt_pk_bf16(qg[2], qg[3]); *(LAS v2u*)(lds + GL_QG + t * GL_SQ + dq * 8) = o;
            o.x = pg8::cvt_pk_bf16(kg[0], kg[1]); o.y = pg8::cvt_pk_bf16(kg[2], kg[3]); *(LAS v2u*)(lds + GL_KG + t * GL_SQ + dq * 8) = o;
            o.x = pg8::cvt_pk_bf16(kd[0], kd[1]); o.y = pg8::cvt_pk_bf16(kd[2], kd[3]); *(LAS v2u*)(lds + GL_KD + t * GL_SKD + dq * 8) = o; }
        f32x4 dc; dc.x = __expf(b.x); dc.y = __expf(b.y); dc.z = __expf(b.z); dc.w = __expf(b.w); *(LAS f32x4*)(lds + GL_DEC + dq * 16) = dc;
    } else if (tid >= 256) {
        const int idx = tid - 256, sr = idx >> 5, ch = idx & 31;
        *(LAS v4u*)(lds + GL_VV + sr * GL_SV + ch * 16) = *(const v4u*)(PROJ + (size_t)(r0 + sr) * NPJ + C_V + h * 256 + ch * 8);
    } else if (tid >= 64) {
        const v4u z = (v4u){0u, 0u, 0u, 0u};
        for (int idx = tid - 64; idx < 256 + 128; idx += 192) {
            if (idx < 256) *(LAS v4u*)(lds + GL_VV + (8 + (idx >> 5)) * GL_SV + (idx & 31) * 16) = z;
            else { const int k2 = idx - 256; *(LAS v4u*)(lds + GL_KD + (8 + (k2 >> 4)) * GL_SKD + (k2 & 15) * 16) = z; } }
    }
    asm volatile("" ::: "memory");
    int lane_off = 4 * hh * 256 + 32 * w + r; asm volatile("" : "+v"(lane_off));
    const float* s0p = S0 + lane_off; float* sop = Sout + lane_off;
    f32x16 S[4];
#pragma unroll
    for (int b = 0; b < 4; ++b) {
#pragma unroll
        for (int i = 0; i < 16; ++i) S[b][i] = s0p[(32 * b + (i & 3) + 8 * (i >> 2)) * 256];
        asm volatile("" ::: "memory"); }
    LDS_BARRIER();
    if (w == 0) {
        f32x16 acc;
#pragma unroll
        for (int i = 0; i < 16; ++i) acc[i] = 0.f;
#pragma unroll
        for (int ks = 0; ks < 8; ++ks) {
            const bf16x8 a = *(const LAS bf16x8*)(lds + GL_QG + r * GL_SQ + (16 * ks + 8 * hh) * 2);
            const bf16x8 b = *(const LAS bf16x8*)(lds + GL_KG + r * GL_SQ + (16 * ks + 8 * hh) * 2);
            acc = MFMA32(a, b, acc); }
#pragma unroll
        for (int i = 0; i < 16; ++i) { const int tl = (i & 3) + 8 * (i >> 2) + 4 * hh; float v = acc[i]; if (r > tl || tl >= 8) v = 0.f;
            if (r < 16) *(LAS unsigned short*)(lds + GL_PP + tl * GL_SP + r * 2) = (unsigned short)f2bf(v); }
    }
    LDS_BARRIER();
    f32x16 o;
    {
        const bf16x8 Bv = tr_frag(lds + GL_VV + (8 * hh + tq) * GL_SV + (4 * w + 2 * tblk + (tp >> 1)) * 16 + 8 * (tp & 1), 4 * GL_SV);
#pragma unroll
        for (int i = 0; i < 16; ++i) o[i] = 0.f;
#pragma unroll
        for (int b = 0; b < 4; ++b)
#pragma unroll
            for (int s2 = 0; s2 < 2; ++s2) {
                const LAS unsigned char* ap = lds + GL_QG + r * GL_SQ + (32 * b + 16 * s2 + 4 * hh) * 2;
                const s16x4 lo = *(const LAS s16x4*)ap, hi = *(const LAS s16x4*)(ap + 16);
                const bf16x8 a = __builtin_shufflevector(lo, hi, 0, 1, 2, 3, 4, 5, 6, 7);
                v4u pk; pk.x = pg8::cvt_pk_bf16(S[b][8 * s2 + 0], S[b][8 * s2 + 1]); pk.y = pg8::cvt_pk_bf16(S[b][8 * s2 + 2], S[b][8 * s2 + 3]);
                pk.z = pg8::cvt_pk_bf16(S[b][8 * s2 + 4], S[b][8 * s2 + 5]); pk.w = pg8::cvt_pk_bf16(S[b][8 * s2 + 6], S[b][8 * s2 + 7]);
                o = MFMA32(a, __builtin_bit_cast(bf16x8, pk), o); }
        { const bf16x8 a = *(const LAS bf16x8*)(lds + GL_PP + r * GL_SP + (8 * hh) * 2); o = MFMA32(a, Bv, o); }
#pragma unroll
        for (int b = 0; b < 4; ++b) {
#pragma unroll
            for (int g4 = 0; g4 < 4; ++g4) { const f32x4 dc = *(const LAS f32x4*)(lds + GL_DEC + (32 * b + 8 * g4 + 4 * hh) * 4);
#pragma unroll
                for (int j = 0; j < 4; ++j) S[b][4 * g4 + j] *= dc[j]; }
            const bf16x8 a = tr_frag(lds + GL_KD + (8 * hh + tq) * GL_SKD + (4 * b + 2 * tblk + (tp >> 1)) * 16 + 8 * (tp & 1), 4 * GL_SKD);
            S[b] = MFMA32(a, Bv, S[b]); }
    }
    LDS_BARRIER();
#pragma unroll
    for (int i = 0; i < 4; ++i) *(LAS float*)(lds + (i + 4 * hh) * GL_SO + (32 * w + r) * 4) = o[i];
    LDS_BARRIER();
    if (tid < 64) {
        const int t = tid >> 3, sg = tid & 7, e0 = sg * 32; const size_t row = (size_t)(r0 + t);
        f32x4 ov[8]; float ss = 0.f;
#pragma unroll
        for (int i = 0; i < 8; ++i) { ov[i] = *(const LAS f32x4*)(lds + t * GL_SO + (e0 + 4 * i) * 4); ss += (ov[i].x * ov[i].x + ov[i].y * ov[i].y) + (ov[i].z * ov[i].z + ov[i].w * ov[i].w); }
        ss += __shfl_xor(ss, 1); ss += __shfl_xor(ss, 2); ss += __shfl_xor(ss, 4);
        const float rn = 1.0f / sqrtf(ss * (1.0f / 256.0f) + EPS);
#pragma unroll
        for (int i = 0; i < 4; ++i) { const v4u gw4 = *(const v4u*)(PROJ + row * NPJ + C_GO + h * 256 + e0 + 8 * i);
            const f32x4 ga = *(const f32x4*)(gn + e0 + 8 * i), gb = *(const f32x4*)(gn + e0 + 8 * i + 4);
            const float g0 = bflo(gw4.x), g1 = bfhi(gw4.x), g2 = bflo(gw4.y), g3 = bfhi(gw4.y), g4 = bflo(gw4.z), g5 = bfhi(gw4.z), g6 = bflo(gw4.w), g7 = bfhi(gw4.w);
            const f32x4 oa = ov[2 * i], ob = ov[2 * i + 1]; v4u ow;
            ow.x = pg8::cvt_pk_bf16(oa.x * rn * ga.x * (g0 * sigmoid_f(g0)), oa.y * rn * ga.y * (g1 * sigmoid_f(g1)));
            ow.y = pg8::cvt_pk_bf16(oa.z * rn * ga.z * (g2 * sigmoid_f(g2)), oa.w * rn * ga.w * (g3 * sigmoid_f(g3)));
            ow.z = pg8::cvt_pk_bf16(ob.x * rn * gb.x * (g4 * sigmoid_f(g4)), ob.y * rn * gb.y * (g5 * sigmoid_f(g5)));
            ow.w = pg8::cvt_pk_bf16(ob.z * rn * gb.z * (g6 * sigmoid_f(g6)), ob.w * rn * gb.w * (g7 * sigmoid_f(g7)));
            *(v4u*)(MIXOUT + row * MIXW + h * 256 + e0 + 8 * i) = ow; }
    }
#pragma unroll
    for (int b = 0; b < 4; ++b) {
#pragma unroll
        for (int i = 0; i < 16; ++i) sop[(32 * b + (i & 3) + 8 * (i >> 2)) * 256] = S[b][i];
        asm volatile("" ::: "memory"); }
    LDS_BARRIER();
}

constexpr int PL_W = 0, PL_A = 40960, PL_SW = 320, PL_SA = 272;
__device__ __forceinline__ void mat128_to_lds(LAS unsigned char* lds, int off, int stride, const float* src, bool tril) {
    const int tid = opaque_tid();
#pragma unroll
    for (int i = 0; i < 8; ++i) { const int idx = tid + 512 * i, row = idx >> 5, c4 = idx & 31; f32x4 v = *(const f32x4*)(src + row * 128 + 4 * c4);
        if (tril) { if (4 * c4 + 0 > row) v.x = 0.f; if (4 * c4 + 1 > row) v.y = 0.f; if (4 * c4 + 2 > row) v.z = 0.f; if (4 * c4 + 3 > row) v.w = 0.f; }
        v2u o; o.x = pg8::cvt_pk_bf16(v.x, v.y); o.y = pg8::cvt_pk_bf16(v.z, v.w); *(LAS v2u*)(lds + off + row * stride + c4 * 8) = o; }
}
template <int G>
__device__ __forceinline__ void pool_tile(LAS unsigned char* lds, const bf16* PROJ, bf16* MIXOUT, const float* scale_g, const float* hist_l, int row0, int pos0, bool sample, int seq0) {
    const int tid = opaque_tid(), lane = tid & 63, w = __builtin_amdgcn_readfirstlane(tid >> 6), r = lane & 31, hh = lane >> 5;
    const int tq = (lane & 15) >> 2, tp = lane & 3, tblk = (lane >> 4) & 1;
    const int c = tid & 127, tqr = tid >> 7, col = C_XP + G * 128 + c;
    constexpr int WIN = 2 << G;
    if (!sample) {
        float P[32]; P[0] = 0.f; float xs[31];
#pragma unroll
        for (int i = 0; i < 31; ++i) { const int p = pos0 + 16 * tqr - 15 + i; xs[i] = p >= 0 ? bf2f(PROJ[(size_t)(row0 - pos0 + p) * NPJ + col]) : 0.f; P[i + 1] = P[i] + xs[i]; }
#pragma unroll
        for (int tt = 0; tt < 16; ++tt) { const int pos = pos0 + 16 * tqr + tt; const int cnt = WIN < pos + 1 ? WIN : pos + 1;
            const float pooled = (P[16 + tt] - P[16 + tt - WIN]) / (float)cnt - xs[15 + tt];
            *(LAS unsigned short*)(lds + PL_A + (16 * tqr + tt) * PL_SA + c * 2) = (unsigned short)f2bf(pooled); }
    } else {
#pragma unroll
        for (int sq = 0; sq < 2; ++sq) { const int seq = seq0 + 2 * tqr + sq;
            float P[24]; P[0] = 0.f; float xs[23];
#pragma unroll
            for (int i = 0; i < 23; ++i) { xs[i] = i < 15 ? hist_l[((size_t)seq * 15 + i) * 512 + G * 128 + c] : bf2f(PROJ[(size_t)(MP + seq * ST + i - 15) * NPJ + col]); P[i + 1] = P[i] + xs[i]; }
#pragma unroll
            for (int tt = 0; tt < 8; ++tt) { const float pooled = (P[16 + tt] - P[16 + tt - WIN]) * (1.0f / (float)WIN) - xs[15 + tt];
                *(LAS unsigned short*)(lds + PL_A + (16 * tqr + 8 * sq + tt) * PL_SA + c * 2) = (unsigned short)f2bf(pooled); } }
    }
    LDS_BARRIER();
    {
        const int rb = w & 1, cb = w >> 1; f32x16 acc;
#pragma unroll
        for (int i = 0; i < 16; ++i) acc[i] = 0.f;
#pragma unroll
        for (int ks = 0; ks < 8; ++ks) {
            const bf16x8 a = *(const LAS bf16x8*)(lds + PL_A + (32 * rb + r) * PL_SA + (16 * ks + 8 * hh) * 2);
            const bf16x8 b = tr_frag(lds + PL_W + (16 * ks + 8 * hh + tq) * PL_SW + (4 * cb + 2 * tblk + (tp >> 1)) * 16 + 8 * (tp & 1), 4 * PL_SW);
            acc = MFMA32(a, b, acc); }
        const float sc = scale_g[32 * cb + r];
#pragma unroll
        for (int i = 0; i < 16; ++i) { const int t = 32 * rb + (i & 3) + 8 * (i >> 2) + 4 * hh;
            MIXOUT[(size_t)(row0 + t) * MIXW + 1024 + G * 128 + 32 * cb + r] = (bf16)f2bf(acc[i] * sc); }
    }
    LDS_BARRIER();
}
constexpr int SG_WT = 0, SG_VI = 34816, SG_SW = 272, SG_SV = 320;
__device__ __forceinline__ void sg_chunk(LAS unsigned char* lds, const bf16* PROJ, bf16* MIXOUT, const float* bs_g, int row0, int g) {
    const int tid = opaque_tid(), lane = tid & 63, w = __builtin_amdgcn_readfirstlane(tid >> 6), r = lane & 31, hh = lane >> 5;
    const int tq = (lane & 15) >> 2, tp = lane & 3, tblk = (lane >> 4) & 1;
#pragma unroll
    for (int i = 0; i < 4; ++i) { const int idx = tid + 512 * i, sr = idx >> 4, ch = idx & 15;
        *(LAS v4u*)(lds + SG_VI + sr * SG_SV + ch * 16) = *(const v4u*)(PROJ + (size_t)(row0 + sr) * NPJ + C_VV + g * 128 + ch * 8); }
    LDS_BARRIER();
    const int dj = w & 3, pair = w >> 2;
#pragma unroll
    for (int pass = 0; pass < 2; ++pass) {
        const int bi = pass == 0 ? pair : 3 - pair, nks = 2 * (bi + 1);
        f32x16 acc;
#pragma unroll
        for (int i = 0; i < 16; ++i) acc[i] = 0.f;
#pragma unroll
        for (int ks = 0; ks < 8; ++ks) if (ks < nks) {
            const bf16x8 a = *(const LAS bf16x8*)(lds + SG_WT + (32 * bi + r) * SG_SW + (16 * ks + 8 * hh) * 2);
            const bf16x8 b = tr_frag(lds + SG_VI + (16 * ks + 8 * hh + tq) * SG_SV + (4 * dj + 2 * tblk + (tp >> 1)) * 16 + 8 * (tp & 1), 4 * SG_SV);
            acc = MFMA32(a, b, acc); }
#pragma unroll
        for (int i = 0; i < 16; ++i) { const int t = 32 * bi + (i & 3) + 8 * (i >> 2) + 4 * hh, d = 32 * dj + r;
            const float u = bf2f(PROJ[(size_t)(row0 + t) * NPJ + C_U + g * 128 + d]);
            MIXOUT[(size_t)(row0 + t) * MIXW + 1536 + g * 128 + d] = (bf16)f2bf(u * (acc[i] + bs_g[t])); }
    }
    LDS_BARRIER();
}

__device__ __forceinline__ void pool_item(LAS unsigned char* lds, const bf16* PROJ, bf16* MIXOUT, const float* wmix, const float* scale, const float* hist  ,
                                          int rowseq0, int tpos0, int nt, int g) {
    const int tid = opaque_tid();
    LAS float* pl = (LAS float*)lds;
    const int w = 2 << g;
    for (int idx = tid; idx < nt * 128; idx += 512) { const int t = idx >> 7, c = idx & 127, pos = tpos0 + t, col = C_XP + g * 128 + c;
        float sum = 0.f;
        for (int i = 0; i < w; ++i) { const int p = pos - i;
            if (p >= 0) sum += bf2f(PROJ[(size_t)(rowseq0 + p) * NPJ + col]);
            else if (hist) sum += hist[(size_t)(15 + p) * 512 + g * 128 + c]; }
        const int cnt = hist ? w : (w < pos + 1 ? w : pos + 1);
        pl[idx] = sum / (float)cnt - bf2f(PROJ[(size_t)(rowseq0 + pos) * NPJ + col]); }
    __syncthreads();
    const int j = tid & 127, tq = __builtin_amdgcn_readfirstlane(tid >> 7), tpq = nt >> 2;
    float acc[4] = {0.f, 0.f, 0.f, 0.f};
    for (int c = 0; c < 128; ++c) { const float wv = wmix[(size_t)(g * 128 + c) * 128 + j];
#pragma unroll
        for (int i = 0; i < 4; ++i) if (i < tpq) acc[i] += pl[(tq * tpq + i) * 128 + c] * wv; }
    const float sc = scale[g * 128 + j];
#pragma unroll
    for (int i = 0; i < 4; ++i) if (i < tpq) MIXOUT[(size_t)(rowseq0 + tpos0 + tq * tpq + i) * MIXW + 1024 + g * 128 + j] = (bf16)f2bf(acc[i] * sc);
    __syncthreads();
}

__device__ __forceinline__ void sg_item(LAS unsigned char* lds, const bf16* PROJ, bf16* MIXOUT, const float* ws, const float* bs, int row0, int L, int g) {
    const int tid = opaque_tid();
    LAS float* vt = (LAS float*)lds;
    LAS float* wt = vt + 128 * 128;
    for (int idx = tid; idx < L * 128; idx += 512) { const int s = idx >> 7, d = idx & 127;
        vt[idx] = bf2f(PROJ[(size_t)(row0 + s) * NPJ + C_VV + g * 128 + d]);
        wt[idx] = ws[(size_t)(g * 128 + s) * 128 + d]; }
    __syncthreads();
    const int d = tid & 127, tq = __builtin_amdgcn_readfirstlane(tid >> 7);
    for (int t = tq; t < L; t += 4) { float acc = 0.f;
        for (int s = 0; s <= t; ++s) acc += wt[t * 128 + s] * vt[s * 128 + d];
        const float u = bf2f(PROJ[(size_t)(row0 + t) * NPJ + C_U + g * 128 + d]);
        MIXOUT[(size_t)(row0 + t) * MIXW + 1536 + g * 128 + d] = (bf16)f2bf(u * (acc + bs[g * 128 + t])); }
    __syncthreads();
}


#ifndef PH
#define PH 0xFFFF
#endif
#if PH & 4096
#define MROWS MP
#else
#define MROWS M
#endif
#ifndef REP_P1
#define REP_P1 1
#endif
#ifndef REP_GS
#define REP_GS 1
#endif
#ifndef REP_PL
#define REP_PL 1
#endif
#ifndef REP_SG
#define REP_SG 1
#endif
#ifndef REP_SS
#define REP_SS 1
#endif
#ifndef REP_P2
#define REP_P2 1
#endif
#ifndef REP_GLAP
#define REP_GLAP 1
#endif
#ifndef REP_LIGHT
#define REP_LIGHT 1
#endif
#ifndef REP_PROJ
#define REP_PROJ 1
#endif
#ifndef REP_MIX
#define REP_MIX 1
#endif
#ifndef REP_BRANCH
#define REP_BRANCH 1
#endif
#ifndef REP_NORM2
#define REP_NORM2 1
#endif
#ifndef REP_FFN1
#define REP_FFN1 1
#endif
__global__ void __launch_bounds__(NWAVES * 64, 2) hybrid_fwd(Args args) {
    extern __shared__ __attribute__((aligned(16))) unsigned char lds_raw[];
    LAS unsigned char* lds = (LAS unsigned char*)lds_raw;
    volatile LAS unsigned* MISC = (volatile LAS unsigned*)(lds + MISC_OFF);
    const int G = gridDim.x, bx = blockIdx.x, vcu = (G % 8 == 0) ? (bx % 8) * (G / 8) + bx / 8 : bx;
    unsigned char* ws = args.ws;
    gu32* ctl = (gu32*)(ws + WS_CTL);
    for (int u = threadIdx.x; u < (LDS_BYTES - LDSCTL_OFF) / 4; u += NWAVES * 64) ((LAS unsigned*)(lds + LDSCTL_OFF))[u] = 0u;
    __syncthreads();
    XcdBarrier bar = xcd_barrier_post((unsigned*)(ctl + CW_BAR), MISC + 8, (unsigned)G, true);
    XcdBarrier bar2 = xcd_barrier_post((unsigned*)(ctl + CW_BAR2), MISC + 10, (unsigned)(G - 128), vcu >= 128);
#ifdef USE_CG
#define GRID_BAR() cooperative_groups::this_grid().sync()
#else
#define GRID_BAR() xcd_barrier(bar)
#endif

    bf16* HN = (bf16*)(ws + WS_HN);
    float* GLOG = (float*)(ws + WS_GLOG);
    float* SLOC = (float*)(ws + WS_HN);
    float* DLOG = (float*)(ws + WS_HN + 16 * MiB);
    bf16* MIX = (bf16*)(ws + WS_MIX);
    bf16* PROJ = (bf16*)(ws + WS_PROJ);
    bf16* FFH = (bf16*)(ws + WS_PROJ);
    bf16* FFHS = (bf16*)(ws + WS_FFHS);
    float* SLAB = (float*)(ws + WS_SLAB);
    float* H = args.out + O_Y;
    const float* xp_in = args.in[0]; const float* xs_in = args.in[1];

#if PH & 1
    convert_weights(args, lds, vcu, G);
    __syncthreads();
#endif
#if PH & 2
    norm_phase<1>(lds, vcu, G, xp_in, xs_in, args.in[4], HN, GLOG, nullptr, args.in[5], args.in[6], args.in[7]);
#endif
    GRID_BAR();

#ifdef EXP_ONELAYER
    for (int l = 0; l < 1; ++l) {
#else
    for (int l = 0; l < DEPTH; ++l) {
#endif
        unsigned char* wl = ws + WS_W + (size_t)l * W_LAYER;
#if PH & 4
        if (l > 0) {
            norm_phase<1>(lds, vcu, G, H, H + (size_t)MP * D, args.in[4] + l * D, HN, GLOG, nullptr, args.in[5] + (size_t)l * D * IN_COLS, args.in[6] + l * 16 * 512, args.in[7] + l * 512);
            GRID_BAR();
        }
#endif
        for (int rep_ = 0; rep_ < REP_PROJ; ++rep_) {
#if PH & 8
        {
            pg8::Gemm g{HN, (const bf16*)(wl + W_IN), D, D}; pg8::Order S; S.init(M, NPJ, D, G, bx, 1);
            pg8::EpiProj E{PROJ, args.out + O_SGV + (size_t)l * MS * 512, H};
            pg8::gemm_phase<pg8::EpiProj>(lds, g, S, E);
        }
#endif
        GRID_BAR();
        }
        for (int rep_ = 0; rep_ < REP_MIX; ++rep_) {
        {
            const float* gn = args.in[8] + l * 256;
            if (vcu < 96) {
#if PH & 16
                const int nh = vcu / 3, js = vcu - 3 * nh;
                for (int q_ = 0; q_ < REP_P1; ++q_)
                gla_chunked<false>(lds, PROJ, GLOG, MIX, gn, (nh >> 2) * SEQ + js * (SEQ / 4), SEQ / 256, nh & 3, 0, nullptr, nullptr, SLOC + (size_t)(nh * 3 + js) * 128 * 256, DLOG + (nh * 3 + js) * 128);
#endif
            } else {
#if PH & 32
                const float* wmix = args.in[9] + (size_t)l * 4 * 128 * 128; const float* pscale = args.in[10] + l * 512;
                const float* wsp = args.in[11] + (size_t)l * 4 * 128 * 128; const float* bsp = args.in[12] + l * 4 * 128;
                const float* spool = args.in[3] + (size_t)l * SB * 15 * 512;
                for (int rl_ = 0; rl_ < REP_LIGHT; ++rl_) {
                const int j = vcu - 96, NJ = G - 96, g = j & 3, jj = j >> 2, NJJ = NJ >> 2;
                for (int q_ = 0; q_ < REP_GS; ++q_)
                for (int it = j; it < SB * 4; it += NJ) { const int n = it >> 2, h = it & 3; const size_t so = ((size_t)(l * SB + n) * 4 + h) * 128 * 256;
#ifndef SKIP_GS
                    gla_sample(lds, PROJ, GLOG, MIX, gn, MP + n * ST, h, args.in[2] + so, args.out + O_GLAS + so); }
#else
 }
#endif
                mat128_to_lds(lds, PL_W, PL_SW, wmix + (size_t)g * 128 * 128, false);
                for (int q_ = 0; q_ < REP_PL; ++q_)
                for (int tile = jj; tile < 256 + 16; tile += NJJ) {
                    const bool smp = tile >= 256; const int st = tile - 256;
                    const int row0 = smp ? MP + st * 64 : (tile >> 5) * SEQ + (tile & 31) * 64, pos0 = smp ? 0 : (tile & 31) * 64;
#ifndef SKIP_PL
                    if (g == 0) pool_tile<0>(lds, PROJ, MIX, pscale, spool, row0, pos0, smp, st * 8);
                    else if (g == 1) pool_tile<1>(lds, PROJ, MIX, pscale + 128, spool, row0, pos0, smp, st * 8);
                    else if (g == 2) pool_tile<2>(lds, PROJ, MIX, pscale + 256, spool, row0, pos0, smp, st * 8);
                    else pool_tile<3>(lds, PROJ, MIX, pscale + 384, spool, row0, pos0, smp, st * 8);
#endif
                }
                mat128_to_lds(lds, SG_WT, SG_SW, wsp + (size_t)g * 128 * 128, true);
#ifndef SKIP_SG
                for (int q_ = 0; q_ < REP_SG; ++q_)
                for (int ch = jj; ch < 128; ch += NJJ) sg_chunk(lds, PROJ, MIX, bsp + g * 128, ch * 128, g);
#endif
                for (int q_ = 0; q_ < REP_SS; ++q_)
                for (int it = j; it < 512 + 136; it += NJ) {
                    int r = it;
                    if (r < 512) { const int g2 = r & 3, n = r >> 2; sg_item(lds, PROJ, MIX, wsp, bsp, MP + n * ST, ST, g2); continue; } r -= 512;
                    const int tid = opaque_tid();
                    if (r < NB) { const int n = r; float* o = args.out + O_POOLP + (size_t)(l * NB + n) * 15 * 512;
                        for (int idx = tid; idx < 15 * 512; idx += 512) { const int i = idx >> 9, c = idx & 511; o[idx] = bf2f(PROJ[(size_t)(n * SEQ + SEQ - 15 + i) * NPJ + C_XP + c]); } }
                    else { const int n = r - NB; float* o = args.out + O_POOLS + (size_t)(l * SB + n) * 15 * 512; const float* hs = spool + (size_t)n * 15 * 512;
                        for (int idx = tid; idx < 15 * 512; idx += 512) { const int i = idx >> 9, c = idx & 511; o[idx] = i < 7 ? hs[(size_t)(8 + i) * 512 + c] : bf2f(PROJ[(size_t)(MP + n * ST + i - 7) * NPJ + C_XP + c]); } }
                }
                }
#endif
            }
        }
        GRID_BAR();
#if PH & 16
        if (vcu < 128) {
            const int nh = vcu >> 2, js = vcu & 3;
            for (int q_ = 0; q_ < REP_P2; ++q_)
            gla_chunked<true>(lds, PROJ, GLOG, MIX, args.in[8] + l * 256, (nh >> 2) * SEQ + js * (SEQ / 4), SEQ / 256, nh & 3, js, SLOC + (size_t)nh * 3 * 128 * 256, DLOG + nh * 3 * 128,
                              js == 3 ? args.out + O_GLAP + ((size_t)(l * NB + (nh >> 2)) * 4 + (nh & 3)) * 128 * 256 : nullptr, nullptr);
        }
#endif
#if PH & 4096
        if (vcu >= 128) {
            const int c2 = vcu - 128;
            if (c2 < 16) { pg8::Gemm g{MIX, (const bf16*)(wl + W_BR), MIXW, MIXW}; pg8::Order S; S.init(MS, D, MIXW, 16, c2, 3, MP / 256);
                pg8::EpiBranch E{PROJ, HN}; pg8::gemm_phase<pg8::EpiBranch>(lds, g, S, E); }
            xcd_barrier(bar2);
            if (c2 < 16) { pg8::Gemm g{HN, (const bf16*)(wl + W_OUT), D, D}; pg8::Order S; S.init(MS, D, D, 16, c2, 1, MP / 256);
                pg8::EpiResid E{l == 0 ? xp_in : H, l == 0 ? xs_in : H + (size_t)MP * D, H}; pg8::gemm_phase<pg8::EpiResid>(lds, g, S, E); }
            xcd_barrier(bar2);
            norm_phase<0>(lds, c2, 128, H, H + (size_t)MP * D, args.in[17] + l * D, HN, nullptr, nullptr, nullptr, nullptr, nullptr, MP, M);
            xcd_barrier(bar2);
            if (c2 < 64) { pg8::Gemm g{HN, (const bf16*)(wl + W_FF1), D, D}; pg8::Order S; S.init(MS, FF, D, 64, c2, 1, MP / 256);
                pg8::EpiRelu2 E{FFHS - (size_t)MP * FF}; pg8::gemm_phase<pg8::EpiRelu2>(lds, g, S, E); }
            xcd_barrier(bar2);
            if (c2 < 64) { pg8::Gemm g{FFHS - (size_t)MP * FF, (const bf16*)(wl + W_FF2), FF, FF}; pg8::Order S; S.init(MS, D, FF, 64, c2, 1, MP / 256, 4);
                pg8::EpiSlab E{SLAB}; pg8::gemm_phase<pg8::EpiSlab>(lds, g, S, E); }
            xcd_barrier(bar2);
            {   const int tid = opaque_tid();
                for (int idx = tid; idx < 8 * 256; idx += 512) { const int rr = c2 * 8 + (idx >> 8), c4 = (idx & 255) * 4; float* hp_ = H + (size_t)(MP + rr) * D + c4;
                    f32x4 a = *(const f32x4*)hp_;
#pragma unroll
                    for (int k = 0; k < 4; ++k) a = a + *(const f32x4*)(SLAB + ((size_t)k * MS + rr) * D + c4);
                    *(f32x4*)hp_ = a; } }
        }
#endif
        GRID_BAR();
        }
#ifdef EXP_COPYGATES
        {   const int tid = opaque_tid();
            for (int row = vcu; row < M; row += G) for (int c = tid; c < 1024; c += 512) H[(size_t)row * D + c] = bf2f(PROJ[(size_t)row * NPJ + C_G + c]);
        }
        GRID_BAR();
#endif
        for (int rep_ = 0; rep_ < REP_BRANCH; ++rep_) {
#if PH & 64
        {
#ifdef EXP_PLAIN_BRANCH
            pg8::Gemm g{MIX, (const bf16*)(wl + W_BR), MIXW, MIXW}; pg8::Order S; S.init(M, D, MIXW, G, bx, 3);
            pg8::EpiPlain E{HN};
            pg8::gemm_phase<pg8::EpiPlain>(lds, g, S, E);
#else
            pg8::Gemm g{MIX, (const bf16*)(wl + W_BR), MIXW, MIXW}; pg8::Order S; S.init(MROWS, D, MIXW, G, bx, 3);
            pg8::EpiBranch E{PROJ, HN};
            pg8::gemm_phase<pg8::EpiBranch>(lds, g, S, E);
#endif
        }
#endif
        GRID_BAR();
        }
#if PH & 128
        {
            pg8::Gemm g{HN, (const bf16*)(wl + W_OUT), D, D}; pg8::Order S; S.init(MROWS, D, D, G, bx, 1);
            pg8::EpiResid E{l == 0 ? xp_in : H, l == 0 ? xs_in : H + (size_t)MP * D, H};
            pg8::gemm_phase<pg8::EpiResid>(lds, g, S, E);
        }
#endif
        GRID_BAR();
        for (int rep_ = 0; rep_ < REP_NORM2; ++rep_) {
#if PH & 256
        norm_phase<0>(lds, vcu, G, H, H + (size_t)MP * D, args.in[17] + l * D, HN, nullptr, nullptr, nullptr, nullptr, nullptr, 0, MROWS);
#endif
        GRID_BAR();
        }
        for (int rep_ = 0; rep_ < REP_FFN1; ++rep_) {
#if PH & 512
        {
            pg8::Gemm g{HN, (const bf16*)(wl + W_FF1), D, D}; pg8::Order S; S.init(MROWS, FF, D, G, bx, 1);
            pg8::EpiRelu2 E{FFH};
            pg8::gemm_phase<pg8::EpiRelu2>(lds, g, S, E);
        }
#endif
        GRID_BAR();
        }
#if PH & 1024
        {
            pg8::Gemm g{FFH, (const bf16*)(wl + W_FF2), FF, FF}; pg8::Order S; S.init(MROWS, D, FF, G, bx, 1);
            pg8::EpiResid E{H, H + (size_t)MP * D, H};
            pg8::gemm_phase<pg8::EpiResid>(lds, g, S, E);
        }
#endif
        GRID_BAR();
    }
#if PH & 2048
    norm_phase<2>(lds, vcu, G, H, H + (size_t)MP * D, args.in[20], nullptr, nullptr, H, nullptr, nullptr, nullptr);
#endif
}

extern "C" void kernel_launch(void* const* d_in, const int* in_sizes, int n_in, void* d_out, int out_size, void* d_ws, size_t ws_size, hipStream_t stream) {
    static int grid = 0;
    if (grid == 0) {
        if (n_in != 21 || in_sizes[0] != MP * D || (size_t)out_size != O_END || ws_size < WS_END) {
            fprintf(stderr, "kernel_launch: unexpected shapes: n_in %d in0 %d out %d ws %zu (need %zu)\n", n_in, n_in > 0 ? in_sizes[0] : -1, out_size, ws_size, (size_t)WS_END); grid = -1; return; }
        int dev = 0, cus = 0, per_cu = 0;
        if (hipGetDevice(&dev) != hipSuccess || hipDeviceGetAttribute(&cus, hipDeviceAttributeMultiprocessorCount, dev) != hipSuccess) { grid = -1; return; }
        if (hipFuncSetAttribute((const void*)hybrid_fwd, hipFuncAttributeMaxDynamicSharedMemorySize, LDS_BYTES) != hipSuccess) { fprintf(stderr, "kernel_launch: hipFuncSetAttribute failed\n"); grid = -1; return; }
        if (hipOccupancyMaxActiveBlocksPerMultiprocessor(&per_cu, (const void*)hybrid_fwd, NWAVES * 64, LDS_BYTES) != hipSuccess || per_cu < 1) {
            fprintf(stderr, "kernel_launch: occupancy query reports %d blocks per CU\n", per_cu); (void)hipGetLastError(); grid = -1; return; }
        grid = cus;
    }
    if (grid < 0) return;
    if (hipMemsetAsync((char*)d_ws + WS_CTL, 0, CTL_ZERO_BYTES, stream) != hipSuccess) { fprintf(stderr, "kernel_launch: memset failed\n"); return; }
    Args a{};
    for (int i = 0; i < 21; ++i) a.in[i] = (const float*)d_in[i];
    a.out = (float*)d_out; a.ws = (unsigned char*)d_ws;
    void* kargs[] = {&a};
    hipError_t e = hipLaunchCooperativeKernel((const void*)hybrid_fwd, dim3(grid), dim3(NWAVES * 64), kargs, LDS_BYTES, stream);
    if (e != hipSuccess) fprintf(stderr, "kernel_launch: cooperative launch failed: %s (grid %d)\n", hipGetErrorString(e), grid);
}
```

```cpp
#include <hip/hip_runtime.h>
#include <hip/hip_cooperative_groups.h>
#include <cstdio>
#include <cstdint>
#ifndef REP_BAR2
#define REP_BAR2 1
#endif
#ifndef REP_CONV
#define REP_CONV 1
#endif
#ifndef REP_N1
#define REP_N1 1
#endif
#ifndef REP_P1
#define REP_P1 1
#endif
#ifndef REP_GS
#define REP_GS 1
#endif
#ifndef REP_PL
#define REP_PL 1
#endif
#ifndef REP_SG
#define REP_SG 1
#endif
#ifndef REP_SS
#define REP_SS 1
#endif
#ifndef REP_P2
#define REP_P2 1
#endif
#ifndef REP_CH1
#define REP_CH1 1
#endif
#ifndef REP_CH4
#define REP_CH4 1
#endif
#ifndef REP_ATT
#define REP_ATT 1
#endif
#ifndef REP_OMM
#define REP_OMM 1
#endif
#ifndef REP_EPI
#define REP_EPI 1
#endif
#ifndef REP_GLAP
#define REP_GLAP 1
#endif
#ifndef REP_LIGHT
#define REP_LIGHT 1
#endif
#ifndef REP_PROJ
#define REP_PROJ 1
#endif
#ifndef REP_MIX
#define REP_MIX 1
#endif
#ifndef REP_BRANCH
#define REP_BRANCH 1
#endif
#ifndef REP_NORM2
#define REP_NORM2 1
#endif
#ifndef REP_FFN1
#define REP_FFN1 1
#endif

constexpr int D = 1024, NB = 8, SEQ = 2048, DEPTH = 2, SB = 128, ST = 8;
constexpr int MP = NB * SEQ;
constexpr int MS = SB * ST;
constexpr int M = MP + MS;
constexpr int IN_COLS = 7696;
constexpr int NPJ = 7680;
constexpr int FF = 4096;
constexpr float EPS = 1e-6f;
constexpr int C_Q = 0, C_K = 512, C_V = 1024, C_GO = 2048, C_XP = 3072, C_U = 3584, C_VV = 4096, C_G = 4608;
constexpr int MIXW = 2048;

constexpr size_t MiB = 1u << 20;
constexpr size_t WS_CTL = 0, CTL_ZERO_BYTES = 1 * MiB;
constexpr size_t WS_W = 2 * MiB;
constexpr size_t W_LAYER = 37 * MiB, W_IN = 0, W_BR = 15 * MiB, W_OUT = 19 * MiB, W_FF1 = 21 * MiB, W_FF2 = 29 * MiB;
constexpr size_t WS_HN = 76 * MiB;
constexpr size_t WS_GLOG = 110 * MiB;
constexpr size_t WS_MIX = 144 * MiB;
constexpr size_t WS_PROJ = 212 * MiB;
constexpr size_t WS_FFHS = 468 * MiB;
constexpr size_t WS_SLAB = 476 * MiB;
constexpr size_t WS_END = 508 * MiB;
static_assert(WS_PROJ + (size_t)M * NPJ * 2 <= WS_FFHS, "ws map");
static_assert(WS_MIX + (size_t)M * MIXW * 2 <= WS_PROJ, "ws map");
static_assert(WS_GLOG + (size_t)M * 512 * 4 <= WS_MIX, "ws map");
static_assert(WS_HN + (size_t)M * D * 2 <= WS_GLOG, "ws map");
static_assert(WS_W + 2 * W_LAYER <= WS_HN, "ws map");
constexpr int CW_BAR = 4096, CW_BAR2 = 8192;

constexpr size_t O_Y = 0;
constexpr size_t O_GLAP = (size_t)M * D;
constexpr size_t O_GLAS = O_GLAP + (size_t)DEPTH * NB * 4 * 128 * 256;
constexpr size_t O_POOLP = O_GLAS + (size_t)DEPTH * SB * 4 * 128 * 256;
constexpr size_t O_POOLS = O_POOLP + (size_t)DEPTH * NB * 15 * 512;
constexpr size_t O_SGV = O_POOLS + (size_t)DEPTH * SB * 15 * 512;
constexpr size_t O_END = O_SGV + (size_t)DEPTH * SB * ST * 512;
static_assert(O_END == 56614912, "output size");

constexpr int RING_BYTES = 131072;
constexpr int LDSCTL_OFF = RING_BYTES, MISC_OFF = LDSCTL_OFF + 320;
constexpr int LDS_BYTES = 147456;
constexpr int NWAVES = 8;

#define GAS __attribute__((address_space(1)))
#define LAS __attribute__((address_space(3)))
typedef unsigned short bf16;
typedef unsigned v4u __attribute__((ext_vector_type(4)));
typedef unsigned v2u __attribute__((ext_vector_type(2)));
typedef float f32x4 __attribute__((ext_vector_type(4)));
typedef short bf16x8 __attribute__((ext_vector_type(8)));
typedef GAS unsigned gu32;
#define RLX_AGENT __ATOMIC_RELAXED, __HIP_MEMORY_SCOPE_AGENT
#define LDS_WAIT() asm volatile("s_waitcnt lgkmcnt(0)" ::: "memory")
#define LDS_BARRIER() do { asm volatile("s_waitcnt lgkmcnt(0)" ::: "memory"); __builtin_amdgcn_s_barrier(); asm volatile("" ::: "memory"); } while (0)

__device__ __forceinline__ unsigned f2bf(float f) { unsigned u = __builtin_bit_cast(unsigned, f); return (u + 0x7fffu + ((u >> 16) & 1u)) >> 16; }
__device__ __forceinline__ unsigned pk2(float lo, float hi) { return f2bf(lo) | (f2bf(hi) << 16); }
__device__ __forceinline__ float bf2f(unsigned short x) { return __builtin_bit_cast(float, (unsigned)x << 16); }
__device__ __forceinline__ float bflo(unsigned w) { return __builtin_bit_cast(float, w << 16); }
__device__ __forceinline__ float bfhi(unsigned w) { return __builtin_bit_cast(float, w & 0xffff0000u); }
__device__ __forceinline__ float sigmoid_f(float x) { return __builtin_amdgcn_rcpf(1.0f + __builtin_amdgcn_exp2f(-1.4426950409f * x)); }
__device__ __forceinline__ float gelu_tanh(float x) { const float z = 1.5957691216f * x * (1.0f + 0.044715f * x * x); return x * sigmoid_f(z); }
__device__ __forceinline__ int opaque_tid() { int t = threadIdx.x; asm volatile("" : "+v"(t)); return t; }
__device__ __forceinline__ float wave_sum(float v) {
#pragma unroll
    for (int o = 1; o < 64; o <<= 1) v += __shfl_xor(v, o);
    return v;
}

namespace pg8 {
#define PG8_LAS __attribute__((address_space(3)))
typedef unsigned short bf16_t;
typedef unsigned u32x4 __attribute__((ext_vector_type(4)));
constexpr int BM = 256, BK = 64, HALF = 128, HTB = HALF * BK * 2, STAGE_BYTES = 8 * HTB, NXCD = 8, WGM = 8;

__host__ __device__ __forceinline__ int lds_byte(int r, int c) { const int st = (r >> 4) * 2 + (c >> 5), rr = r & 15, cc = c & 31, ob = rr * 64 + cc * 2; return st * 1024 + (ob ^ (((ob >> 9) & 1) << 5)); }
__host__ __device__ __forceinline__ void stage_rc(int b, int& R, int& C) { const int st = b / 1024, sb = b % 1024, swz = sb ^ (((sb >> 9) & 1) << 5); R = (st >> 1) * 16 + swz / 64; C = (st & 1) * 32 + (swz % 64) / 2; }
__host__ __device__ __forceinline__ int perm32(int rho) { const int n = rho >> 4, i = rho & 15; return 8 * (i >> 2) + 4 * n + (i & 3); }

struct Unit { int pm, pn, k0, nt, sub, keep, ks; };
struct Gemm { const bf16_t* A; const bf16_t* Bt; int lda, ldb; };

struct Order {
    int nM, nN, nwg, G, c, nsub, ntk, pm_off, ksplit;
    __device__ void init(int M_, int N_, int K_, int G_, int c_, int nsub_, int pm_off_ = 0, int ksplit_ = 1) { nM = M_ / BM; nN = N_ / BM; nwg = nM * nN; G = G_; c = c_; nsub = nsub_; ntk = K_ / BK; pm_off = pm_off_; ksplit = ksplit_; }
    __device__ bool next(int i, Unit& u) const {
        const int ti = i / nsub, sub = i - ti * nsub;
        long L = (long)ti * G + c; if (L >= (long)nwg * ksplit) return false;
        const int ksr = (int)(L % ksplit); L /= ksplit;
        int wgid = (int)L; { const int q = nwg / NXCD, r = nwg % NXCD, xcd = wgid % NXCD, off = wgid / NXCD; wgid = (xcd < r ? xcd * (q + 1) : r * (q + 1) + (xcd - r) * q) + off; }
        const int nig = WGM * nN, gid = wgid / nig, fm = gid * WGM, gsz = (nM - fm) < WGM ? (nM - fm) : WGM;
        u.pm = pm_off + fm + ((wgid % nig) % gsz); u.pn = (wgid % nig) / gsz; u.sub = sub; u.ks = ksr;
        if (nsub == 1) { u.nt = ntk / ksplit; u.k0 = ksr * u.nt * BK; u.keep = 0; }
        else { const int len = (sub == 0 ? 1024 : 512) / ksplit; u.k0 = (sub == 0 ? 0 : (sub == 1 ? 1024 : 1536)) + ksr * len; u.nt = len / BK; u.keep = sub < 2 ? 1 : 0; }
        return true;
    }
};

typedef __bf16 bf16x2_t __attribute__((ext_vector_type(2)));
typedef float f32x2_t __attribute__((ext_vector_type(2)));
__device__ __forceinline__ unsigned cvt_pk_bf16(float lo, float hi) { const f32x2_t v = {lo, hi}; const bf16x2_t b = __builtin_convertvector(v, bf16x2_t); return __builtin_bit_cast(unsigned, b); }

typedef f32x4 acc_t[2][2][4][2];

template <int ACT> __device__ __forceinline__ float act_f(float x) {
    if (ACT == 1) return x * 0.08838834764831845f;
    if (ACT == 2) return gelu_tanh(x);
    if (ACT == 3) return sigmoid_f(x);
    if (ACT == 4) { const float r = x > 0.f ? x : 0.f; return r * r; }
    return x;
}
template <int ACT> __device__ __forceinline__ void store_bf16_tile(const acc_t& acc, bf16_t* O, int ldc, int row0, int col0, float* sgv  , int sgcol0) {
#pragma unroll
    for (int ai = 0; ai < 2; ++ai)
#pragma unroll
        for (int m = 0; m < 4; ++m) { const int row = row0 + ai * HALF + m * 16; bf16_t* rowp = O + (size_t)row * ldc + col0;
#pragma unroll
            for (int bj = 0; bj < 2; ++bj) { f32x4 v0 = acc[ai][bj][m][0], v1 = acc[ai][bj][m][1];
#pragma unroll
                for (int j = 0; j < 4; ++j) { v0[j] = act_f<ACT>(v0[j]); v1[j] = act_f<ACT>(v1[j]); }
                u32x4 w; w.x = cvt_pk_bf16(v0[0], v0[1]); w.y = cvt_pk_bf16(v0[2], v0[3]); w.z = cvt_pk_bf16(v1[0], v1[1]); w.w = cvt_pk_bf16(v1[2], v1[3]);
                *(u32x4*)(rowp + bj * HALF) = w;
                if (ACT == 2 && sgv) { float* sp = sgv + (size_t)(row - MP) * 512 + sgcol0 + bj * HALF; *(f32x4*)sp = v0; *(f32x4*)(sp + 4) = v1; }
                if (ACT == 3 && sgv) { float* sp = sgv + (size_t)row * D + sgcol0 + bj * HALF; *(f32x4*)sp = v0; *(f32x4*)(sp + 4) = v1; } } }
}

struct EpiProj {
    static constexpr bool PERM = true;
    bf16_t* O; float* sgv; float* dbg;
    __device__ __forceinline__ void operator()(acc_t& acc, const Unit& u, int wr, int wc, int fr, int fq) const {
        const int row0 = u.pm * BM + wr * 64 + fr, col0 = u.pn * BM + wc * 32 + 8 * fq, pn = u.pn;
        if (pn < 2) store_bf16_tile<1>(acc, O, NPJ, row0, col0, nullptr, 0);
        else if (pn < 14) store_bf16_tile<0>(acc, O, NPJ, row0, col0, nullptr, 0);
        else if (pn < 18) store_bf16_tile<2>(acc, O, NPJ, row0, col0, (pn >= 16 && u.pm >= MP / BM) ? sgv : nullptr, col0 - C_VV);
#ifdef EXP_GATEOUT
        else store_bf16_tile<3>(acc, O, NPJ, row0, col0, (pn >= 26) ? dbg : nullptr, col0 - C_G - 2048);
#else
        else store_bf16_tile<3>(acc, O, NPJ, row0, col0, nullptr, 0);
#endif
    }
};
struct EpiPlain {
    static constexpr bool PERM = true;
    bf16_t* O;
    __device__ __forceinline__ void operator()(acc_t& acc, const Unit& u, int wr, int wc, int fr, int fq) const {
        if (u.keep) return;
        store_bf16_tile<0>(acc, O, D, u.pm * BM + wr * 64 + fr, u.pn * BM + wc * 32 + 8 * fq, nullptr, 0);
    }
};
struct EpiRelu2 {
    static constexpr bool PERM = true;
    bf16_t* O;
    __device__ __forceinline__ void operator()(acc_t& acc, const Unit& u, int wr, int wc, int fr, int fq) const {
        store_bf16_tile<4>(acc, O, FF, u.pm * BM + wr * 64 + fr, u.pn * BM + wc * 32 + 8 * fq, nullptr, 0);
    }
};
struct EpiBranch {
    static constexpr bool PERM = true;
    const bf16_t* P; bf16_t* O; float* slab;
    __device__ __forceinline__ void operator()(acc_t& acc, const Unit& u, int wr, int wc, int fr, int fq) const {
        const int row0 = u.pm * BM + wr * 64 + fr, col0 = u.pn * BM + wc * 32 + 8 * fq, sub = u.sub;
#pragma unroll
        for (int ai = 0; ai < 2; ++ai)
#pragma unroll
            for (int m = 0; m < 4; ++m) { const int row = row0 + ai * HALF + m * 16; const bf16_t* gp = P + (size_t)row * NPJ + C_G + col0;
#pragma unroll
                for (int bj = 0; bj < 2; ++bj) {
#ifdef EXP_NOLOAD
                    const u32x4 g1 = (u32x4){0x3f003f00u, 0x3f003f00u, 0x3f003f00u, 0x3f003f00u};
#elif defined(EXP_SC1)
                    u32x4 g1; { const unsigned long long* q = (const unsigned long long*)(gp + sub * 1024 + bj * HALF);
                        const unsigned long long q0 = __hip_atomic_load(q, __ATOMIC_RELAXED, __HIP_MEMORY_SCOPE_SYSTEM), q1 = __hip_atomic_load(q + 1, __ATOMIC_RELAXED, __HIP_MEMORY_SCOPE_SYSTEM);
                        g1.x = (unsigned)q0; g1.y = (unsigned)(q0 >> 32); g1.z = (unsigned)q1; g1.w = (unsigned)(q1 >> 32); }
#elif defined(EXP_DEADLOAD)
                    const u32x4 g1_ = *(const u32x4*)(gp + sub * 1024 + bj * HALF);
#else
                    const u32x4 g1 = *(const u32x4*)(gp + sub * 1024 + bj * HALF);
#endif
#ifdef EXP_DEADLOAD
                    u32x4 g1 = g1_; asm volatile("" : "+v"(g1.x), "+v"(g1.y), "+v"(g1.z), "+v"(g1.w)); g1 = (u32x4){0x3f003f00u, 0x3f003f00u, 0x3f003f00u, 0x3f003f00u};
#endif
                    float f[8];
                    f[0] = bflo(g1.x); f[1] = bfhi(g1.x); f[2] = bflo(g1.y); f[3] = bfhi(g1.y); f[4] = bflo(g1.z); f[5] = bfhi(g1.z); f[6] = bflo(g1.w); f[7] = bfhi(g1.w);
#pragma unroll
                    for (int j = 0; j < 8; ++j) f[j] = f[j] > 1e-30f ? f[j] : 1e-30f;
#ifndef EXP_NODIV
                    if (sub < 2) {
                        const u32x4 g2 = *(const u32x4*)(gp + (sub + 1) * 1024 + bj * HALF);
                        float d[8];
                        d[0] = bflo(g2.x); d[1] = bfhi(g2.x); d[2] = bflo(g2.y); d[3] = bfhi(g2.y); d[4] = bflo(g2.z); d[5] = bfhi(g2.z); d[6] = bflo(g2.w); d[7] = bfhi(g2.w);
#pragma unroll
                        for (int j = 0; j < 8; ++j) { d[j] = d[j] > 1e-30f ? d[j] : 1e-30f; f[j] = f[j] / d[j]; }
                    }
#endif
                    f32x4 v0 = acc[ai][bj][m][0], v1 = acc[ai][bj][m][1];
#pragma unroll
                    for (int j = 0; j < 4; ++j) { v0[j] *= f[j]; v1[j] *= f[4 + j]; }
                    acc[ai][bj][m][0] = v0; acc[ai][bj][m][1] = v1;
                    if (sub == 2) {
                        if (slab) { float* sp = slab + ((size_t)u.ks * MS + (row - MP)) * D + col0 + bj * HALF; *(f32x4*)sp = v0; *(f32x4*)(sp + 4) = v1; }
                        else { u32x4 w; w.x = cvt_pk_bf16(v0[0], v0[1]); w.y = cvt_pk_bf16(v0[2], v0[3]); w.z = cvt_pk_bf16(v1[0], v1[1]); w.w = cvt_pk_bf16(v1[2], v1[3]);
                            *(u32x4*)(O + (size_t)row * D + col0 + bj * HALF) = w; } }
                }
                asm volatile("" ::: "memory"); }
    }
};
struct EpiResid {
    static constexpr bool PERM = false;
    const float* bp; const float* bs; float* out;
    __device__ __forceinline__ void operator()(acc_t& acc, const Unit& u, int wr, int wc, int fr, int fq) const {
        const int row0 = u.pm * BM + wr * 64 + fr, col0 = u.pn * BM + wc * 32 + 4 * fq;
        const bool smp = u.pm >= MP / BM;
#pragma unroll
        for (int ai = 0; ai < 2; ++ai)
#pragma unroll
            for (int m = 0; m < 4; ++m) { const int row = row0 + ai * HALF + m * 16;
                const float* b = smp ? bs + (size_t)(row - MP) * D + col0 : bp + (size_t)row * D + col0; float* o = out + (size_t)row * D + col0;
#pragma unroll
                for (int bj = 0; bj < 2; ++bj)
#pragma unroll
                    for (int n = 0; n < 2; ++n) { const f32x4 bv = *(const f32x4*)(b + bj * HALF + n * 16); *(f32x4*)(o + bj * HALF + n * 16) = bv + acc[ai][bj][m][n]; }
                if (m & 1) asm volatile("" ::: "memory"); }
    }
};

struct EpiSlab {
    static constexpr bool PERM = false;
    float* slab;
    __device__ __forceinline__ void operator()(acc_t& acc, const Unit& u, int wr, int wc, int fr, int fq) const {
        const int row0 = u.pm * BM + wr * 64 + fr - MP, col0 = u.pn * BM + wc * 32 + 4 * fq;
        float* base = slab + (size_t)u.ks * MS * D;
#pragma unroll
        for (int ai = 0; ai < 2; ++ai)
#pragma unroll
            for (int m = 0; m < 4; ++m) { float* o = base + (size_t)(row0 + ai * HALF + m * 16) * D + col0;
#pragma unroll
                for (int bj = 0; bj < 2; ++bj)
#pragma unroll
                    for (int n = 0; n < 2; ++n) *(f32x4*)(o + bj * HALF + n * 16) = acc[ai][bj][m][n]; }
    }
};

template <class Epi>
__device__ __forceinline__ void gemm_phase(PG8_LAS unsigned char* lds, const Gemm g, const Order& S, const Epi& E) {
    int tid_ = threadIdx.x; asm volatile("" : "+v"(tid_));
    const int tid = tid_, wid = __builtin_amdgcn_readfirstlane(tid >> 6), lane = tid & 63, wr = wid >> 2, wc = wid & 3, fr = lane & 15, fq = lane >> 4;
    unsigned voffA[2], voffB[2];
#pragma unroll
    for (int i = 0; i < 2; ++i) { int R, C; stage_rc(tid * 16 + i * 8192, R, C); const int Rb = Epi::PERM ? ((R & ~31) + perm32(R & 31)) : R;
        voffA[i] = (unsigned)(R * g.lda + C) * 2u; voffB[i] = (unsigned)(Rb * g.ldb + C) * 2u; }
    const size_t kstep = (size_t)(BK * 2);
    const size_t hstepA = (size_t)HALF * g.lda * 2, hstepB = (size_t)HALF * g.ldb * 2;
    const size_t tstepA = 2 * hstepA, tstepB = 2 * hstepB;
    const unsigned ldsw = (unsigned)wid * 1024u;
    const int aoff = lds_byte(wr * 64 + fr, fq * 8), boff = lds_byte(wc * 32 + fr, fq * 8);
#define PG8_SA(b, h) (((b) * 2 + (h)) * HTB)
#define PG8_SB(b, h) ((4 + (b) * 2 + (h)) * HTB)
#define PG8_STAGE(bufoff, gbase, voff) do { _Pragma("unroll") for (int _i = 0; _i < 2; ++_i) \
        __builtin_amdgcn_global_load_lds((const unsigned*)((const char*)(gbase) + (voff)[_i]), (PG8_LAS unsigned*)(lds + (bufoff) + ldsw + _i * 8192), 16, 0, 0); } while (0)
#define PG8_LDA(dst, b, h) do { _Pragma("unroll") for (int m = 0; m < 4; ++m) _Pragma("unroll") for (int k = 0; k < 2; ++k) dst[m][k] = *(const PG8_LAS bf16x8*)(lds + PG8_SA(b, h) + aoff + m * 2048 + k * 1024); } while (0)
#define PG8_LDB(dst, b, h) do { _Pragma("unroll") for (int n = 0; n < 2; ++n) _Pragma("unroll") for (int k = 0; k < 2; ++k) dst[n][k] = *(const PG8_LAS bf16x8*)(lds + PG8_SB(b, h) + boff + n * 2048 + k * 1024); } while (0)
#define PG8_MMA(ai, bj, At, Bt) do { __builtin_amdgcn_s_setprio(1); _Pragma("unroll") for (int m = 0; m < 4; ++m) _Pragma("unroll") for (int n = 0; n < 2; ++n) _Pragma("unroll") for (int k = 0; k < 2; ++k) \
        acc[ai][bj][m][n] = __builtin_amdgcn_mfma_f32_16x16x32_bf16(Bt[n][k], At[m][k], acc[ai][bj][m][n], 0, 0, 0); __builtin_amdgcn_s_setprio(0); } while (0)
#define PG8_WAIT_V(n) asm volatile("s_waitcnt vmcnt(" #n ")" ::: "memory")
#define PG8_WAIT_L(n) asm volatile("s_waitcnt lgkmcnt(" #n ")" ::: "memory")
#define PG8_BAR __builtin_amdgcn_s_barrier()
#define PG8_SCHED __builtin_amdgcn_sched_barrier(0)
    Unit cur, nxt; int ui = 0;
    if (!S.next(0, cur)) return;
    f32x4 acc[2][2][4][2];
#pragma unroll
    for (int a = 0; a < 2; ++a)
#pragma unroll
        for (int b = 0; b < 2; ++b)
#pragma unroll
            for (int m = 0; m < 4; ++m)
#pragma unroll
                for (int n = 0; n < 2; ++n) acc[a][b][m][n] = (f32x4){0.f, 0.f, 0.f, 0.f};
    bf16x8 At[4][2], B0[2][2], B1[2][2];
    const char* cA = (const char*)g.A + (size_t)cur.pm * tstepA + (size_t)cur.k0 * 2; const char* cB = (const char*)g.Bt + (size_t)cur.pn * tstepB + (size_t)cur.k0 * 2;
    PG8_STAGE(PG8_SB(0, 0), cB, voffB); PG8_STAGE(PG8_SB(0, 1), cB + hstepB, voffB); PG8_STAGE(PG8_SA(0, 0), cA, voffA); PG8_STAGE(PG8_SA(0, 1), cA + hstepA, voffA);
    if (wr == 1) PG8_BAR;
    PG8_WAIT_V(2); PG8_BAR;
    PG8_STAGE(PG8_SB(1, 0), cB + kstep, voffB); PG8_STAGE(PG8_SA(1, 0), cA + kstep, voffA); PG8_STAGE(PG8_SB(1, 1), cB + hstepB + kstep, voffB);
    PG8_WAIT_V(6); PG8_BAR;
    for (;;) {
        const bool has_next = S.next(ui + 1, nxt);
        const char* nA = has_next ? (const char*)g.A + (size_t)nxt.pm * tstepA + (size_t)nxt.k0 * 2 : cA; const char* nB = has_next ? (const char*)g.Bt + (size_t)nxt.pn * tstepB + (size_t)nxt.k0 * 2 : cB;
        const int nt = cur.nt;
        for (int t = 0; t < nt; t += 2) {
            const bool last = (t == nt - 2);
            const char* a1 = cA + (size_t)(t + 1) * kstep;
            const char* a2 = last ? nA : cA + (size_t)(t + 2) * kstep; const char* b2 = last ? nB : cB + (size_t)(t + 2) * kstep;
            const char* a3 = a2 + kstep; const char* b3 = b2 + kstep;
            PG8_LDB(B0, 0, 0); PG8_LDB(B1, 0, 1); PG8_SCHED; PG8_LDA(At, 0, 0); PG8_STAGE(PG8_SA(1, 1), a1 + hstepA, voffA);
            PG8_WAIT_V(8); PG8_WAIT_L(0); PG8_BAR; PG8_MMA(0, 0, At, B0); PG8_MMA(0, 1, At, B1); PG8_BAR; PG8_SCHED;
            PG8_LDA(At, 0, 1); PG8_STAGE(PG8_SB(0, 0), b2, voffB); PG8_STAGE(PG8_SB(0, 1), b2 + hstepB, voffB); PG8_STAGE(PG8_SA(0, 0), a2, voffA);
            PG8_WAIT_V(8); PG8_WAIT_L(0); PG8_BAR; PG8_MMA(1, 0, At, B0); PG8_MMA(1, 1, At, B1); PG8_BAR; PG8_SCHED;
            PG8_LDB(B0, 1, 0); PG8_LDB(B1, 1, 1); PG8_SCHED; PG8_LDA(At, 1, 0); PG8_STAGE(PG8_SA(0, 1), a2 + hstepA, voffA);
            PG8_WAIT_V(8); PG8_WAIT_L(0); PG8_BAR; PG8_MMA(0, 0, At, B0); PG8_MMA(0, 1, At, B1); PG8_BAR; PG8_SCHED;
            PG8_LDA(At, 1, 1); PG8_STAGE(PG8_SB(1, 0), b3, voffB); PG8_STAGE(PG8_SB(1, 1), b3 + hstepB, voffB); PG8_STAGE(PG8_SA(1, 0), a3, voffA);
            PG8_WAIT_V(8); PG8_WAIT_L(0); PG8_BAR; PG8_MMA(1, 0, At, B0); PG8_MMA(1, 1, At, B1); PG8_BAR; PG8_SCHED;
        }
        if (wr == 0) PG8_BAR;
        E(acc, cur, wr, wc, fr, fq);
        if (!has_next) break;
        if (!cur.keep) {
#pragma unroll
            for (int a = 0; a < 2; ++a)
#pragma unroll
                for (int b = 0; b < 2; ++b)
#pragma unroll
                    for (int m = 0; m < 4; ++m)
#pragma unroll
                        for (int n = 0; n < 2; ++n) acc[a][b][m][n] = (f32x4){0.f, 0.f, 0.f, 0.f};
        }
        cur = nxt; cA = nA; cB = nB; ++ui;
        if (wr == 1) PG8_BAR;
    }
    PG8_WAIT_V(0);
    PG8_BAR;
#undef PG8_SA
#undef PG8_SB
#undef PG8_STAGE
#undef PG8_LDA
#undef PG8_LDB
#undef PG8_MMA
#undef PG8_WAIT_V
#undef PG8_WAIT_L
#undef PG8_BAR
#undef PG8_SCHED
}
}

#define XB_TMO      128
#define XB_XCNT(j)  (256  + 64 * (j))
#define XB_XSUB(j)  (1280 + 64 * (j))
#define XB_XGEN(j)  (2304 + 64 * (j))
#define XB_TOP      3328
#define XB_TOPGEN   3392
#define XCD_BAR_WORDS 3456
#define XB_SPIN_CAP (1u << 20)

__device__ __forceinline__ unsigned xb_ld(unsigned* p)              { return __hip_atomic_load(p, __ATOMIC_RELAXED, __HIP_MEMORY_SCOPE_AGENT); }
__device__ __forceinline__ unsigned xb_add(unsigned* p, unsigned v) { return __hip_atomic_fetch_add(p, v, __ATOMIC_RELAXED, __HIP_MEMORY_SCOPE_AGENT); }
__device__ __forceinline__ unsigned xb_xcc_id() { return (unsigned)__builtin_amdgcn_s_getreg((3 << 11) | 20) & 0xFu; }
#define XB_SPIN(cond, bar) do { unsigned _sp = 0; while (cond) { __builtin_amdgcn_s_sleep(1); \
    if ((++_sp & 255u) == 0u) { if (xb_ld(&(bar)[XB_TMO])) break; if (_sp > XB_SPIN_CAP) { atomicAdd(&(bar)[XB_TMO], 1u); break; } } } } while (0)

struct XcdBarrier { unsigned* bar; unsigned x; volatile LAS unsigned* st; unsigned np; };

__device__ __forceinline__ XcdBarrier xcd_barrier_post(unsigned* bar, volatile LAS unsigned* st, unsigned np, bool member) {
    XcdBarrier b; b.bar = bar; b.x = 0; b.st = st; b.np = np;
    if (member && threadIdx.x == 0) (void)xb_add(&bar[XB_XCNT(xb_xcc_id())], 1u);
    return b;
}
__device__ __forceinline__ void xcd_barrier_complete(unsigned* bar, unsigned x, unsigned G, unsigned& nloc, unsigned& nx) {
    unsigned sum, cnt, mine, sp = 0u;
    for (;;) {
        sum = 0u; cnt = 0u; mine = 0u;
#pragma unroll
        for (unsigned j = 0; j < 16; ++j) { const unsigned c = xb_ld(&bar[XB_XCNT(j)]); sum += c; cnt += (c > 0u) ? 1u : 0u; mine = (j == x) ? c : mine; }
        if (sum == G) break;
        __builtin_amdgcn_s_sleep(1);
        if ((++sp & 255u) == 0u) { if (xb_ld(&bar[XB_TMO])) break; if (sp > XB_SPIN_CAP) { atomicAdd(&bar[XB_TMO], 1u); break; } }
    }
    nloc = mine > 0u ? mine : 1u; nx = cnt > 0u ? cnt : 1u;
}
__device__ __forceinline__ void xcd_barrier(const XcdBarrier& b) {
    asm volatile("s_waitcnt vmcnt(0)" ::: "memory");
    __syncthreads();
    if (threadIdx.x == 0) {
        unsigned* bar = b.bar;
        unsigned xo = 0; asm volatile("s_mov_b32 %0, 0" : "=s"(xo));
        bar += xo;
        const unsigned bx_ = xb_xcc_id();
        __builtin_amdgcn_s_waitcnt(0);
        unsigned nloc = b.st[0], nx = b.st[1];
        if (nloc == 0u) { xcd_barrier_complete(bar, bx_, b.np, nloc, nx); b.st[0] = nloc; b.st[1] = nx; }
        const unsigned old = xb_add(&bar[XB_XSUB(bx_)], 1u);
        const unsigned gen = old / nloc;
        if (old + 1u == (gen + 1u) * nloc) {
            __builtin_amdgcn_fence(__ATOMIC_RELEASE, "agent");
            asm volatile("s_waitcnt vmcnt(0)" ::: "memory");
            const unsigned og = xb_add(&bar[XB_TOP], 1u);
            const unsigned tg = og / nx;
            if (og + 1u == (tg + 1u) * nx) xb_add(&bar[XB_TOPGEN], 1u);
            else XB_SPIN(xb_ld(&bar[XB_TOPGEN]) == tg, bar);
            __builtin_amdgcn_fence(__ATOMIC_ACQUIRE, "agent");
            xb_add(&bar[XB_XGEN(bx_)], 1u);
            asm volatile("s_waitcnt vmcnt(0)" ::: "memory");
        } else {
            XB_SPIN(xb_ld(&bar[XB_XGEN(bx_)]) == gen, bar);
            __builtin_amdgcn_fence(__ATOMIC_ACQUIRE, "agent");
            asm volatile("s_waitcnt vmcnt(0)" ::: "memory");
        }
    }
    __syncthreads();
}

struct Args {
    const float* in[21];
    float* out; unsigned char* ws;
};

__device__ __forceinline__ void transpose_item(const float* W, int ldw, int ncols, bf16* WT, int ldd, int row_off, int col_off, LAS float* scr, int item, int lane) {
    const int nblk = ncols / 32, kb = item / nblk, nb = item % nblk, k0 = 64 * kb, n0 = 32 * nb;
#pragma unroll 8
    for (int i = 0; i < 32; ++i) { const int kk = 2 * i + (lane >> 5); scr[kk * 33 + (lane & 31)] = W[(size_t)(k0 + kk) * ldw + n0 + (lane & 31)]; }
    LDS_WAIT(); asm volatile("" ::: "memory");
    const int c = lane & 7;
#pragma unroll
    for (int j = 0; j < 4; ++j) { const int n = (lane >> 3) + 8 * j; const LAS float* s = scr + (8 * c) * 33 + n;
        v4u o; o.x = pk2(s[0 * 33], s[1 * 33]); o.y = pk2(s[2 * 33], s[3 * 33]); o.z = pk2(s[4 * 33], s[5 * 33]); o.w = pk2(s[6 * 33], s[7 * 33]);
        *(GAS v4u*)(WT + (size_t)(row_off + n0 + n) * ldd + col_off + k0 + 8 * c) = o; }
    LDS_WAIT(); asm volatile("" ::: "memory");
}

__device__ __forceinline__ void convert_weights(const Args& a, LAS unsigned char* lds, int vcu, int G) {
    const int tid = opaque_tid(), lane = tid & 63, wave = __builtin_amdgcn_readfirstlane(tid >> 6), gw = vcu * NWAVES + wave, NGW = G * NWAVES;
    LAS float* scr = (LAS float*)(lds + wave * 16384);
    constexpr int I_IN1 = 16 * 96, I_IN2 = 16 * 144, I_BA = 16 * 32, I_BB = 8 * 32, I_BC = 8 * 32, I_O = 16 * 32, I_F1 = 16 * 128, I_F2 = 64 * 32;
    constexpr int PER_LAYER = I_IN1 + I_IN2 + I_BA + I_BB + I_BC + I_O + I_F1 + I_F2;
    for (int it = gw; it < 2 * PER_LAYER; it += NGW) {
        const int l = it / PER_LAYER; int r = it - l * PER_LAYER;
        unsigned char* wl = a.ws + WS_W + (size_t)l * W_LAYER;
        const float* w_in = a.in[5] + (size_t)l * D * IN_COLS;
        if (r < I_IN1) { transpose_item(w_in, IN_COLS, 3072, (bf16*)(wl + W_IN), D, 0, 0, scr, r, lane); continue; } r -= I_IN1;
        if (r < I_IN2) { transpose_item(w_in + 3088, IN_COLS, 4608, (bf16*)(wl + W_IN), D, 3072, 0, scr, r, lane); continue; } r -= I_IN2;
        if (r < I_BA) { transpose_item(a.in[13] + (size_t)l * 1024 * 1024, 1024, 1024, (bf16*)(wl + W_BR), 2048, 0, 0, scr, r, lane); continue; } r -= I_BA;
        if (r < I_BB) { transpose_item(a.in[14] + (size_t)l * 512 * 1024, 1024, 1024, (bf16*)(wl + W_BR), 2048, 0, 1024, scr, r, lane); continue; } r -= I_BB;
        if (r < I_BC) { transpose_item(a.in[15] + (size_t)l * 512 * 1024, 1024, 1024, (bf16*)(wl + W_BR), 2048, 0, 1536, scr, r, lane); continue; } r -= I_BC;
        if (r < I_O) { transpose_item(a.in[16] + (size_t)l * 1024 * 1024, 1024, 1024, (bf16*)(wl + W_OUT), 1024, 0, 0, scr, r, lane); continue; } r -= I_O;
        if (r < I_F1) { transpose_item(a.in[18] + (size_t)l * 1024 * FF, FF, FF, (bf16*)(wl + W_FF1), 1024, 0, 0, scr, r, lane); continue; } r -= I_F1;
        transpose_item(a.in[19] + (size_t)l * FF * 1024, 1024, 1024, (bf16*)(wl + W_FF2), FF, 0, 0, scr, r, lane);
    }
}

template <int MODE>
__device__ __forceinline__ void norm_phase(LAS unsigned char* lds, int vcu, int G,
                                           const float* hp, const float* hs, const float* w, bf16* HN, float* GLOG, float* outf,
                                           const float* w_in_l, const float* w_gk2_l, const float* b_gk_l, int mlo = 0, int mhi = M) {
    const int tid = opaque_tid(), lane = tid & 63, wave = __builtin_amdgcn_readfirstlane(tid >> 6), gw = vcu * NWAVES + wave, NGW = G * NWAVES;
    LAS float* Wg = (LAS float*)lds;
    LAS float* Wk = Wg + 16 * 1024;
    if (MODE == 1) {
        for (int idx = tid; idx < 16 * 1024; idx += 512) { const int k = idx >> 4, c = idx & 15; Wg[c * 1024 + k] = w_in_l[(size_t)k * IN_COLS + 3072 + c]; }
        for (int idx = tid; idx < 16 * 512; idx += 512) Wk[idx] = w_gk2_l[idx];
        __syncthreads();
    }
    f32x4 wv[4];
#pragma unroll
    for (int j = 0; j < 4; ++j) wv[j] = *(const f32x4*)(w + 4 * lane + 256 * j);
    for (int m = mlo + gw; m < mhi; m += NGW) {
        const float* xr = (m < MP) ? hp + (size_t)m * D : hs + (size_t)(m - MP) * D;
        f32x4 v[4]; float ss = 0.f;
#pragma unroll
        for (int j = 0; j < 4; ++j) { v[j] = *(const f32x4*)(xr + 4 * lane + 256 * j); ss += (v[j].x * v[j].x + v[j].y * v[j].y) + (v[j].z * v[j].z + v[j].w * v[j].w); }
        const float r = 1.0f / sqrtf(wave_sum(ss) * (1.0f / D) + EPS);
#pragma unroll
        for (int j = 0; j < 4; ++j) v[j] = v[j] * r * wv[j];
        if (MODE == 2) {
#pragma unroll
            for (int j = 0; j < 4; ++j) *(f32x4*)(outf + (size_t)m * D + 4 * lane + 256 * j) = v[j];
        } else {
#pragma unroll
            for (int j = 0; j < 4; ++j) { v2u o; o.x = pk2(v[j].x, v[j].y); o.y = pk2(v[j].z, v[j].w); *(v2u*)(HN + (size_t)m * D + 4 * lane + 256 * j) = o; }
        }
        if (MODE == 1) {
            float gl[16];
#pragma unroll
            for (int c = 0; c < 16; ++c) { float p = 0.f;
#pragma unroll
                for (int j = 0; j < 4; ++j) { const f32x4 wg = *(const LAS f32x4*)(Wg + c * 1024 + 4 * lane + 256 * j); p += (v[j].x * wg.x + v[j].y * wg.y) + (v[j].z * wg.z + v[j].w * wg.w); }
                gl[c] = wave_sum(p); if ((c & 3) == 3) asm volatile("" ::: "memory"); }
#pragma unroll
            for (int hb = 0; hb < 2; ++hb) { const int d0 = 4 * lane + 256 * hb;
                f32x4 acc = *(const f32x4*)(b_gk_l + d0);
#pragma unroll
                for (int c = 0; c < 16; ++c) { const f32x4 wk = *(const LAS f32x4*)(Wk + c * 512 + d0); acc = acc + wk * gl[c]; }
                f32x4 o;
#pragma unroll
                for (int i = 0; i < 4; ++i) { const float x = acc[i]; const float ls = (x < 0.f ? x : 0.f) - log1pf(__expf(-fabsf(x))); o[i] = ls * (1.0f / 16.0f); }
                *(f32x4*)(GLOG + (size_t)m * 512 + d0) = o; }
        }
    }
    if (MODE == 1) __syncthreads();
}

__device__ __forceinline__ void gla_seq(LAS unsigned char* lds, const bf16* PROJ, const float* GLOG, bf16* MIXOUT, const float* gn,
                                        int row0, int T, int h, const float* S0, float* Sout) {
    const int tid = opaque_tid(), lane = tid & 63, wave = __builtin_amdgcn_readfirstlane(tid >> 6);
    LAS float* qs = (LAS float*)lds;
    LAS float* ks = qs + 16 * 128;
    LAS float* as = ks + 16 * 128;
    LAS float* op = as + 16 * 128;
    const int e = tid & 255, dh = __builtin_amdgcn_readfirstlane(tid >> 8);
    float S[64];
#pragma unroll
    for (int i = 0; i < 64; ++i) S[i] = S0 ? S0[(size_t)(dh * 64 + i) * 256 + e] : 0.f;
    const int TB = T < 16 ? T : 16;
    for (int t0 = 0; t0 < T; t0 += TB) {
        __syncthreads();
        for (int idx = tid; idx < TB * 128; idx += 512) { const int t = idx >> 7, d = idx & 127; const size_t row = (size_t)(row0 + t0 + t);
            qs[idx] = bf2f(PROJ[row * NPJ + C_Q + h * 128 + d]); ks[idx] = bf2f(PROJ[row * NPJ + C_K + h * 128 + d]); as[idx] = __expf(GLOG[row * 512 + h * 128 + d]); }
        __syncthreads();
        for (int t = 0; t < TB; ++t) {
            const float v = bf2f(PROJ[(size_t)(row0 + t0 + t) * NPJ + C_V + h * 256 + e]);
            const LAS float* qp = qs + t * 128 + dh * 64; const LAS float* kp = ks + t * 128 + dh * 64; const LAS float* ap = as + t * 128 + dh * 64;
            float o = 0.f;
#pragma unroll
            for (int i4 = 0; i4 < 16; ++i4) { const f32x4 q4 = *(const LAS f32x4*)(qp + 4 * i4), k4 = *(const LAS f32x4*)(kp + 4 * i4), a4 = *(const LAS f32x4*)(ap + 4 * i4);
#pragma unroll
                for (int j = 0; j < 4; ++j) { const int i = 4 * i4 + j; S[i] = a4[j] * S[i] + k4[j] * v; o += q4[j] * S[i]; } }
            op[(t * 2 + dh) * 256 + e] = o;
        }
        __syncthreads();
#pragma unroll
        for (int tt = 0; tt < 2; ++tt) { const int t = wave * 2 + tt;
            if (t < TB) { const int e4 = lane * 4; const size_t row = (size_t)(row0 + t0 + t);
                const f32x4 o = *(const LAS f32x4*)(op + (t * 2) * 256 + e4) + *(const LAS f32x4*)(op + (t * 2 + 1) * 256 + e4);
                const float ss = wave_sum((o.x * o.x + o.y * o.y) + (o.z * o.z + o.w * o.w));
                const float r = 1.0f / sqrtf(ss * (1.0f / 256.0f) + EPS);
                const v2u gw2 = *(const v2u*)(PROJ + row * NPJ + C_GO + h * 256 + e4);
                const f32x4 g4 = *(const f32x4*)(gn + e4);
                const float g0 = bflo(gw2.x), g1 = bfhi(gw2.x), g2 = bflo(gw2.y), g3 = bfhi(gw2.y);
                v2u ow; ow.x = pk2(o.x * r * g4.x * (g0 * sigmoid_f(g0)), o.y * r * g4.y * (g1 * sigmoid_f(g1))); ow.y = pk2(o.z * r * g4.z * (g2 * sigmoid_f(g2)), o.w * r * g4.w * (g3 * sigmoid_f(g3)));
                *(v2u*)(MIXOUT + row * MIXW + h * 256 + e4) = ow; } }
    }
#pragma unroll
    for (int i = 0; i < 64; ++i) Sout[(size_t)(dh * 64 + i) * 256 + e] = S[i];
    __syncthreads();
}

typedef float f32x16 __attribute__((ext_vector_type(16)));
typedef short s16x4 __attribute__((ext_vector_type(4)));
#define MFMA32(a, b, c) __builtin_amdgcn_mfma_f32_32x32x16_bf16((a), (b), (c), 0, 0, 0)
constexpr int GL_QG = 0, GL_KG = 17408, GL_KD = 34816, GL_VV = 55296, GL_PP = 92160, GL_DEC = 101376, GL_TOT = 101888, GL_END = 110080;
constexpr int GL_SQ = 272, GL_SKD = 320, GL_SV = 576, GL_SP = 144, GL_SO = 1040;
static_assert(GL_END <= RING_BYTES && 64 * GL_SO <= GL_PP, "gla lds map");
__device__ __forceinline__ bf16x8 tr_frag(LAS unsigned char* p, int rowstride4) {
    const s16x4 lo = __builtin_amdgcn_ds_read_tr16_b64_v4i16((LAS s16x4*)p), hi = __builtin_amdgcn_ds_read_tr16_b64_v4i16((LAS s16x4*)(p + rowstride4));
    return __builtin_shufflevector(lo, hi, 0, 1, 2, 3, 4, 5, 6, 7);
}
template <bool FULL>
__device__ __forceinline__ void gla_chunked(LAS unsigned char* lds, const bf16* PROJ, const float* GLOG, bf16* MIXOUT, const float* gn, int row0, int nchunks, int h,
                                            int nprev, const float* Sloc_prev, const float* Dlog_prev, float* Sout, float* Dlog_out) {
    const int tid = opaque_tid(), lane = tid & 63, w = __builtin_amdgcn_readfirstlane(tid >> 6), r = lane & 31, hh = lane >> 5;
    const int tq = (lane & 15) >> 2, tp = lane & 3, tblk = (lane >> 4) & 1;
    const int dq = tid & 31, seg = tid >> 5;
    f32x16 S[4];
#pragma unroll
    for (int b = 0; b < 4; ++b)
#pragma unroll
        for (int i = 0; i < 16; ++i) S[b][i] = 0.f;
    for (int pi = 0; pi < nprev; ++pi) {
        int lo_ = 4 * hh * 256 + 32 * w + r; asm volatile("" : "+v"(lo_));
        const float* sp = Sloc_prev + (size_t)pi * 128 * 256 + lo_; const float* dp = Dlog_prev + pi * 128 + 4 * hh;
#pragma unroll
        for (int b = 0; b < 4; ++b) {
#pragma unroll
            for (int i = 0; i < 16; ++i) { const int dr = 32 * b + (i & 3) + 8 * (i >> 2); S[b][i] = __expf(dp[dr]) * S[b][i] + sp[dr * 256]; }
            asm volatile("" ::: "memory"); }
    }
    f32x4 dsum = (f32x4){0.f, 0.f, 0.f, 0.f};
    f32x4 gr[4]; v2u qv[4], kv[4]; v4u vv[4];
#define GLA_LOAD_RAW(R0) do { _Pragma("unroll") for (int i = 0; i < 4; ++i) { gr[i] = *(const f32x4*)(GLOG + (size_t)((R0) + 4 * seg + i) * 512 + h * 128 + 4 * dq); \
        const bf16* pr = PROJ + (size_t)((R0) + 4 * seg + i) * NPJ + h * 128 + 4 * dq; qv[i] = *(const v2u*)(pr + C_Q); kv[i] = *(const v2u*)(pr + C_K); } } while (0)
#define GLA_LOAD_V(R0) do { _Pragma("unroll") for (int i = 0; i < 4; ++i) { \
        const int idx = tid + 512 * i, sr = idx >> 5, ch = idx & 31; vv[i] = *(const v4u*)(PROJ + (size_t)((R0) + sr) * NPJ + C_V + h * 256 + ch * 8); } } while (0)
    GLA_LOAD_RAW(row0); GLA_LOAD_V(row0);
    for (int c = 0; c < nchunks; ++c) {
        const int r0 = row0 + 64 * c;
        {
            f32x4 cs[4];
#pragma unroll
            for (int i = 0; i < 4; ++i) { cs[i] = gr[i]; if (i) cs[i] = cs[i] + cs[i - 1]; }
            *(LAS f32x4*)(lds + GL_TOT + (seg * 128 + 4 * dq) * 4) = cs[3];
            LDS_BARRIER();
            f32x4 pre = (f32x4){0.f, 0.f, 0.f, 0.f}, tot = (f32x4){0.f, 0.f, 0.f, 0.f};
#pragma unroll
            for (int s2 = 0; s2 < 16; ++s2) { const f32x4 tv = *(const LAS f32x4*)(lds + GL_TOT + (s2 * 128 + 4 * dq) * 4); tot = tot + tv; if (s2 < seg) pre = pre + tv; }
#pragma unroll
            for (int i = 0; i < 4; ++i) { const f32x4 b = pre + cs[i]; const int t = 4 * seg + i;
                float q4[4] = {bflo(qv[i].x), bfhi(qv[i].x), bflo(qv[i].y), bfhi(qv[i].y)}, k4[4] = {bflo(kv[i].x), bfhi(kv[i].x), bflo(kv[i].y), bfhi(kv[i].y)};
                float qg[4], kg[4], kd[4];
#pragma unroll
                for (int j = 0; j < 4; ++j) { qg[j] = q4[j] * __expf(b[j]); kg[j] = k4[j] * __expf(-b[j]); kd[j] = k4[j] * __expf(tot[j] - b[j]); }
                v2u o;
                if (FULL) { o.x = pg8::cvt_pk_bf16(qg[0], qg[1]); o.y = pg8::cvt_pk_bf16(qg[2], qg[3]); *(LAS v2u*)(lds + GL_QG + t * GL_SQ + dq * 8) = o;
                            o.x = pg8::cvt_pk_bf16(kg[0], kg[1]); o.y = pg8::cvt_pk_bf16(kg[2], kg[3]); *(LAS v2u*)(lds + GL_KG + t * GL_SQ + dq * 8) = o; }
                o.x = pg8::cvt_pk_bf16(kd[0], kd[1]); o.y = pg8::cvt_pk_bf16(kd[2], kd[3]); *(LAS v2u*)(lds + GL_KD + t * GL_SKD + dq * 8) = o; }
            dsum = dsum + tot;
            if (seg == 0) { f32x4 dc; dc.x = __expf(tot.x); dc.y = __expf(tot.y); dc.z = __expf(tot.z); dc.w = __expf(tot.w); *(LAS f32x4*)(lds + GL_DEC + dq * 16) = dc; }
#pragma unroll
            for (int i = 0; i < 4; ++i) { const int idx = tid + 512 * i, sr = idx >> 5, ch = idx & 31; *(LAS v4u*)(lds + GL_VV + sr * GL_SV + ch * 16) = vv[i]; }
            if (c + 1 < nchunks) GLA_LOAD_RAW(r0 + 64);
        }
        LDS_BARRIER();
        for (int qa_ = 0; qa_ < REP_ATT; ++qa_) {
        if (FULL && w < 3) {
            const int bi = w > 0 ? 1 : 0, bj = w > 1 ? 1 : 0;
            f32x16 acc;
#pragma unroll
            for (int i = 0; i < 16; ++i) acc[i] = 0.f;
#pragma unroll
            for (int ks = 0; ks < 8; ++ks) {
                const bf16x8 a = *(const LAS bf16x8*)(lds + GL_QG + (32 * bi + r) * GL_SQ + (16 * ks + 8 * hh) * 2);
                const bf16x8 b = *(const LAS bf16x8*)(lds + GL_KG + (32 * bj + r) * GL_SQ + (16 * ks + 8 * hh) * 2);
                acc = MFMA32(a, b, acc); }
            int pbase = GL_PP + (32 * bi + 4 * hh) * GL_SP + (32 * bj + r) * 2; asm volatile("" : "+v"(pbase));
#pragma unroll
            for (int i = 0; i < 16; ++i) { const int tl = (i & 3) + 8 * (i >> 2) + 4 * hh; float v = acc[i]; if (bi == bj && r > tl) v = 0.f;
                *(LAS unsigned short*)(lds + pbase + ((i & 3) + 8 * (i >> 2)) * GL_SP) = (unsigned short)f2bf(v); }
        }
        if (FULL) LDS_BARRIER();
        }
        f32x16 o[2];
        {
            bf16x8 Bv[4];
#pragma unroll
            for (int ks = 0; ks < 4; ++ks) Bv[ks] = tr_frag(lds + GL_VV + (16 * ks + 8 * hh + tq) * GL_SV + (4 * w + 2 * tblk + (tp >> 1)) * 16 + 8 * (tp & 1), 4 * GL_SV);
            for (int qm_ = 0; qm_ < REP_OMM; ++qm_)
#pragma unroll
            for (int rb = 0; rb < (FULL ? 2 : 0); ++rb) {
#pragma unroll
                for (int i = 0; i < 16; ++i) o[rb][i] = 0.f;
#pragma unroll
                for (int b = 0; b < 4; ++b)
#pragma unroll
                    for (int s2 = 0; s2 < 2; ++s2) {
                        const LAS unsigned char* ap = lds + GL_QG + (32 * rb + r) * GL_SQ + (32 * b + 16 * s2 + 4 * hh) * 2;
                        const s16x4 lo = *(const LAS s16x4*)ap, hi = *(const LAS s16x4*)(ap + 16);
                        const bf16x8 a = __builtin_shufflevector(lo, hi, 0, 1, 2, 3, 4, 5, 6, 7);
                        v4u pk; pk.x = pg8::cvt_pk_bf16(S[b][8 * s2 + 0], S[b][8 * s2 + 1]); pk.y = pg8::cvt_pk_bf16(S[b][8 * s2 + 2], S[b][8 * s2 + 3]);
                        pk.z = pg8::cvt_pk_bf16(S[b][8 * s2 + 4], S[b][8 * s2 + 5]); pk.w = pg8::cvt_pk_bf16(S[b][8 * s2 + 6], S[b][8 * s2 + 7]);
                        o[rb] = MFMA32(a, __builtin_bit_cast(bf16x8, pk), o[rb]); if (s2) asm volatile("" ::: "memory"); }
#pragma unroll
                for (int ks = 0; ks < 4; ++ks) if (ks < 2 || rb == 1) {
                    const bf16x8 a = *(const LAS bf16x8*)(lds + GL_PP + (32 * rb + r) * GL_SP + (16 * ks + 8 * hh) * 2);
                    o[rb] = MFMA32(a, Bv[ks], o[rb]); }
            }
#pragma unroll
            for (int b = 0; b < 4; ++b) {
#pragma unroll
                for (int g4 = 0; g4 < 4; ++g4) { const f32x4 dc = *(const LAS f32x4*)(lds + GL_DEC + (32 * b + 8 * g4 + 4 * hh) * 4);
#pragma unroll
                    for (int j = 0; j < 4; ++j) S[b][4 * g4 + j] *= dc[j]; }
#pragma unroll
                for (int ks = 0; ks < 4; ++ks) {
                    const bf16x8 a = tr_frag(lds + GL_KD + (16 * ks + 8 * hh + tq) * GL_SKD + (4 * b + 2 * tblk + (tp >> 1)) * 16 + 8 * (tp & 1), 4 * GL_SKD);
                    S[b] = MFMA32(a, Bv[ks], S[b]); }
                asm volatile("" ::: "memory");
            }
        }
        LDS_BARRIER();
        if (!FULL) { if (c + 1 < nchunks) GLA_LOAD_V(r0 + 64); }
        if (FULL) for (int qe_ = 0; qe_ < REP_EPI; ++qe_) {
        v4u gpre[4];
#pragma unroll
        for (int i = 0; i < 4; ++i) gpre[i] = *(const v4u*)(PROJ + (size_t)(r0 + (tid >> 3)) * NPJ + C_GO + h * 256 + (tid & 7) * 32 + 8 * i);
        int obase = 4 * hh * GL_SO + (32 * w + r) * 4; asm volatile("" : "+v"(obase));
#pragma unroll
        for (int rb = 0; rb < 2; ++rb)
#pragma unroll
            for (int i = 0; i < 16; ++i) *(LAS float*)(lds + obase + (32 * rb + (i & 3) + 8 * (i >> 2)) * GL_SO) = o[rb][i];
        if (c + 1 < nchunks) GLA_LOAD_V(r0 + 64);
        LDS_BARRIER();
        {
            const int t = tid >> 3, sg = tid & 7, e0 = sg * 32; const size_t row = (size_t)(r0 + t);
            int e0g = e0; asm volatile("" : "+v"(e0g));
            f32x4 ov[8]; float ss = 0.f;
#pragma unroll
            for (int i = 0; i < 8; ++i) { ov[i] = *(const LAS f32x4*)(lds + t * GL_SO + (e0 + 4 * i) * 4); ss += (ov[i].x * ov[i].x + ov[i].y * ov[i].y) + (ov[i].z * ov[i].z + ov[i].w * ov[i].w); }
            ss += __shfl_xor(ss, 1); ss += __shfl_xor(ss, 2); ss += __shfl_xor(ss, 4);
            const float rn = 1.0f / sqrtf(ss * (1.0f / 256.0f) + EPS);
#pragma unroll
            for (int i = 0; i < 4; ++i) { const v4u gw4 = gpre[i];
                const f32x4 ga = *(const f32x4*)(gn + e0g + 8 * i), gb = *(const f32x4*)(gn + e0g + 8 * i + 4);
                const float g0 = bflo(gw4.x), g1 = bfhi(gw4.x), g2 = bflo(gw4.y), g3 = bfhi(gw4.y), g4 = bflo(gw4.z), g5 = bfhi(gw4.z), g6 = bflo(gw4.w), g7 = bfhi(gw4.w);
                const f32x4 oa = ov[2 * i], ob = ov[2 * i + 1]; v4u ow;
                ow.x = pg8::cvt_pk_bf16(oa.x * rn * ga.x * (g0 * sigmoid_f(g0)), oa.y * rn * ga.y * (g1 * sigmoid_f(g1)));
                ow.y = pg8::cvt_pk_bf16(oa.z * rn * ga.z * (g2 * sigmoid_f(g2)), oa.w * rn * ga.w * (g3 * sigmoid_f(g3)));
                ow.z = pg8::cvt_pk_bf16(ob.x * rn * gb.x * (g4 * sigmoid_f(g4)), ob.y * rn * gb.y * (g5 * sigmoid_f(g5)));
                ow.w = pg8::cvt_pk_bf16(ob.z * rn * gb.z * (g6 * sigmoid_f(g6)), ob.w * rn * gb.w * (g7 * sigmoid_f(g7)));
                *(v4u*)(MIXOUT + row * MIXW + h * 256 + e0 + 8 * i) = ow; }
        }
        LDS_BARRIER();
        }
    }
    if (Sout) {
        int lo_ = 4 * hh * 256 + 32 * w + r; asm volatile("" : "+v"(lo_)); float* sop = Sout + lo_;
#pragma unroll
        for (int b = 0; b < 4; ++b) {
#pragma unroll
            for (int i = 0; i < 16; ++i) sop[(32 * b + (i & 3) + 8 * (i >> 2)) * 256] = S[b][i];
            asm volatile("" ::: "memory"); }
    }
    if (Dlog_out && seg == 0) *(f32x4*)(Dlog_out + 4 * dq) = dsum;
#undef GLA_LOAD_RAW
#undef GLA_LOAD_V
}

__device__ __forceinline__ void gla_sample(LAS unsigned char* lds, const bf16* PROJ, const float* GLOG, bf16* MIXOUT, const float* gn, int r0, int h, const float* S0, float* Sout) {
    const int tid = opaque_tid(), lane = tid & 63, w = __builtin_amdgcn_readfirstlane(tid >> 6), r = lane & 31, hh = lane >> 5;
    const int tq = (lane & 15) >> 2, tp = lane & 3, tblk = (lane >> 4) & 1;
    if (tid < 32) {
        const int dq = tid; f32x4 b = (f32x4){0.f, 0.f, 0.f, 0.f}, bs[8];
#pragma unroll
        for (int t = 0; t < 8; ++t) { b = b + *(const f32x4*)(GLOG + (size_t)(r0 + t) * 512 + h * 128 + 4 * dq); bs[t] = b; }
#pragma unroll
        for (int t = 0; t < 8; ++t) { const bf16* pr = PROJ + (size_t)(r0 + t) * NPJ + h * 128 + 4 * dq; const v2u qv = *(const v2u*)(pr + C_Q), kv = *(const v2u*)(pr + C_K);
            const float q4[4] = {bflo(qv.x), bfhi(qv.x), bflo(qv.y), bfhi(qv.y)}, k4[4] = {bflo(kv.x), bfhi(kv.x), bflo(kv.y), bfhi(kv.y)};
            float qg[4], kg[4], kd[4];
#pragma unroll
            for (int j = 0; j < 4; ++j) { qg[j] = q4[j] * __expf(bs[t][j]); kg[j] = k4[j] * __expf(-bs[t][j]); kd[j] = k4[j] * __expf(b[j] - bs[t][j]); }
            v2u o; o.x = pg8::cvt_pk_bf16(qg[0], qg[1]); o.y = pg8::cvt_pk_bf16(qg[2], qg[3]); *(LAS v2u*)(lds + GL_QG + t * GL_SQ + dq * 8) = o;
            o.x = pg8::cvt_pk_bf16(kg[0], kg[1]); o.y = pg8::cvt_pk_bf16(kg[2], kg[3]); *(LAS v2u*)(lds + GL_KG + t * GL_SQ + dq * 8) = o;
            o.x = pg8::cvt_pk_bf16(kd[0], kd[1]); o.y = pg8::cvt_pk_bf16(kd[2], kd[3]); *(LAS v2u*)(lds + GL_KD + t * GL_SKD + dq * 8) = o; }
        f32x4 dc; dc.x = __expf(b.x); dc.y = __expf(b.y); dc.z = __expf(b.z); dc.w = __expf(b.w); *(LAS f32x4*)(lds + GL_DEC + dq * 16) = dc;
    } else if (tid >= 256) {
        const int idx = tid - 256, sr = idx >> 5, ch = idx & 31;
        *(LAS v4u*)(lds + GL_VV + sr * GL_SV + ch * 16) = *(const v4u*)(PROJ + (size_t)(r0 + sr) * NPJ + C_V + h * 256 + ch * 8);
    } else if (tid >= 64) {
        const v4u z = (v4u){0u, 0u, 0u, 0u};
        for (int idx = tid - 64; idx < 256 + 128; idx += 192) {
            if (idx < 256) *(LAS v4u*)(lds + GL_VV + (8 + (idx >> 5)) * GL_SV + (idx & 31) * 16) = z;
            else { const int k2 = idx - 256; *(LAS v4u*)(lds + GL_KD + (8 + (k2 >> 4)) * GL_SKD + (k2 & 15) * 16) = z; } }
    }
    asm volatile("" ::: "memory");
    int lane_off = 4 * hh * 256 + 32 * w + r; asm volatile("" : "+v"(lane_off));
    const float* s0p = S0 + lane_off; float* sop = Sout + lane_off;
    f32x16 S[4];
#pragma unroll
    for (int b = 0; b < 4; ++b) {
#pragma unroll
        for (int i = 0; i < 16; ++i) S[b][i] = s0p[(32 * b + (i & 3) + 8 * (i >> 2)) * 256];
        asm volatile("" ::: "memory"); }
    LDS_BARRIER();
    if (w == 0) {
        f32x16 acc;
#pragma unroll
        for (int i = 0; i < 16; ++i) acc[i] = 0.f;
#pragma unroll
        for (int ks = 0; ks < 8; ++ks) {
            const bf16x8 a = *(const LAS bf16x8*)(lds + GL_QG + r * GL_SQ + (16 * ks + 8 * hh) * 2);
            const bf16x8 b = *(const LAS bf16x8*)(lds + GL_KG + r * GL_SQ + (16 * ks + 8 * hh) * 2);
            acc = MFMA32(a, b, acc); }
#pragma unroll
        for (int i = 0; i < 16; ++i) { const int tl = (i & 3) + 8 * (i >> 2) + 4 * hh; float v = acc[i]; if (r > tl || tl >= 8) v = 0.f;
            if (r < 16) *(LAS unsigned short*)(lds + GL_PP + tl * GL_SP + r * 2) = (unsigned short)f2bf(v); }
    }
    LDS_BARRIER();
    f32x16 o;
    {
        const bf16x8 Bv = tr_frag(lds + GL_VV + (8 * hh + tq) * GL_SV + (4 * w + 2 * tblk + (tp >> 1)) * 16 + 8 * (tp & 1), 4 * GL_SV);
#pragma unroll
        for (int i = 0; i < 16; ++i) o[i] = 0.f;
#pragma unroll
        for (int b = 0; b < 4; ++b)
#pragma unroll
            for (int s2 = 0; s2 < 2; ++s2) {
                const LAS unsigned char* ap = lds + GL_QG + r * GL_SQ + (32 * b + 16 * s2 + 4 * hh) * 2;
                const s16x4 lo = *(const LAS s16x4*)ap, hi = *(const LAS s16x4*)(ap + 16);
                const bf16x8 a = __builtin_shufflevector(lo, hi, 0, 1, 2, 3, 4, 5, 6, 7);
                v4u pk; pk.x = pg8::cvt_pk_bf16(S[b][8 * s2 + 0], S[b][8 * s2 + 1]); pk.y = pg8::cvt_pk_bf16(S[b][8 * s2 + 2], S[b][8 * s2 + 3]);
                pk.z = pg8::cvt_pk_bf16(S[b][8 * s2 + 4], S[b][8 * s2 + 5]); pk.w = pg8::cvt_pk_bf16(S[b][8 * s2 + 6], S[b][8 * s2 + 7]);
                o = MFMA32(a, __builtin_bit_cast(bf16x8, pk), o); }
        { const bf16x8 a = *(const LAS bf16x8*)(lds + GL_PP + r * GL_SP + (8 * hh) * 2); o = MFMA32(a, Bv, o); }
#pragma unroll
        for (int b = 0; b < 4; ++b) {
#pragma unroll
            for (int g4 = 0; g4 < 4; ++g4) { const f32x4 dc = *(const LAS f32x4*)(lds + GL_DEC + (32 * b + 8 * g4 + 4 * hh) * 4);
#pragma unroll
                for (int j = 0; j < 4; ++j) S[b][4 * g4 + j] *= dc[j]; }
            const bf16x8 a = tr_frag(lds + GL_KD + (8 * hh + tq) * GL_SKD + (4 * b + 2 * tblk + (tp >> 1)) * 16 + 8 * (tp & 1), 4 * GL_SKD);
            S[b] = MFMA32(a, Bv, S[b]); }
    }
    LDS_BARRIER();
#pragma unroll
    for (int i = 0; i < 4; ++i) *(LAS float*)(lds + (i + 4 * hh) * GL_SO + (32 * w + r) * 4) = o[i];
    LDS_BARRIER();
    if (tid < 64) {
        const int t = tid >> 3, sg = tid & 7, e0 = sg * 32; const size_t row = (size_t)(r0 + t);
        f32x4 ov[8]; float ss = 0.f;
#pragma unroll
        for (int i = 0; i < 8; ++i) { ov[i] = *(const LAS f32x4*)(lds + t * GL_SO + (e0 + 4 * i) * 4); ss += (ov[i].x * ov[i].x + ov[i].y * ov[i].y) + (ov[i].z * ov[i].z + ov[i].w * ov[i].w); }
        ss += __shfl_xor(ss, 1); ss += __shfl_xor(ss, 2); ss += __shfl_xor(ss, 4);
        const float rn = 1.0f / sqrtf(ss * (1.0f / 256.0f) + EPS);
#pragma unroll
        for (int i = 0; i < 4; ++i) { const v4u gw4 = *(const v4u*)(PROJ + row * NPJ + C_GO + h * 256 + e0 + 8 * i);
            const f32x4 ga = *(const f32x4*)(gn + e0 + 8 * i), gb = *(const f32x4*)(gn + e0 + 8 * i + 4);
            const float g0 = bflo(gw4.x), g1 = bfhi(gw4.x), g2 = bflo(gw4.y), g3 = bfhi(gw4.y), g4 = bflo(gw4.z), g5 = bfhi(gw4.z), g6 = bflo(gw4.w), g7 = bfhi(gw4.w);
            const f32x4 oa = ov[2 * i], ob = ov[2 * i + 1]; v4u ow;
            ow.x = pg8::cvt_pk_bf16(oa.x * rn * ga.x * (g0 * sigmoid_f(g0)), oa.y * rn * ga.y * (g1 * sigmoid_f(g1)));
            ow.y = pg8::cvt_pk_bf16(oa.z * rn * ga.z * (g2 * sigmoid_f(g2)), oa.w * rn * ga.w * (g3 * sigmoid_f(g3)));
            ow.z = pg8::cvt_pk_bf16(ob.x * rn * gb.x * (g4 * sigmoid_f(g4)), ob.y * rn * gb.y * (g5 * sigmoid_f(g5)));
            ow.w = pg8::cvt_pk_bf16(ob.z * rn * gb.z * (g6 * sigmoid_f(g6)), ob.w * rn * gb.w * (g7 * sigmoid_f(g7)));
            *(v4u*)(MIXOUT + row * MIXW + h * 256 + e0 + 8 * i) = ow; }
    }
#pragma unroll
    for (int b = 0; b < 4; ++b) {
#pragma unroll
        for (int i = 0; i < 16; ++i) sop[(32 * b + (i & 3) + 8 * (i >> 2)) * 256] = S[b][i];
        asm volatile("" ::: "memory"); }
    LDS_BARRIER();
}

constexpr int PL_W = 0, PL_A = 40960, PL_SW = 320, PL_SA = 272;
__device__ __forceinline__ void mat128_to_lds(LAS unsigned char* lds, int off, int stride, const float* src, bool tril) {
    const int tid = opaque_tid();
#pragma unroll
    for (int i = 0; i < 8; ++i) { const int idx = tid + 512 * i, row = idx >> 5, c4 = idx & 31; f32x4 v = *(const f32x4*)(src + row * 128 + 4 * c4);
        if (tril) { if (4 * c4 + 0 > row) v.x = 0.f; if (4 * c4 + 1 > row) v.y = 0.f; if (4 * c4 + 2 > row) v.z = 0.f; if (4 * c4 + 3 > row) v.w = 0.f; }
        v2u o; o.x = pg8::cvt_pk_bf16(v.x, v.y); o.y = pg8::cvt_pk_bf16(v.z, v.w); *(LAS v2u*)(lds + off + row * stride + c4 * 8) = o; }
}
template <int G>
__device__ __forceinline__ void pool_tile(LAS unsigned char* lds, const bf16* PROJ, bf16* MIXOUT, const float* scale_g, const float* hist_l, int row0, int pos0, bool sample, int seq0) {
    const int tid = opaque_tid(), lane = tid & 63, w = __builtin_amdgcn_readfirstlane(tid >> 6), r = lane & 31, hh = lane >> 5;
    const int tq = (lane & 15) >> 2, tp = lane & 3, tblk = (lane >> 4) & 1;
    const int c = tid & 127, tqr = tid >> 7, col = C_XP + G * 128 + c;
    constexpr int WIN = 2 << G;
    if (!sample) {
        float P[32]; P[0] = 0.f; float xs[31];
#pragma unroll
        for (int i = 0; i < 31; ++i) { const int p = pos0 + 16 * tqr - 15 + i; xs[i] = p >= 0 ? bf2f(PROJ[(size_t)(row0 - pos0 + p) * NPJ + col]) : 0.f; P[i + 1] = P[i] + xs[i]; }
#pragma unroll
        for (int tt = 0; tt < 16; ++tt) { const int pos = pos0 + 16 * tqr + tt; const int cnt = WIN < pos + 1 ? WIN : pos + 1;
            const float pooled = (P[16 + tt] - P[16 + tt - WIN]) / (float)cnt - xs[15 + tt];
            *(LAS unsigned short*)(lds + PL_A + (16 * tqr + tt) * PL_SA + c * 2) = (unsigned short)f2bf(pooled); }
    } else {
#pragma unroll
        for (int sq = 0; sq < 2; ++sq) { const int seq = seq0 + 2 * tqr + sq;
            float P[24]; P[0] = 0.f; float xs[23];
#pragma unroll
            for (int i = 0; i < 23; ++i) { xs[i] = i < 15 ? hist_l[((size_t)seq * 15 + i) * 512 + G * 128 + c] : bf2f(PROJ[(size_t)(MP + seq * ST + i - 15) * NPJ + col]); P[i + 1] = P[i] + xs[i]; }
#pragma unroll
            for (int tt = 0; tt < 8; ++tt) { const float pooled = (P[16 + tt] - P[16 + tt - WIN]) * (1.0f / (float)WIN) - xs[15 + tt];
                *(LAS unsigned short*)(lds + PL_A + (16 * tqr + 8 * sq + tt) * PL_SA + c * 2) = (unsigned short)f2bf(pooled); } }
    }
    LDS_BARRIER();
    {
        const int rb = w & 1, cb = w >> 1; f32x16 acc;
#pragma unroll
        for (int i = 0; i < 16; ++i) acc[i] = 0.f;
#pragma unroll
        for (int ks = 0; ks < 8; ++ks) {
            const bf16x8 a = *(const LAS bf16x8*)(lds + PL_A + (32 * rb + r) * PL_SA + (16 * ks + 8 * hh) * 2);
            const bf16x8 b = tr_frag(lds + PL_W + (16 * ks + 8 * hh + tq) * PL_SW + (4 * cb + 2 * tblk + (tp >> 1)) * 16 + 8 * (tp & 1), 4 * PL_SW);
            acc = MFMA32(a, b, acc); }
        const float sc = scale_g[32 * cb + r];
#pragma unroll
        for (int i = 0; i < 16; ++i) { const int t = 32 * rb + (i & 3) + 8 * (i >> 2) + 4 * hh;
            MIXOUT[(size_t)(row0 + t) * MIXW + 1024 + G * 128 + 32 * cb + r] = (bf16)f2bf(acc[i] * sc); }
    }
    LDS_BARRIER();
}
constexpr int SG_WT = 0, SG_VI = 34816, SG_SW = 272, SG_SV = 320;
__device__ __forceinline__ void sg_chunk(LAS unsigned char* lds, const bf16* PROJ, bf16* MIXOUT, const float* bs_g, int row0, int g) {
    const int tid = opaque_tid(), lane = tid & 63, w = __builtin_amdgcn_readfirstlane(tid >> 6), r = lane & 31, hh = lane >> 5;
    const int tq = (lane & 15) >> 2, tp = lane & 3, tblk = (lane >> 4) & 1;
#pragma unroll
    for (int i = 0; i < 4; ++i) { const int idx = tid + 512 * i, sr = idx >> 4, ch = idx & 15;
        *(LAS v4u*)(lds + SG_VI + sr * SG_SV + ch * 16) = *(const v4u*)(PROJ + (size_t)(row0 + sr) * NPJ + C_VV + g * 128 + ch * 8); }
    LDS_BARRIER();
    const int dj = w & 3, pair = w >> 2;
#pragma unroll
    for (int pass = 0; pass < 2; ++pass) {
        const int bi = pass == 0 ? pair : 3 - pair, nks = 2 * (bi + 1);
        f32x16 acc;
#pragma unroll
        for (int i = 0; i < 16; ++i) acc[i] = 0.f;
#pragma unroll
        for (int ks = 0; ks < 8; ++ks) if (ks < nks) {
            const bf16x8 a = *(const LAS bf16x8*)(lds + SG_WT + (32 * bi + r) * SG_SW + (16 * ks + 8 * hh) * 2);
            const bf16x8 b = tr_frag(lds + SG_VI + (16 * ks + 8 * hh + tq) * SG_SV + (4 * dj + 2 * tblk + (tp >> 1)) * 16 + 8 * (tp & 1), 4 * SG_SV);
            acc = MFMA32(a, b, acc); }
#pragma unroll
        for (int i = 0; i < 16; ++i) { const int t = 32 * bi + (i & 3) + 8 * (i >> 2) + 4 * hh, d = 32 * dj + r;
            const float u = bf2f(PROJ[(size_t)(row0 + t) * NPJ + C_U + g * 128 + d]);
            MIXOUT[(size_t)(row0 + t) * MIXW + 1536 + g * 128 + d] = (bf16)f2bf(u * (acc[i] + bs_g[t])); }
    }
    LDS_BARRIER();
}

__device__ __forceinline__ void pool_item(LAS unsigned char* lds, const bf16* PROJ, bf16* MIXOUT, const float* wmix, const float* scale, const float* hist  ,
                                          int rowseq0, int tpos0, int nt, int g) {
    const int tid = opaque_tid();
    LAS float* pl = (LAS float*)lds;
    const int w = 2 << g;
    for (int idx = tid; idx < nt * 128; idx += 512) { const int t = idx >> 7, c = idx & 127, pos = tpos0 + t, col = C_XP + g * 128 + c;
        float sum = 0.f;
        for (int i = 0; i < w; ++i) { const int p = pos - i;
            if (p >= 0) sum += bf2f(PROJ[(size_t)(rowseq0 + p) * NPJ + col]);
            else if (hist) sum += hist[(size_t)(15 + p) * 512 + g * 128 + c]; }
        const int cnt = hist ? w : (w < pos + 1 ? w : pos + 1);
        pl[idx] = sum / (float)cnt - bf2f(PROJ[(size_t)(rowseq0 + pos) * NPJ + col]); }
    __syncthreads();
    const int j = tid & 127, tq = __builtin_amdgcn_readfirstlane(tid >> 7), tpq = nt >> 2;
    float acc[4] = {0.f, 0.f, 0.f, 0.f};
    for (int c = 0; c < 128; ++c) { const float wv = wmix[(size_t)(g * 128 + c) * 128 + j];
#pragma unroll
        for (int i = 0; i < 4; ++i) if (i < tpq) acc[i] += pl[(tq * tpq + i) * 128 + c] * wv; }
    const float sc = scale[g * 128 + j];
#pragma unroll
    for (int i = 0; i < 4; ++i) if (i < tpq) MIXOUT[(size_t)(rowseq0 + tpos0 + tq * tpq + i) * MIXW + 1024 + g * 128 + j] = (bf16)f2bf(acc[i] * sc);
    __syncthreads();
}

__device__ __forceinline__ void sg_item(LAS unsigned char* lds, const bf16* PROJ, bf16* MIXOUT, const float* ws, const float* bs, int row0, int L, int g) {
    const int tid = opaque_tid();
    LAS float* vt = (LAS float*)lds;
    LAS float* wt = vt + 128 * 128;
    for (int idx = tid; idx < L * 128; idx += 512) { const int s = idx >> 7, d = idx & 127;
        vt[idx] = bf2f(PROJ[(size_t)(row0 + s) * NPJ + C_VV + g * 128 + d]);
        wt[idx] = ws[(size_t)(g * 128 + s) * 128 + d]; }
    __syncthreads();
    const int d = tid & 127, tq = __builtin_amdgcn_readfirstlane(tid >> 7);
    for (int t = tq; t < L; t += 4) { float acc = 0.f;
        for (int s = 0; s <= t; ++s) acc += wt[t * 128 + s] * vt[s * 128 + d];
        const float u = bf2f(PROJ[(size_t)(row0 + t) * NPJ + C_U + g * 128 + d]);
        MIXOUT[(size_t)(row0 + t) * MIXW + 1536 + g * 128 + d] = (bf16)f2bf(u * (acc + bs[g * 128 + t])); }
    __syncthreads();
}


#ifndef PH
#define PH 0xFFFF
#endif
#if PH & 4096
#define MROWS MP
#else
#define MROWS M
#endif
__global__ void __launch_bounds__(NWAVES * 64, 2) hybrid_fwd(Args args) {
    extern __shared__ __attribute__((aligned(16))) unsigned char lds_raw[];
    LAS unsigned char* lds = (LAS unsigned char*)lds_raw;
    volatile LAS unsigned* MISC = (volatile LAS unsigned*)(lds + MISC_OFF);
    const int G = gridDim.x, bx = blockIdx.x, vcu = (G % 8 == 0) ? (bx % 8) * (G / 8) + bx / 8 : bx;
    unsigned char* ws = args.ws;
    gu32* ctl = (gu32*)(ws + WS_CTL);
    for (int u = threadIdx.x; u < (LDS_BYTES - LDSCTL_OFF) / 4; u += NWAVES * 64) ((LAS unsigned*)(lds + LDSCTL_OFF))[u] = 0u;
    __syncthreads();
    XcdBarrier bar = xcd_barrier_post((unsigned*)(ctl + CW_BAR), MISC + 8, (unsigned)G, true);
    XcdBarrier bar2 = xcd_barrier_post((unsigned*)(ctl + CW_BAR2), MISC + 10, 64u, vcu >= 128 && vcu < 192);
#ifdef USE_CG
#define GRID_BAR() cooperative_groups::this_grid().sync()
#else
#define GRID_BAR() xcd_barrier(bar)
#endif

    bf16* HN = (bf16*)(ws + WS_HN);
    float* GLOG = (float*)(ws + WS_GLOG);
    float* SLOC = (float*)(ws + WS_HN);
    float* DLOG = (float*)(ws + WS_HN + 16 * MiB);
    bf16* MIX = (bf16*)(ws + WS_MIX);
    bf16* PROJ = (bf16*)(ws + WS_PROJ);
    bf16* FFH = (bf16*)(ws + WS_PROJ);
    bf16* FFHS = (bf16*)(ws + WS_FFHS);
    float* SLAB = (float*)(ws + WS_SLAB);
    float* H = args.out + O_Y;
    const float* xp_in = args.in[0]; const float* xs_in = args.in[1];

#if PH & 1
    for (int q_ = 0; q_ < REP_CONV; ++q_) { convert_weights(args, lds, vcu, G);
    __syncthreads(); }
#endif
#if PH & 2
    for (int q_ = 0; q_ < REP_N1; ++q_)
    norm_phase<1>(lds, vcu, G, xp_in, xs_in, args.in[4], HN, GLOG, nullptr, args.in[5], args.in[6], args.in[7]);
#endif
    GRID_BAR();

#ifdef EXP_ONELAYER
    for (int l = 0; l < 1; ++l) {
#else
    for (int l = 0; l < DEPTH; ++l) {
#endif
        unsigned char* wl = ws + WS_W + (size_t)l * W_LAYER;
#if PH & 4
        if (l > 0) {
            norm_phase<1>(lds, vcu, G, H, H + (size_t)MP * D, args.in[4] + l * D, HN, GLOG, nullptr, args.in[5] + (size_t)l * D * IN_COLS, args.in[6] + l * 16 * 512, args.in[7] + l * 512);
            GRID_BAR();
        }
#endif
        for (int rep_ = 0; rep_ < REP_PROJ; ++rep_) {
#if PH & 8
        {
            pg8::Gemm g{HN, (const bf16*)(wl + W_IN), D, D}; pg8::Order S; S.init(M, NPJ, D, G, bx, 1);
            pg8::EpiProj E{PROJ, args.out + O_SGV + (size_t)l * MS * 512, H};
            pg8::gemm_phase<pg8::EpiProj>(lds, g, S, E);
        }
#endif
        GRID_BAR();
        }
        for (int rep_ = 0; rep_ < REP_MIX; ++rep_) {
        {
            const float* gn = args.in[8] + l * 256;
            if (vcu < 96) {
#if PH & 16
                const int nh = vcu / 3, js = vcu - 3 * nh;
                for (int q_ = 0; q_ < REP_P1; ++q_)
                gla_chunked<false>(lds, PROJ, GLOG, MIX, gn, (nh >> 2) * SEQ + js * (SEQ / 4), SEQ / 256, nh & 3, 0, nullptr, nullptr, SLOC + (size_t)(nh * 3 + js) * 128 * 256, DLOG + (nh * 3 + js) * 128);
#endif
            } else {
#if PH & 32
                const float* wmix = args.in[9] + (size_t)l * 4 * 128 * 128; const float* pscale = args.in[10] + l * 512;
                const float* wsp = args.in[11] + (size_t)l * 4 * 128 * 128; const float* bsp = args.in[12] + l * 4 * 128;
                const float* spool = args.in[3] + (size_t)l * SB * 15 * 512;
                for (int rl_ = 0; rl_ < REP_LIGHT; ++rl_) {
                const int j = vcu - 96, NJ = G - 96, g = j & 3, jj = j >> 2, NJJ = NJ >> 2;
                for (int q_ = 0; q_ < REP_GS; ++q_)
                for (int it = j; it < SB * 4; it += NJ) { const int n = it >> 2, h = it & 3; const size_t so = ((size_t)(l * SB + n) * 4 + h) * 128 * 256;
#ifndef SKIP_GS
                    gla_sample(lds, PROJ, GLOG, MIX, gn, MP + n * ST, h, args.in[2] + so, args.out + O_GLAS + so); }
#else
 }
#endif
                if (jj < 16) mat128_to_lds(lds, PL_W, PL_SW, wmix + (size_t)g * 128 * 128, false);
                for (int q_ = 0; q_ < REP_PL; ++q_)
                for (int tile = 256 + jj; tile < 256 + 16; tile += NJJ) {
                    const bool smp = tile >= 256; const int st = tile - 256;
                    const int row0 = smp ? MP + st * 64 : (tile >> 5) * SEQ + (tile & 31) * 64, pos0 = smp ? 0 : (tile & 31) * 64;
#ifndef SKIP_PL
                    if (g == 0) pool_tile<0>(lds, PROJ, MIX, pscale, spool, row0, pos0, smp, st * 8);
                    else if (g == 1) pool_tile<1>(lds, PROJ, MIX, pscale + 128, spool, row0, pos0, smp, st * 8);
                    else if (g == 2) pool_tile<2>(lds, PROJ, MIX, pscale + 256, spool, row0, pos0, smp, st * 8);
                    else pool_tile<3>(lds, PROJ, MIX, pscale + 384, spool, row0, pos0, smp, st * 8);
#endif
                }
                for (int q_ = 0; q_ < REP_SS; ++q_)
                for (int it = j; it < 512 + 136; it += NJ) {
                    int r = it;
                    if (r < 512) { const int g2 = r & 3, n = r >> 2; sg_item(lds, PROJ, MIX, wsp, bsp, MP + n * ST, ST, g2); continue; } r -= 512;
                    const int tid = opaque_tid();
                    if (r < NB) { const int n = r; float* o = args.out + O_POOLP + (size_t)(l * NB + n) * 15 * 512;
                        for (int idx = tid; idx < 15 * 512; idx += 512) { const int i = idx >> 9, c = idx & 511; o[idx] = bf2f(PROJ[(size_t)(n * SEQ + SEQ - 15 + i) * NPJ + C_XP + c]); } }
                    else { const int n = r - NB; float* o = args.out + O_POOLS + (size_t)(l * SB + n) * 15 * 512; const float* hs = spool + (size_t)n * 15 * 512;
                        for (int idx = tid; idx < 15 * 512; idx += 512) { const int i = idx >> 9, c = idx & 511; o[idx] = i < 7 ? hs[(size_t)(8 + i) * 512 + c] : bf2f(PROJ[(size_t)(MP + n * ST + i - 7) * NPJ + C_XP + c]); } }
                }
                }
#endif
            }
        }
        GRID_BAR();
#if PH & 16
        if (vcu < 128) {
            const int nh = vcu >> 2, js = vcu & 3;
            for (int q_ = 0; q_ < REP_P2; ++q_)
            gla_chunked<true>(lds, PROJ, GLOG, MIX, args.in[8] + l * 256, (nh >> 2) * SEQ + js * (SEQ / 4), SEQ / 256, nh & 3, js, SLOC + (size_t)nh * 3 * 128 * 256, DLOG + nh * 3 * 128,
                              js == 3 ? args.out + O_GLAP + ((size_t)(l * NB + (nh >> 2)) * 4 + (nh & 3)) * 128 * 256 : nullptr, nullptr);
#if PH & 32
            {
                const float* wmix = args.in[9] + (size_t)l * 4 * 128 * 128; const float* pscale = args.in[10] + l * 512;
                const int g = vcu & 3, jj = vcu >> 2;
                mat128_to_lds(lds, PL_W, PL_SW, wmix + (size_t)g * 128 * 128, false);
                for (int tile = jj; tile < 256; tile += 32) { const int row0 = (tile >> 5) * SEQ + (tile & 31) * 64, pos0 = (tile & 31) * 64;
                    if (g == 0) pool_tile<0>(lds, PROJ, MIX, pscale, nullptr, row0, pos0, false, 0);
                    else if (g == 1) pool_tile<1>(lds, PROJ, MIX, pscale + 128, nullptr, row0, pos0, false, 0);
                    else if (g == 2) pool_tile<2>(lds, PROJ, MIX, pscale + 256, nullptr, row0, pos0, false, 0);
                    else pool_tile<3>(lds, PROJ, MIX, pscale + 384, nullptr, row0, pos0, false, 0); }
            }
#endif
        }
#endif
#if PH & 32
        if (vcu >= 192) {
            const float* wsp = args.in[11] + (size_t)l * 4 * 128 * 128; const float* bsp = args.in[12] + l * 4 * 128;
            const int j = vcu - 192, g = j & 3, jj = j >> 2;
            mat128_to_lds(lds, SG_WT, SG_SW, wsp + (size_t)g * 128 * 128, true);
            for (int ch = jj; ch < 128; ch += 16) sg_chunk(lds, PROJ, MIX, bsp + g * 128, ch * 128, g);
        }
#endif
#if PH & 4096
        if (vcu >= 128 && vcu < 192) {
            const int c2 = vcu - 128;
#define BAR2() do { for (int qb_ = 0; qb_ < REP_BAR2; ++qb_) xcd_barrier(bar2); } while (0)
            if (c2 < 64) { pg8::Gemm g{MIX, (const bf16*)(wl + W_BR), MIXW, MIXW}; pg8::Order S; S.init(MS, D, MIXW, 64, c2, 3, MP / 256, 4);
                pg8::EpiBranch E{PROJ, HN, SLAB}; pg8::gemm_phase<pg8::EpiBranch>(lds, g, S, E); }
            BAR2();
            {   const int tid = opaque_tid();
                for (int idx = tid; idx < 16 * 256; idx += 512) { const int rr = c2 * 16 + (idx >> 8), c4 = (idx & 255) * 4;
                    f32x4 a = *(const f32x4*)(SLAB + (size_t)rr * D + c4);
#pragma unroll
                    for (int k = 1; k < 4; ++k) a = a + *(const f32x4*)(SLAB + ((size_t)k * MS + rr) * D + c4);
                    v2u o; o.x = pg8::cvt_pk_bf16(a.x, a.y); o.y = pg8::cvt_pk_bf16(a.z, a.w); *(v2u*)(HN + (size_t)(MP + rr) * D + c4) = o; } }
            BAR2();
            if (c2 < 64) { pg8::Gemm g{HN, (const bf16*)(wl + W_OUT), D, D}; pg8::Order S; S.init(MS, D, D, 64, c2, 1, MP / 256, 4);
                pg8::EpiSlab E{SLAB}; pg8::gemm_phase<pg8::EpiSlab>(lds, g, S, E); }
            BAR2();
            for (int half_ = 0; half_ < 2; ++half_)
            {   const int tid = opaque_tid(), lane = tid & 63, wave = __builtin_amdgcn_readfirstlane(tid >> 6), rr = c2 * 16 + half_ * 8 + wave;
                const float* bsrc = (l == 0 ? xs_in : H + (size_t)MP * D) + (size_t)rr * D; float* hrow = H + (size_t)(MP + rr) * D; const float* wn = args.in[17] + l * D;
                f32x4 v[4]; float ss = 0.f;
#pragma unroll
                for (int j = 0; j < 4; ++j) { const int c4 = 4 * lane + 256 * j; f32x4 a = *(const f32x4*)(bsrc + c4);
#pragma unroll
                    for (int k = 0; k < 4; ++k) a = a + *(const f32x4*)(SLAB + ((size_t)k * MS + rr) * D + c4);
                    v[j] = a; *(f32x4*)(hrow + c4) = a; ss += (a.x * a.x + a.y * a.y) + (a.z * a.z + a.w * a.w); }
                const float r = 1.0f / sqrtf(wave_sum(ss) * (1.0f / D) + EPS);
#pragma unroll
                for (int j = 0; j < 4; ++j) { const int c4 = 4 * lane + 256 * j; const f32x4 wv = *(const f32x4*)(wn + c4); const f32x4 y = v[j] * r * wv;
                    v2u o; o.x = pg8::cvt_pk_bf16(y.x, y.y); o.y = pg8::cvt_pk_bf16(y.z, y.w); *(v2u*)(HN + (size_t)(MP + rr) * D + c4) = o; } }
            BAR2();
            for (int q_ = 0; q_ < REP_CH4; ++q_)
            if (c2 < 64) { pg8::Gemm g{HN, (const bf16*)(wl + W_FF1), D, D}; pg8::Order S; S.init(MS, FF, D, 64, c2, 1, MP / 256);
                pg8::EpiRelu2 E{FFHS - (size_t)MP * FF}; pg8::gemm_phase<pg8::EpiRelu2>(lds, g, S, E); }
            BAR2();
            { pg8::Gemm g{FFHS - (size_t)MP * FF, (const bf16*)(wl + W_FF2), FF, FF}; pg8::Order S; S.init(MS, D, FF, 64, c2, 1, MP / 256, 4);
                pg8::EpiSlab E{SLAB}; pg8::gemm_phase<pg8::EpiSlab>(lds, g, S, E); }
            BAR2();
            {   const int tid = opaque_tid();
                for (int idx = tid; idx < 16 * 256; idx += 512) { const int rr = c2 * 16 + (idx >> 8), c4 = (idx & 255) * 4; float* hp_ = H + (size_t)(MP + rr) * D + c4;
                    f32x4 a = *(const f32x4*)hp_;
#pragma unroll
                    for (int k = 0; k < 4; ++k) a = a + *(const f32x4*)(SLAB + ((size_t)k * MS + rr) * D + c4);
                    *(f32x4*)hp_ = a; } }
#undef BAR2
        }
#endif
        GRID_BAR();
        }
#ifdef EXP_COPYGATES
        {   const int tid = opaque_tid();
            for (int row = vcu; row < M; row += G) for (int c = tid; c < 1024; c += 512) H[(size_t)row * D + c] = bf2f(PROJ[(size_t)row * NPJ + C_G + c]);
        }
        GRID_BAR();
#endif
        for (int rep_ = 0; rep_ < REP_BRANCH; ++rep_) {
#if PH & 64
        {
#ifdef EXP_PLAIN_BRANCH
            pg8::Gemm g{MIX, (const bf16*)(wl + W_BR), MIXW, MIXW}; pg8::Order S; S.init(M, D, MIXW, G, bx, 3);
            pg8::EpiPlain E{HN};
            pg8::gemm_phase<pg8::EpiPlain>(lds, g, S, E);
#else
            pg8::Gemm g{MIX, (const bf16*)(wl + W_BR), MIXW, MIXW}; pg8::Order S; S.init(MROWS, D, MIXW, G, bx, 3);
            pg8::EpiBranch E{PROJ, HN, nullptr};
            pg8::gemm_phase<pg8::EpiBranch>(lds, g, S, E);
#endif
        }
#endif
        GRID_BAR();
        }
#if PH & 128
        {
            pg8::Gemm g{HN, (const bf16*)(wl + W_OUT), D, D}; pg8::Order S; S.init(MROWS, D, D, G, bx, 1);
            pg8::EpiResid E{l == 0 ? xp_in : H, l == 0 ? xs_in : H + (size_t)MP * D, H};
            pg8::gemm_phase<pg8::EpiResid>(lds, g, S, E);
        }
#endif
        GRID_BAR();
        for (int rep_ = 0; rep_ < REP_NORM2; ++rep_) {
#if PH & 256
        norm_phase<0>(lds, vcu, G, H, H + (size_t)MP * D, args.in[17] + l * D, HN, nullptr, nullptr, nullptr, nullptr, nullptr, 0, MROWS);
#endif
        GRID_BAR();
        }
        for (int rep_ = 0; rep_ < REP_FFN1; ++rep_) {
#if PH & 512
        {
            pg8::Gemm g{HN, (const bf16*)(wl + W_FF1), D, D}; pg8::Order S; S.init(MROWS, FF, D, G, bx, 1);
            pg8::EpiRelu2 E{FFH};
            pg8::gemm_phase<pg8::EpiRelu2>(lds, g, S, E);
        }
#endif
        GRID_BAR();
        }
#if PH & 1024
        {
            pg8::Gemm g{FFH, (const bf16*)(wl + W_FF2), FF, FF}; pg8::Order S; S.init(MROWS, D, FF, G, bx, 1);
            pg8::EpiResid E{H, H + (size_t)MP * D, H};
            pg8::gemm_phase<pg8::EpiResid>(lds, g, S, E);
        }
#endif
        GRID_BAR();
    }
#if PH & 2048
    norm_phase<2>(lds, vcu, G, H, H + (size_t)MP * D, args.in[20], nullptr, nullptr, H, nullptr, nullptr, nullptr);
#endif
}

extern "C" void kernel_launch(void* const* d_in, const int* in_sizes, int n_in, void* d_out, int out_size, void* d_ws, size_t ws_size, hipStream_t stream) {
    static int grid = 0;
    if (grid == 0) {
        if (n_in != 21 || in_sizes[0] != MP * D || (size_t)out_size != O_END || ws_size < WS_END) {
            fprintf(stderr, "kernel_launch: unexpected shapes: n_in %d in0 %d out %d ws %zu (need %zu)\n", n_in, n_in > 0 ? in_sizes[0] : -1, out_size, ws_size, (size_t)WS_END); grid = -1; return; }
        int dev = 0, cus = 0, per_cu = 0;
        if (hipGetDevice(&dev) != hipSuccess || hipDeviceGetAttribute(&cus, hipDeviceAttributeMultiprocessorCount, dev) != hipSuccess) { grid = -1; return; }
        if (hipFuncSetAttribute((const void*)hybrid_fwd, hipFuncAttributeMaxDynamicSharedMemorySize, LDS_BYTES) != hipSuccess) { fprintf(stderr, "kernel_launch: hipFuncSetAttribute failed\n"); grid = -1; return; }
        if (hipOccupancyMaxActiveBlocksPerMultiprocessor(&per_cu, (const void*)hybrid_fwd, NWAVES * 64, LDS_BYTES) != hipSuccess || per_cu < 1) {
            fprintf(stderr, "kernel_launch: occupancy query reports %d blocks per CU\n", per_cu); (void)hipGetLastError(); grid = -1; return; }
        grid = cus;
    }
    if (grid < 0) return;
    if (hipMemsetAsync((char*)d_ws + WS_CTL, 0, CTL_ZERO_BYTES, stream) != hipSuccess) { fprintf(stderr, "kernel_launch: memset failed\n"); return; }
    Args a{};
    for (int i = 0; i < 21; ++i) a.in[i] = (const float*)d_in[i];
    a.out = (float*)d_out; a.ws = (unsigned char*)d_ws;
    void* kargs[] = {&a};
    hipError_t e = hipLaunchCooperativeKernel((const void*)hybrid_fwd, dim3(grid), dim3(NWAVES * 64), kargs, LDS_BYTES, stream);
    if (e != hipSuccess) fprintf(stderr, "kernel_launch: cooperative launch failed: %s (grid %d)\n", hipGetErrorString(e), grid);
}
```

```cpp
#include <hip/hip_runtime.h>
#include <hip/hip_cooperative_groups.h>
#include <cstdio>
#include <cstdint>
#ifndef REP_BAR2
#define REP_BAR2 1
#endif
#ifndef REP_CONV
#define REP_CONV 1
#endif
#ifndef REP_N1
#define REP_N1 1
#endif
#ifndef REP_P1
#define REP_P1 1
#endif
#ifndef REP_GS
#define REP_GS 1
#endif
#ifndef REP_PL
#define REP_PL 1
#endif
#ifndef REP_SG
#define REP_SG 1
#endif
#ifndef REP_SS
#define REP_SS 1
#endif
#ifndef REP_P2
#define REP_P2 1
#endif
#ifndef REP_CH1
#define REP_CH1 1
#endif
#ifndef REP_CH4
#define REP_CH4 1
#endif
#ifndef REP_ATT
#define REP_ATT 1
#endif
#ifndef REP_OMM
#define REP_OMM 1
#endif
#ifndef REP_EPI
#define REP_EPI 1
#endif
#ifndef REP_GLAP
#define REP_GLAP 1
#endif
#ifndef REP_LIGHT
#define REP_LIGHT 1
#endif
#ifndef REP_PROJ
#define REP_PROJ 1
#endif
#ifndef REP_MIX
#define REP_MIX 1
#endif
#ifndef REP_BRANCH
#define REP_BRANCH 1
#endif
#ifndef REP_NORM2
#define REP_NORM2 1
#endif
#ifndef REP_FFN1
#define REP_FFN1 1
#endif

constexpr int D = 1024, NB = 8, SEQ = 2048, DEPTH = 2, SB = 128, ST = 8;
constexpr int MP = NB * SEQ;
constexpr int MS = SB * ST;
constexpr int M = MP + MS;
constexpr int IN_COLS = 7696;
constexpr int NPJ = 7680;
constexpr int FF = 4096;
constexpr float EPS = 1e-6f;
constexpr int C_Q = 0, C_K = 512, C_V = 1024, C_GO = 2048, C_XP = 3072, C_U = 3584, C_VV = 4096, C_G = 4608;
constexpr int MIXW = 2048;

constexpr size_t MiB = 1u << 20;
constexpr size_t WS_CTL = 0, CTL_ZERO_BYTES = 1 * MiB;
constexpr size_t WS_W = 2 * MiB;
constexpr size_t W_LAYER = 37 * MiB, W_IN = 0, W_BR = 15 * MiB, W_OUT = 19 * MiB, W_FF1 = 21 * MiB, W_FF2 = 29 * MiB;
constexpr size_t WS_HN = 76 * MiB;
constexpr size_t WS_GLOG = 110 * MiB;
constexpr size_t WS_MIX = 144 * MiB;
constexpr size_t WS_PROJ = 212 * MiB;
constexpr size_t WS_FFHS = 468 * MiB;
constexpr size_t WS_SLAB = 476 * MiB;
constexpr size_t WS_END = 508 * MiB;
static_assert(WS_PROJ + (size_t)M * NPJ * 2 <= WS_FFHS, "ws map");
static_assert(WS_MIX + (size_t)M * MIXW * 2 <= WS_PROJ, "ws map");
static_assert(WS_GLOG + (size_t)M * 512 * 4 <= WS_MIX, "ws map");
static_assert(WS_HN + (size_t)M * D * 2 <= WS_GLOG, "ws map");
static_assert(WS_W + 2 * W_LAYER <= WS_HN, "ws map");
constexpr int CW_BAR = 4096, CW_BAR2 = 8192;

constexpr size_t O_Y = 0;
constexpr size_t O_GLAP = (size_t)M * D;
constexpr size_t O_GLAS = O_GLAP + (size_t)DEPTH * NB * 4 * 128 * 256;
constexpr size_t O_POOLP = O_GLAS + (size_t)DEPTH * SB * 4 * 128 * 256;
constexpr size_t O_POOLS = O_POOLP + (size_t)DEPTH * NB * 15 * 512;
constexpr size_t O_SGV = O_POOLS + (size_t)DEPTH * SB * 15 * 512;
constexpr size_t O_END = O_SGV + (size_t)DEPTH * SB * ST * 512;
static_assert(O_END == 56614912, "output size");

constexpr int RING_BYTES = 131072;
constexpr int LDSCTL_OFF = RING_BYTES, MISC_OFF = LDSCTL_OFF + 320;
constexpr int LDS_BYTES = 147456;
constexpr int NWAVES = 8;

#define GAS __attribute__((address_space(1)))
#define LAS __attribute__((address_space(3)))
typedef unsigned short bf16;
typedef unsigned v4u __attribute__((ext_vector_type(4)));
typedef unsigned v2u __attribute__((ext_vector_type(2)));
typedef float f32x4 __attribute__((ext_vector_type(4)));
typedef short bf16x8 __attribute__((ext_vector_type(8)));
typedef GAS unsigned gu32;
#define RLX_AGENT __ATOMIC_RELAXED, __HIP_MEMORY_SCOPE_AGENT
#define LDS_WAIT() asm volatile("s_waitcnt lgkmcnt(0)" ::: "memory")
#define LDS_BARRIER() do { asm volatile("s_waitcnt lgkmcnt(0)" ::: "memory"); __builtin_amdgcn_s_barrier(); asm volatile("" ::: "memory"); } while (0)

__device__ __forceinline__ unsigned f2bf(float f) { unsigned u = __builtin_bit_cast(unsigned, f); return (u + 0x7fffu + ((u >> 16) & 1u)) >> 16; }
__device__ __forceinline__ unsigned pk2(float lo, float hi) { return f2bf(lo) | (f2bf(hi) << 16); }
__device__ __forceinline__ float bf2f(unsigned short x) { return __builtin_bit_cast(float, (unsigned)x << 16); }
__device__ __forceinline__ float bflo(unsigned w) { return __builtin_bit_cast(float, w << 16); }
__device__ __forceinline__ float bfhi(unsigned w) { return __builtin_bit_cast(float, w & 0xffff0000u); }
__device__ __forceinline__ float sigmoid_f(float x) { return __builtin_amdgcn_rcpf(1.0f + __builtin_amdgcn_exp2f(-1.4426950409f * x)); }
__device__ __forceinline__ float gelu_tanh(float x) { const float z = 1.5957691216f * x * (1.0f + 0.044715f * x * x); return x * sigmoid_f(z); }
__device__ __forceinline__ int opaque_tid() { int t = threadIdx.x; asm volatile("" : "+v"(t)); return t; }
template <int CTRL> __device__ __forceinline__ float dpp_f(float v) { return __builtin_bit_cast(float, __builtin_amdgcn_update_dpp(0, __builtin_bit_cast(int, v), CTRL, 0xf, 0xf, false)); }
__device__ __forceinline__ float wave_sum(float v) {
    v += dpp_f<0xB1>(v);
    v += dpp_f<0x4E>(v);
    v += dpp_f<0x141>(v);
    v += dpp_f<0x140>(v);
    const int iv = __builtin_bit_cast(int, v);
    return (__builtin_bit_cast(float, __builtin_amdgcn_readlane(iv, 0)) + __builtin_bit_cast(float, __builtin_amdgcn_readlane(iv, 16)))
         + (__builtin_bit_cast(float, __builtin_amdgcn_readlane(iv, 32)) + __builtin_bit_cast(float, __builtin_amdgcn_readlane(iv, 48)));
}

namespace pg8 {
#define PG8_LAS __attribute__((address_space(3)))
typedef unsigned short bf16_t;
typedef unsigned u32x4 __attribute__((ext_vector_type(4)));
constexpr int BM = 256, BK = 64, HALF = 128, HTB = HALF * BK * 2, STAGE_BYTES = 8 * HTB, NXCD = 8, WGM = 8;

__host__ __device__ __forceinline__ int lds_byte(int r, int c) { const int st = (r >> 4) * 2 + (c >> 5), rr = r & 15, cc = c & 31, ob = rr * 64 + cc * 2; return st * 1024 + (ob ^ (((ob >> 9) & 1) << 5)); }
__host__ __device__ __forceinline__ void stage_rc(int b, int& R, int& C) { const int st = b / 1024, sb = b % 1024, swz = sb ^ (((sb >> 9) & 1) << 5); R = (st >> 1) * 16 + swz / 64; C = (st & 1) * 32 + (swz % 64) / 2; }
__host__ __device__ __forceinline__ int perm32(int rho) { const int n = rho >> 4, i = rho & 15; return 8 * (i >> 2) + 4 * n + (i & 3); }

struct Unit { int pm, pn, k0, nt, sub, keep, ks; };
struct Gemm { const bf16_t* A; const bf16_t* Bt; int lda, ldb; };

struct Order {
    int nM, nN, nwg, G, c, nsub, ntk, pm_off, ksplit;
    __device__ void init(int M_, int N_, int K_, int G_, int c_, int nsub_, int pm_off_ = 0, int ksplit_ = 1) { nM = M_ / BM; nN = N_ / BM; nwg = nM * nN; G = G_; c = c_; nsub = nsub_; ntk = K_ / BK; pm_off = pm_off_; ksplit = ksplit_; }
    __device__ bool next(int i, Unit& u) const {
        const int ti = i / nsub, sub = i - ti * nsub;
        long L = (long)ti * G + c; if (L >= (long)nwg * ksplit) return false;
        const int ksr = (int)(L % ksplit); L /= ksplit;
        int wgid = (int)L; { const int q = nwg / NXCD, r = nwg % NXCD, xcd = wgid % NXCD, off = wgid / NXCD; wgid = (xcd < r ? xcd * (q + 1) : r * (q + 1) + (xcd - r) * q) + off; }
        const int nig = WGM * nN, gid = wgid / nig, fm = gid * WGM, gsz = (nM - fm) < WGM ? (nM - fm) : WGM;
        u.pm = pm_off + fm + ((wgid % nig) % gsz); u.pn = (wgid % nig) / gsz; u.sub = sub; u.ks = ksr;
        if (nsub == 1) { u.nt = ntk / ksplit; u.k0 = ksr * u.nt * BK; u.keep = 0; }
        else { const int len = (sub == 0 ? 1024 : 512) / ksplit; u.k0 = (sub == 0 ? 0 : (sub == 1 ? 1024 : 1536)) + ksr * len; u.nt = len / BK; u.keep = sub < 2 ? 1 : 0; }
        return true;
    }
};

typedef __bf16 bf16x2_t __attribute__((ext_vector_type(2)));
typedef float f32x2_t __attribute__((ext_vector_type(2)));
__device__ __forceinline__ unsigned cvt_pk_bf16(float lo, float hi) { const f32x2_t v = {lo, hi}; const bf16x2_t b = __builtin_convertvector(v, bf16x2_t); return __builtin_bit_cast(unsigned, b); }

typedef f32x4 acc_t[2][2][4][2];

template <int ACT> __device__ __forceinline__ float act_f(float x) {
    if (ACT == 1) return x * 0.08838834764831845f;
    if (ACT == 2) return gelu_tanh(x);
    if (ACT == 3) return sigmoid_f(x);
    if (ACT == 4) { const float r = x > 0.f ? x : 0.f; return r * r; }
    return x;
}
template <int ACT> __device__ __forceinline__ void store_bf16_tile(const acc_t& acc, bf16_t* O, int ldc, int row0, int col0, float* sgv  , int sgcol0) {
#pragma unroll
    for (int ai = 0; ai < 2; ++ai)
#pragma unroll
        for (int m = 0; m < 4; ++m) { const int row = row0 + ai * HALF + m * 16; bf16_t* rowp = O + (size_t)row * ldc + col0;
#pragma unroll
            for (int bj = 0; bj < 2; ++bj) { f32x4 v0 = acc[ai][bj][m][0], v1 = acc[ai][bj][m][1];
#pragma unroll
                for (int j = 0; j < 4; ++j) { v0[j] = act_f<ACT>(v0[j]); v1[j] = act_f<ACT>(v1[j]); }
                u32x4 w; w.x = cvt_pk_bf16(v0[0], v0[1]); w.y = cvt_pk_bf16(v0[2], v0[3]); w.z = cvt_pk_bf16(v1[0], v1[1]); w.w = cvt_pk_bf16(v1[2], v1[3]);
                *(u32x4*)(rowp + bj * HALF) = w;
                if (ACT == 2 && sgv) { float* sp = sgv + (size_t)(row - MP) * 512 + sgcol0 + bj * HALF; *(f32x4*)sp = v0; *(f32x4*)(sp + 4) = v1; }
                if (ACT == 3 && sgv) { float* sp = sgv + (size_t)row * D + sgcol0 + bj * HALF; *(f32x4*)sp = v0; *(f32x4*)(sp + 4) = v1; } } }
}

struct EpiProj {
    static constexpr bool PERM = true;
    bf16_t* O; float* sgv; float* dbg;
    __device__ __forceinline__ void operator()(acc_t& acc, const Unit& u, int wr, int wc, int fr, int fq) const {
        const int row0 = u.pm * BM + wr * 64 + fr, col0 = u.pn * BM + wc * 32 + 8 * fq, pn = u.pn;
        if (pn < 2) store_bf16_tile<1>(acc, O, NPJ, row0, col0, nullptr, 0);
        else if (pn < 14) store_bf16_tile<0>(acc, O, NPJ, row0, col0, nullptr, 0);
        else if (pn < 18) store_bf16_tile<2>(acc, O, NPJ, row0, col0, (pn >= 16 && u.pm >= MP / BM) ? sgv : nullptr, col0 - C_VV);
#ifdef EXP_GATEOUT
        else store_bf16_tile<3>(acc, O, NPJ, row0, col0, (pn >= 26) ? dbg : nullptr, col0 - C_G - 2048);
#else
        else store_bf16_tile<3>(acc, O, NPJ, row0, col0, nullptr, 0);
#endif
    }
};
struct EpiPlain {
    static constexpr bool PERM = true;
    bf16_t* O;
    __device__ __forceinline__ void operator()(acc_t& acc, const Unit& u, int wr, int wc, int fr, int fq) const {
        if (u.keep) return;
        store_bf16_tile<0>(acc, O, D, u.pm * BM + wr * 64 + fr, u.pn * BM + wc * 32 + 8 * fq, nullptr, 0);
    }
};
struct EpiRelu2 {
    static constexpr bool PERM = true;
    bf16_t* O;
    __device__ __forceinline__ void operator()(acc_t& acc, const Unit& u, int wr, int wc, int fr, int fq) const {
        store_bf16_tile<4>(acc, O, FF, u.pm * BM + wr * 64 + fr, u.pn * BM + wc * 32 + 8 * fq, nullptr, 0);
    }
};
struct EpiBranch {
    static constexpr bool PERM = true;
    const bf16_t* P; bf16_t* O; float* slab;
    __device__ __forceinline__ void operator()(acc_t& acc, const Unit& u, int wr, int wc, int fr, int fq) const {
        const int row0 = u.pm * BM + wr * 64 + fr, col0 = u.pn * BM + wc * 32 + 8 * fq, sub = u.sub;
#pragma unroll
        for (int ai = 0; ai < 2; ++ai)
#pragma unroll
            for (int m = 0; m < 4; ++m) { const int row = row0 + ai * HALF + m * 16; const bf16_t* gp = P + (size_t)row * NPJ + C_G + col0;
#pragma unroll
                for (int bj = 0; bj < 2; ++bj) {
#ifdef EXP_NOLOAD
                    const u32x4 g1 = (u32x4){0x3f003f00u, 0x3f003f00u, 0x3f003f00u, 0x3f003f00u};
#elif defined(EXP_SC1)
                    u32x4 g1; { const unsigned long long* q = (const unsigned long long*)(gp + sub * 1024 + bj * HALF);
                        const unsigned long long q0 = __hip_atomic_load(q, __ATOMIC_RELAXED, __HIP_MEMORY_SCOPE_SYSTEM), q1 = __hip_atomic_load(q + 1, __ATOMIC_RELAXED, __HIP_MEMORY_SCOPE_SYSTEM);
                        g1.x = (unsigned)q0; g1.y = (unsigned)(q0 >> 32); g1.z = (unsigned)q1; g1.w = (unsigned)(q1 >> 32); }
#elif defined(EXP_DEADLOAD)
                    const u32x4 g1_ = *(const u32x4*)(gp + sub * 1024 + bj * HALF);
#else
                    const u32x4 g1 = *(const u32x4*)(gp + sub * 1024 + bj * HALF);
#endif
#ifdef EXP_DEADLOAD
                    u32x4 g1 = g1_; asm volatile("" : "+v"(g1.x), "+v"(g1.y), "+v"(g1.z), "+v"(g1.w)); g1 = (u32x4){0x3f003f00u, 0x3f003f00u, 0x3f003f00u, 0x3f003f00u};
#endif
                    float f[8];
                    f[0] = bflo(g1.x); f[1] = bfhi(g1.x); f[2] = bflo(g1.y); f[3] = bfhi(g1.y); f[4] = bflo(g1.z); f[5] = bfhi(g1.z); f[6] = bflo(g1.w); f[7] = bfhi(g1.w);
#pragma unroll
                    for (int j = 0; j < 8; ++j) f[j] = f[j] > 1e-30f ? f[j] : 1e-30f;
#ifndef EXP_NODIV
                    if (sub < 2) {
                        const u32x4 g2 = *(const u32x4*)(gp + (sub + 1) * 1024 + bj * HALF);
                        float d[8];
                        d[0] = bflo(g2.x); d[1] = bfhi(g2.x); d[2] = bflo(g2.y); d[3] = bfhi(g2.y); d[4] = bflo(g2.z); d[5] = bfhi(g2.z); d[6] = bflo(g2.w); d[7] = bfhi(g2.w);
#pragma unroll
                        for (int j = 0; j < 8; ++j) { d[j] = d[j] > 1e-30f ? d[j] : 1e-30f; f[j] = f[j] * __builtin_amdgcn_rcpf(d[j]); }
                    }
#endif
                    f32x4 v0 = acc[ai][bj][m][0], v1 = acc[ai][bj][m][1];
#pragma unroll
                    for (int j = 0; j < 4; ++j) { v0[j] *= f[j]; v1[j] *= f[4 + j]; }
                    acc[ai][bj][m][0] = v0; acc[ai][bj][m][1] = v1;
                    if (sub == 2) {
                        if (slab) { float* sp = slab + ((size_t)u.ks * MS + (row - MP)) * D + col0 + bj * HALF; *(f32x4*)sp = v0; *(f32x4*)(sp + 4) = v1; }
                        else { u32x4 w; w.x = cvt_pk_bf16(v0[0], v0[1]); w.y = cvt_pk_bf16(v0[2], v0[3]); w.z = cvt_pk_bf16(v1[0], v1[1]); w.w = cvt_pk_bf16(v1[2], v1[3]);
                            *(u32x4*)(O + (size_t)row * D + col0 + bj * HALF) = w; } }
                }
                asm volatile("" ::: "memory"); }
    }
};
struct EpiResid {
    static constexpr bool PERM = false;
    const float* bp; const float* bs; float* out;
    __device__ __forceinline__ void operator()(acc_t& acc, const Unit& u, int wr, int wc, int fr, int fq) const {
        const int row0 = u.pm * BM + wr * 64 + fr, col0 = u.pn * BM + wc * 32 + 4 * fq;
        const bool smp = u.pm >= MP / BM;
#pragma unroll
        for (int ai = 0; ai < 2; ++ai)
#pragma unroll
            for (int m = 0; m < 4; ++m) { const int row = row0 + ai * HALF + m * 16;
                const float* b = smp ? bs + (size_t)(row - MP) * D + col0 : bp + (size_t)row * D + col0; float* o = out + (size_t)row * D + col0;
#pragma unroll
                for (int bj = 0; bj < 2; ++bj)
#pragma unroll
                    for (int n = 0; n < 2; ++n) { const f32x4 bv = *(const f32x4*)(b + bj * HALF + n * 16); *(f32x4*)(o + bj * HALF + n * 16) = bv + acc[ai][bj][m][n]; }
                if (m & 1) asm volatile("" ::: "memory"); }
    }
};

struct EpiSlab {
    static constexpr bool PERM = false;
    float* slab;
    __device__ __forceinline__ void operator()(acc_t& acc, const Unit& u, int wr, int wc, int fr, int fq) const {
        const int row0 = u.pm * BM + wr * 64 + fr - MP, col0 = u.pn * BM + wc * 32 + 4 * fq;
        float* base = slab + (size_t)u.ks * MS * D;
#pragma unroll
        for (int ai = 0; ai < 2; ++ai)
#pragma unroll
            for (int m = 0; m < 4; ++m) { float* o = base + (size_t)(row0 + ai * HALF + m * 16) * D + col0;
#pragma unroll
                for (int bj = 0; bj < 2; ++bj)
#pragma unroll
                    for (int n = 0; n < 2; ++n) *(f32x4*)(o + bj * HALF + n * 16) = acc[ai][bj][m][n]; }
    }
};

template <class Epi>
__device__ __forceinline__ void gemm_phase(PG8_LAS unsigned char* lds, const Gemm g, const Order& S, const Epi& E) {
    int tid_ = threadIdx.x; asm volatile("" : "+v"(tid_));
    const int tid = tid_, wid = __builtin_amdgcn_readfirstlane(tid >> 6), lane = tid & 63, wr = wid >> 2, wc = wid & 3, fr = lane & 15, fq = lane >> 4;
    unsigned voffA[2], voffB[2];
#pragma unroll
    for (int i = 0; i < 2; ++i) { int R, C; stage_rc(tid * 16 + i * 8192, R, C); const int Rb = Epi::PERM ? ((R & ~31) + perm32(R & 31)) : R;
        voffA[i] = (unsigned)(R * g.lda + C) * 2u; voffB[i] = (unsigned)(Rb * g.ldb + C) * 2u; }
    const size_t kstep = (size_t)(BK * 2);
    const size_t hstepA = (size_t)HALF * g.lda * 2, hstepB = (size_t)HALF * g.ldb * 2;
    const size_t tstepA = 2 * hstepA, tstepB = 2 * hstepB;
    const unsigned ldsw = (unsigned)wid * 1024u;
    const int aoff = lds_byte(wr * 64 + fr, fq * 8), boff = lds_byte(wc * 32 + fr, fq * 8);
#define PG8_SA(b, h) (((b) * 2 + (h)) * HTB)
#define PG8_SB(b, h) ((4 + (b) * 2 + (h)) * HTB)
#define PG8_STAGE(bufoff, gbase, voff) do { _Pragma("unroll") for (int _i = 0; _i < 2; ++_i) \
        __builtin_amdgcn_global_load_lds((const unsigned*)((const char*)(gbase) + (voff)[_i]), (PG8_LAS unsigned*)(lds + (bufoff) + ldsw + _i * 8192), 16, 0, 0); } while (0)
#define PG8_LDA(dst, b, h) do { _Pragma("unroll") for (int m = 0; m < 4; ++m) _Pragma("unroll") for (int k = 0; k < 2; ++k) dst[m][k] = *(const PG8_LAS bf16x8*)(lds + PG8_SA(b, h) + aoff + m * 2048 + k * 1024); } while (0)
#define PG8_LDB(dst, b, h) do { _Pragma("unroll") for (int n = 0; n < 2; ++n) _Pragma("unroll") for (int k = 0; k < 2; ++k) dst[n][k] = *(const PG8_LAS bf16x8*)(lds + PG8_SB(b, h) + boff + n * 2048 + k * 1024); } while (0)
#define PG8_MMA(ai, bj, At, Bt) do { __builtin_amdgcn_s_setprio(1); _Pragma("unroll") for (int m = 0; m < 4; ++m) _Pragma("unroll") for (int n = 0; n < 2; ++n) _Pragma("unroll") for (int k = 0; k < 2; ++k) \
        acc[ai][bj][m][n] = __builtin_amdgcn_mfma_f32_16x16x32_bf16(Bt[n][k], At[m][k], acc[ai][bj][m][n], 0, 0, 0); __builtin_amdgcn_s_setprio(0); } while (0)
#define PG8_WAIT_V(n) asm volatile("s_waitcnt vmcnt(" #n ")" ::: "memory")
#define PG8_WAIT_L(n) asm volatile("s_waitcnt lgkmcnt(" #n ")" ::: "memory")
#define PG8_BAR __builtin_amdgcn_s_barrier()
#define PG8_SCHED __builtin_amdgcn_sched_barrier(0)
    Unit cur, nxt; int ui = 0;
    if (!S.next(0, cur)) return;
    f32x4 acc[2][2][4][2];
#pragma unroll
    for (int a = 0; a < 2; ++a)
#pragma unroll
        for (int b = 0; b < 2; ++b)
#pragma unroll
            for (int m = 0; m < 4; ++m)
#pragma unroll
                for (int n = 0; n < 2; ++n) acc[a][b][m][n] = (f32x4){0.f, 0.f, 0.f, 0.f};
    bf16x8 At[4][2], B0[2][2], B1[2][2];
    const char* cA = (const char*)g.A + (size_t)cur.pm * tstepA + (size_t)cur.k0 * 2; const char* cB = (const char*)g.Bt + (size_t)cur.pn * tstepB + (size_t)cur.k0 * 2;
    PG8_STAGE(PG8_SB(0, 0), cB, voffB); PG8_STAGE(PG8_SB(0, 1), cB + hstepB, voffB); PG8_STAGE(PG8_SA(0, 0), cA, voffA); PG8_STAGE(PG8_SA(0, 1), cA + hstepA, voffA);
    if (wr == 1) PG8_BAR;
    PG8_WAIT_V(2); PG8_BAR;
    PG8_STAGE(PG8_SB(1, 0), cB + kstep, voffB); PG8_STAGE(PG8_SA(1, 0), cA + kstep, voffA); PG8_STAGE(PG8_SB(1, 1), cB + hstepB + kstep, voffB);
    PG8_WAIT_V(6); PG8_BAR;
    for (;;) {
        const bool has_next = S.next(ui + 1, nxt);
        const char* nA = has_next ? (const char*)g.A + (size_t)nxt.pm * tstepA + (size_t)nxt.k0 * 2 : cA; const char* nB = has_next ? (const char*)g.Bt + (size_t)nxt.pn * tstepB + (size_t)nxt.k0 * 2 : cB;
        const int nt = cur.nt;
        for (int t = 0; t < nt; t += 2) {
            const bool last = (t == nt - 2);
            const char* a1 = cA + (size_t)(t + 1) * kstep;
            const char* a2 = last ? nA : cA + (size_t)(t + 2) * kstep; const char* b2 = last ? nB : cB + (size_t)(t + 2) * kstep;
            const char* a3 = a2 + kstep; const char* b3 = b2 + kstep;
            PG8_LDB(B0, 0, 0); PG8_LDB(B1, 0, 1); PG8_SCHED; PG8_LDA(At, 0, 0); PG8_STAGE(PG8_SA(1, 1), a1 + hstepA, voffA);
            PG8_WAIT_V(8); PG8_WAIT_L(0); PG8_BAR; PG8_MMA(0, 0, At, B0); PG8_MMA(0, 1, At, B1); PG8_BAR; PG8_SCHED;
            PG8_LDA(At, 0, 1); PG8_STAGE(PG8_SB(0, 0), b2, voffB); PG8_STAGE(PG8_SB(0, 1), b2 + hstepB, voffB); PG8_STAGE(PG8_SA(0, 0), a2, voffA);
            PG8_WAIT_V(8); PG8_WAIT_L(0); PG8_BAR; PG8_MMA(1, 0, At, B0); PG8_MMA(1, 1, At, B1); PG8_BAR; PG8_SCHED;
            PG8_LDB(B0, 1, 0); PG8_LDB(B1, 1, 1); PG8_SCHED; PG8_LDA(At, 1, 0); PG8_STAGE(PG8_SA(0, 1), a2 + hstepA, voffA);
            PG8_WAIT_V(8); PG8_WAIT_L(0); PG8_BAR; PG8_MMA(0, 0, At, B0); PG8_MMA(0, 1, At, B1); PG8_BAR; PG8_SCHED;
            PG8_LDA(At, 1, 1); PG8_STAGE(PG8_SB(1, 0), b3, voffB); PG8_STAGE(PG8_SB(1, 1), b3 + hstepB, voffB); PG8_STAGE(PG8_SA(1, 0), a3, voffA);
            PG8_WAIT_V(8); PG8_WAIT_L(0); PG8_BAR; PG8_MMA(1, 0, At, B0); PG8_MMA(1, 1, At, B1); PG8_BAR; PG8_SCHED;
        }
        if (wr == 0) PG8_BAR;
        E(acc, cur, wr, wc, fr, fq);
        if (!has_next) break;
        if (!cur.keep) {
#pragma unroll
            for (int a = 0; a < 2; ++a)
#pragma unroll
                for (int b = 0; b < 2; ++b)
#pragma unroll
                    for (int m = 0; m < 4; ++m)
#pragma unroll
                        for (int n = 0; n < 2; ++n) acc[a][b][m][n] = (f32x4){0.f, 0.f, 0.f, 0.f};
        }
        cur = nxt; cA = nA; cB = nB; ++ui;
        if (wr == 1) PG8_BAR;
    }
    PG8_WAIT_V(0);
    PG8_BAR;
#undef PG8_SA
#undef PG8_SB
#undef PG8_STAGE
#undef PG8_LDA
#undef PG8_LDB
#undef PG8_MMA
#undef PG8_WAIT_V
#undef PG8_WAIT_L
#undef PG8_BAR
#undef PG8_SCHED
}
}

#define XB_TMO      128
#define XB_XCNT(j)  (256  + 64 * (j))
#define XB_XSUB(j)  (1280 + 64 * (j))
#define XB_XGEN(j)  (2304 + 64 * (j))
#define XB_TOP      3328
#define XB_TOPGEN   3392
#define XCD_BAR_WORDS 3456
#define XB_SPIN_CAP (1u << 20)

__device__ __forceinline__ unsigned xb_ld(unsigned* p)              { return __hip_atomic_load(p, __ATOMIC_RELAXED, __HIP_MEMORY_SCOPE_AGENT); }
__device__ __forceinline__ unsigned xb_add(unsigned* p, unsigned v) { return __hip_atomic_fetch_add(p, v, __ATOMIC_RELAXED, __HIP_MEMORY_SCOPE_AGENT); }
__device__ __forceinline__ unsigned xb_xcc_id() { return (unsigned)__builtin_amdgcn_s_getreg((3 << 11) | 20) & 0xFu; }
#define XB_SPIN(cond, bar) do { unsigned _sp = 0; while (cond) { __builtin_amdgcn_s_sleep(1); \
    if ((++_sp & 255u) == 0u) { if (xb_ld(&(bar)[XB_TMO])) break; if (_sp > XB_SPIN_CAP) { atomicAdd(&(bar)[XB_TMO], 1u); break; } } } } while (0)

struct XcdBarrier { unsigned* bar; unsigned x; volatile LAS unsigned* st; unsigned np; };

__device__ __forceinline__ XcdBarrier xcd_barrier_post(unsigned* bar, volatile LAS unsigned* st, unsigned np, bool member) {
    XcdBarrier b; b.bar = bar; b.x = 0; b.st = st; b.np = np;
    if (member && threadIdx.x == 0) (void)xb_add(&bar[XB_XCNT(xb_xcc_id())], 1u);
    return b;
}
__device__ __forceinline__ void xcd_barrier_complete(unsigned* bar, unsigned x, unsigned G, unsigned& nloc, unsigned& nx) {
    unsigned sum, cnt, mine, sp = 0u;
    for (;;) {
        sum = 0u; cnt = 0u; mine = 0u;
#pragma unroll
        for (unsigned j = 0; j < 16; ++j) { const unsigned c = xb_ld(&bar[XB_XCNT(j)]); sum += c; cnt += (c > 0u) ? 1u : 0u; mine = (j == x) ? c : mine; }
        if (sum == G) break;
        __builtin_amdgcn_s_sleep(1);
        if ((++sp & 255u) == 0u) { if (xb_ld(&bar[XB_TMO])) break; if (sp > XB_SPIN_CAP) { atomicAdd(&bar[XB_TMO], 1u); break; } }
    }
    nloc = mine > 0u ? mine : 1u; nx = cnt > 0u ? cnt : 1u;
}
__device__ __forceinline__ void xcd_barrier(const XcdBarrier& b) {
    asm volatile("s_waitcnt vmcnt(0)" ::: "memory");
    __syncthreads();
    if (threadIdx.x == 0) {
        unsigned* bar = b.bar;
        unsigned xo = 0; asm volatile("s_mov_b32 %0, 0" : "=s"(xo));
        bar += xo;
        const unsigned bx_ = xb_xcc_id();
        __builtin_amdgcn_s_waitcnt(0);
        unsigned nloc = b.st[0], nx = b.st[1];
        if (nloc == 0u) { xcd_barrier_complete(bar, bx_, b.np, nloc, nx); b.st[0] = nloc; b.st[1] = nx; }
        const unsigned old = xb_add(&bar[XB_XSUB(bx_)], 1u);
        const unsigned gen = old / nloc;
        if (old + 1u == (gen + 1u) * nloc) {
            __builtin_amdgcn_fence(__ATOMIC_RELEASE, "agent");
            asm volatile("s_waitcnt vmcnt(0)" ::: "memory");
            const unsigned og = xb_add(&bar[XB_TOP], 1u);
            const unsigned tg = og / nx;
            if (og + 1u == (tg + 1u) * nx) xb_add(&bar[XB_TOPGEN], 1u);
            else XB_SPIN(xb_ld(&bar[XB_TOPGEN]) == tg, bar);
            __builtin_amdgcn_fence(__ATOMIC_ACQUIRE, "agent");
            xb_add(&bar[XB_XGEN(bx_)], 1u);
            asm volatile("s_waitcnt vmcnt(0)" ::: "memory");
        } else {
            XB_SPIN(xb_ld(&bar[XB_XGEN(bx_)]) == gen, bar);
            __builtin_amdgcn_fence(__ATOMIC_ACQUIRE, "agent");
            asm volatile("s_waitcnt vmcnt(0)" ::: "memory");
        }
    }
    __syncthreads();
}

struct Args {
    const float* in[21];
    float* out; unsigned char* ws;
};

__device__ __forceinline__ void transpose_item(const float* W, int ldw, int ncols, bf16* WT, int ldd, int row_off, int col_off, LAS float* scr, int item, int lane) {
    const int nblk = ncols / 32, kb = item / nblk, nb = item % nblk, k0 = 64 * kb, n0 = 32 * nb;
#pragma unroll 8
    for (int i = 0; i < 32; ++i) { const int kk = 2 * i + (lane >> 5); scr[kk * 33 + (lane & 31)] = W[(size_t)(k0 + kk) * ldw + n0 + (lane & 31)]; }
    LDS_WAIT(); asm volatile("" ::: "memory");
    const int c = lane & 7;
#pragma unroll
    for (int j = 0; j < 4; ++j) { const int n = (lane >> 3) + 8 * j; const LAS float* s = scr + (8 * c) * 33 + n;
        v4u o; o.x = pk2(s[0 * 33], s[1 * 33]); o.y = pk2(s[2 * 33], s[3 * 33]); o.z = pk2(s[4 * 33], s[5 * 33]); o.w = pk2(s[6 * 33], s[7 * 33]);
        *(GAS v4u*)(WT + (size_t)(row_off + n0 + n) * ldd + col_off + k0 + 8 * c) = o; }
    LDS_WAIT(); asm volatile("" ::: "memory");
}

__device__ __forceinline__ void convert_weights(const Args& a, LAS unsigned char* lds, int vcu, int G) {
    const int tid = opaque_tid(), lane = tid & 63, wave = __builtin_amdgcn_readfirstlane(tid >> 6), gw = vcu * NWAVES + wave, NGW = G * NWAVES;
    LAS float* scr = (LAS float*)(lds + wave * 16384);
    constexpr int I_IN1 = 16 * 96, I_IN2 = 16 * 144, I_BA = 16 * 32, I_BB = 8 * 32, I_BC = 8 * 32, I_O = 16 * 32, I_F1 = 16 * 128, I_F2 = 64 * 32;
    constexpr int PER_LAYER = I_IN1 + I_IN2 + I_BA + I_BB + I_BC + I_O + I_F1 + I_F2;
    for (int it = gw; it < 2 * PER_LAYER; it += NGW) {
        const int l = it / PER_LAYER; int r = it - l * PER_LAYER;
        unsigned char* wl = a.ws + WS_W + (size_t)l * W_LAYER;
        const float* w_in = a.in[5] + (size_t)l * D * IN_COLS;
        if (r < I_IN1) { transpose_item(w_in, IN_COLS, 3072, (bf16*)(wl + W_IN), D, 0, 0, scr, r, lane); continue; } r -= I_IN1;
        if (r < I_IN2) { transpose_item(w_in + 3088, IN_COLS, 4608, (bf16*)(wl + W_IN), D, 3072, 0, scr, r, lane); continue; } r -= I_IN2;
        if (r < I_BA) { transpose_item(a.in[13] + (size_t)l * 1024 * 1024, 1024, 1024, (bf16*)(wl + W_BR), 2048, 0, 0, scr, r, lane); continue; } r -= I_BA;
        if (r < I_BB) { transpose_item(a.in[14] + (size_t)l * 512 * 1024, 1024, 1024, (bf16*)(wl + W_BR), 2048, 0, 1024, scr, r, lane); continue; } r -= I_BB;
        if (r < I_BC) { transpose_item(a.in[15] + (size_t)l * 512 * 1024, 1024, 1024, (bf16*)(wl + W_BR), 2048, 0, 1536, scr, r, lane); continue; } r -= I_BC;
        if (r < I_O) { transpose_item(a.in[16] + (size_t)l * 1024 * 1024, 1024, 1024, (bf16*)(wl + W_OUT), 1024, 0, 0, scr, r, lane); continue; } r -= I_O;
        if (r < I_F1) { transpose_item(a.in[18] + (size_t)l * 1024 * FF, FF, FF, (bf16*)(wl + W_FF1), 1024, 0, 0, scr, r, lane); continue; } r -= I_F1;
        transpose_item(a.in[19] + (size_t)l * FF * 1024, 1024, 1024, (bf16*)(wl + W_FF2), FF, 0, 0, scr, r, lane);
    }
}

template <int MODE>
__device__ __forceinline__ void norm_phase(LAS unsigned char* lds, int vcu, int G,
                                           const float* hp, const float* hs, const float* w, bf16* HN, float* GLOG, float* outf,
                                           const float* w_in_l, const float* w_gk2_l, const float* b_gk_l, int mlo = 0, int mhi = M) {
    const int tid = opaque_tid(), lane = tid & 63, wave = __builtin_amdgcn_readfirstlane(tid >> 6), gw = vcu * NWAVES + wave, NGW = G * NWAVES;
    LAS float* Wg = (LAS float*)lds;
    LAS float* Wk = Wg + 16 * 1024;
    if (MODE == 1) {
        for (int idx = tid; idx < 16 * 1024; idx += 512) { const int k = idx >> 4, c = idx & 15; Wg[c * 1024 + k] = w_in_l[(size_t)k * IN_COLS + 3072 + c]; }
        for (int idx = tid; idx < 16 * 512; idx += 512) Wk[idx] = w_gk2_l[idx];
        __syncthreads();
    }
    f32x4 wv[4];
#pragma unroll
    for (int j = 0; j < 4; ++j) wv[j] = *(const f32x4*)(w + 4 * lane + 256 * j);
    for (int m = mlo + gw; m < mhi; m += NGW) {
        const float* xr = (m < MP) ? hp + (size_t)m * D : hs + (size_t)(m - MP) * D;
        f32x4 v[4]; float ss = 0.f;
#pragma unroll
        for (int j = 0; j < 4; ++j) { v[j] = *(const f32x4*)(xr + 4 * lane + 256 * j); ss += (v[j].x * v[j].x + v[j].y * v[j].y) + (v[j].z * v[j].z + v[j].w * v[j].w); }
        const float r = 1.0f / sqrtf(wave_sum(ss) * (1.0f / D) + EPS);
#pragma unroll
        for (int j = 0; j < 4; ++j) v[j] = v[j] * r * wv[j];
        if (MODE == 2) {
#pragma unroll
            for (int j = 0; j < 4; ++j) *(f32x4*)(outf + (size_t)m * D + 4 * lane + 256 * j) = v[j];
        } else {
#pragma unroll
            for (int j = 0; j < 4; ++j) { v2u o; o.x = pk2(v[j].x, v[j].y); o.y = pk2(v[j].z, v[j].w); *(v2u*)(HN + (size_t)m * D + 4 * lane + 256 * j) = o; }
        }
        if (MODE == 1) {
            float gl[16];
#pragma unroll
            for (int c = 0; c < 16; ++c) { float p = 0.f;
#pragma unroll
                for (int j = 0; j < 4; ++j) { const f32x4 wg = *(const LAS f32x4*)(Wg + c * 1024 + 4 * lane + 256 * j); p += (v[j].x * wg.x + v[j].y * wg.y) + (v[j].z * wg.z + v[j].w * wg.w); }
                gl[c] = wave_sum(p); if ((c & 3) == 3) asm volatile("" ::: "memory"); }
#pragma unroll
            for (int hb = 0; hb < 2; ++hb) { const int d0 = 4 * lane + 256 * hb;
                f32x4 acc = *(const f32x4*)(b_gk_l + d0);
#pragma unroll
                for (int c = 0; c < 16; ++c) { const f32x4 wk = *(const LAS f32x4*)(Wk + c * 512 + d0); acc = acc + wk * gl[c]; }
                f32x4 o;
#pragma unroll
                for (int i = 0; i < 4; ++i) { const float x = acc[i]; const float ls = (x < 0.f ? x : 0.f) - __logf(1.0f + __expf(-fabsf(x))); o[i] = ls * (1.0f / 16.0f); }
                *(f32x4*)(GLOG + (size_t)m * 512 + d0) = o; }
        }
    }
    if (MODE == 1) __syncthreads();
}

__device__ __forceinline__ void gla_seq(LAS unsigned char* lds, const bf16* PROJ, const float* GLOG, bf16* MIXOUT, const float* gn,
                                        int row0, int T, int h, const float* S0, float* Sout) {
    const int tid = opaque_tid(), lane = tid & 63, wave = __builtin_amdgcn_readfirstlane(tid >> 6);
    LAS float* qs = (LAS float*)lds;
    LAS float* ks = qs + 16 * 128;
    LAS float* as = ks + 16 * 128;
    LAS float* op = as + 16 * 128;
    const int e = tid & 255, dh = __builtin_amdgcn_readfirstlane(tid >> 8);
    float S[64];
#pragma unroll
    for (int i = 0; i < 64; ++i) S[i] = S0 ? S0[(size_t)(dh * 64 + i) * 256 + e] : 0.f;
    const int TB = T < 16 ? T : 16;
    for (int t0 = 0; t0 < T; t0 += TB) {
        __syncthreads();
        for (int idx = tid; idx < TB * 128; idx += 512) { const int t = idx >> 7, d = idx & 127; const size_t row = (size_t)(row0 + t0 + t);
            qs[idx] = bf2f(PROJ[row * NPJ + C_Q + h * 128 + d]); ks[idx] = bf2f(PROJ[row * NPJ + C_K + h * 128 + d]); as[idx] = __expf(GLOG[row * 512 + h * 128 + d]); }
        __syncthreads();
        for (int t = 0; t < TB; ++t) {
            const float v = bf2f(PROJ[(size_t)(row0 + t0 + t) * NPJ + C_V + h * 256 + e]);
            const LAS float* qp = qs + t * 128 + dh * 64; const LAS float* kp = ks + t * 128 + dh * 64; const LAS float* ap = as + t * 128 + dh * 64;
            float o = 0.f;
#pragma unroll
            for (int i4 = 0; i4 < 16; ++i4) { const f32x4 q4 = *(const LAS f32x4*)(qp + 4 * i4), k4 = *(const LAS f32x4*)(kp + 4 * i4), a4 = *(const LAS f32x4*)(ap + 4 * i4);
#pragma unroll
                for (int j = 0; j < 4; ++j) { const int i = 4 * i4 + j; S[i] = a4[j] * S[i] + k4[j] * v; o += q4[j] * S[i]; } }
            op[(t * 2 + dh) * 256 + e] = o;
        }
        __syncthreads();
#pragma unroll
        for (int tt = 0; tt < 2; ++tt) { const int t = wave * 2 + tt;
            if (t < TB) { const int e4 = lane * 4; const size_t row = (size_t)(row0 + t0 + t);
                const f32x4 o = *(const LAS f32x4*)(op + (t * 2) * 256 + e4) + *(const LAS f32x4*)(op + (t * 2 + 1) * 256 + e4);
                const float ss = wave_sum((o.x * o.x + o.y * o.y) + (o.z * o.z + o.w * o.w));
                const float r = 1.0f / sqrtf(ss * (1.0f / 256.0f) + EPS);
                const v2u gw2 = *(const v2u*)(PROJ + row * NPJ + C_GO + h * 256 + e4);
                const f32x4 g4 = *(const f32x4*)(gn + e4);
                const float g0 = bflo(gw2.x), g1 = bfhi(gw2.x), g2 = bflo(gw2.y), g3 = bfhi(gw2.y);
                v2u ow; ow.x = pk2(o.x * r * g4.x * (g0 * sigmoid_f(g0)), o.y * r * g4.y * (g1 * sigmoid_f(g1))); ow.y = pk2(o.z * r * g4.z * (g2 * sigmoid_f(g2)), o.w * r * g4.w * (g3 * sigmoid_f(g3)));
                *(v2u*)(MIXOUT + row * MIXW + h * 256 + e4) = ow; } }
    }
#pragma unroll
    for (int i = 0; i < 64; ++i) Sout[(size_t)(dh * 64 + i) * 256 + e] = S[i];
    __syncthreads();
}

typedef float f32x16 __attribute__((ext_vector_type(16)));
typedef short s16x4 __attribute__((ext_vector_type(4)));
#define MFMA32(a, b, c) __builtin_amdgcn_mfma_f32_32x32x16_bf16((a), (b), (c), 0, 0, 0)
constexpr int GL_QG = 0, GL_KG = 17408, GL_KD = 34816, GL_VV = 55296, GL_PP = 92160, GL_DEC = 101376, GL_TOT = 101888, GL_END = 110080;
constexpr int GL_SQ = 272, GL_SKD = 320, GL_SV = 576, GL_SP = 144, GL_SO = 1040;
static_assert(GL_END <= RING_BYTES && 64 * GL_SO <= GL_PP, "gla lds map");
__device__ __forceinline__ bf16x8 tr_frag(LAS unsigned char* p, int rowstride4) {
    const s16x4 lo = __builtin_amdgcn_ds_read_tr16_b64_v4i16((LAS s16x4*)p), hi = __builtin_amdgcn_ds_read_tr16_b64_v4i16((LAS s16x4*)(p + rowstride4));
    return __builtin_shufflevector(lo, hi, 0, 1, 2, 3, 4, 5, 6, 7);
}
template <bool FULL>
__device__ __forceinline__ void gla_chunked(LAS unsigned char* lds, const bf16* PROJ, const float* GLOG, bf16* MIXOUT, const float* gn, int row0, int nchunks, int h,
                                            int nprev, const float* Sloc_prev, const float* Dlog_prev, float* Sout, float* Dlog_out) {
    const int tid = opaque_tid(), lane = tid & 63, w = __builtin_amdgcn_readfirstlane(tid >> 6), r = lane & 31, hh = lane >> 5;
    const int tq = (lane & 15) >> 2, tp = lane & 3, tblk = (lane >> 4) & 1;
    const int dq = tid & 31, seg = tid >> 5;
    f32x16 S[4];
#pragma unroll
    for (int b = 0; b < 4; ++b)
#pragma unroll
        for (int i = 0; i < 16; ++i) S[b][i] = 0.f;
    for (int pi = 0; pi < nprev; ++pi) {
        int lo_ = 4 * hh * 256 + 32 * w + r; asm volatile("" : "+v"(lo_));
        const float* sp = Sloc_prev + (size_t)pi * 128 * 256 + lo_; const float* dp = Dlog_prev + pi * 128 + 4 * hh;
#pragma unroll
        for (int b = 0; b < 4; ++b) {
#pragma unroll
            for (int i = 0; i < 16; ++i) { const int dr = 32 * b + (i & 3) + 8 * (i >> 2); S[b][i] = __expf(dp[dr]) * S[b][i] + sp[dr * 256]; }
            asm volatile("" ::: "memory"); }
    }
    f32x4 dsum = (f32x4){0.f, 0.f, 0.f, 0.f};
    f32x4 gr[4]; v2u qv[4], kv[4]; v4u vv[4];
#define GLA_LOAD_RAW(R0) do { _Pragma("unroll") for (int i = 0; i < 4; ++i) { gr[i] = *(const f32x4*)(GLOG + (size_t)((R0) + 4 * seg + i) * 512 + h * 128 + 4 * dq); \
        const bf16* pr = PROJ + (size_t)((R0) + 4 * seg + i) * NPJ + h * 128 + 4 * dq; qv[i] = *(const v2u*)(pr + C_Q); kv[i] = *(const v2u*)(pr + C_K); } } while (0)
#define GLA_LOAD_V(R0) do { _Pragma("unroll") for (int i = 0; i < 4; ++i) { \
        const int idx = tid + 512 * i, sr = idx >> 5, ch = idx & 31; vv[i] = *(const v4u*)(PROJ + (size_t)((R0) + sr) * NPJ + C_V + h * 256 + ch * 8); } } while (0)
    GLA_LOAD_RAW(row0); GLA_LOAD_V(row0);
    for (int c = 0; c < nchunks; ++c) {
        const int r0 = row0 + 64 * c;
        {
            f32x4 cs[4];
#pragma unroll
            for (int i = 0; i < 4; ++i) { cs[i] = gr[i]; if (i) cs[i] = cs[i] + cs[i - 1]; }
            *(LAS f32x4*)(lds + GL_TOT + (seg * 128 + 4 * dq) * 4) = cs[3];
            LDS_BARRIER();
            f32x4 pre = (f32x4){0.f, 0.f, 0.f, 0.f}, tot = (f32x4){0.f, 0.f, 0.f, 0.f};
#pragma unroll
            for (int s2 = 0; s2 < 16; ++s2) { const f32x4 tv = *(const LAS f32x4*)(lds + GL_TOT + (s2 * 128 + 4 * dq) * 4); tot = tot + tv; if (s2 < seg) pre = pre + tv; }
#pragma unroll
            for (int i = 0; i < 4; ++i) { const f32x4 b = pre + cs[i]; const int t = 4 * seg + i;
                float q4[4] = {bflo(qv[i].x), bfhi(qv[i].x), bflo(qv[i].y), bfhi(qv[i].y)}, k4[4] = {bflo(kv[i].x), bfhi(kv[i].x), bflo(kv[i].y), bfhi(kv[i].y)};
                float qg[4], kg[4], kd[4];
#pragma unroll
                for (int j = 0; j < 4; ++j) { qg[j] = q4[j] * __expf(b[j]); kg[j] = k4[j] * __expf(-b[j]); kd[j] = k4[j] * __expf(tot[j] - b[j]); }
                v2u o;
                if (FULL) { o.x = pg8::cvt_pk_bf16(qg[0], qg[1]); o.y = pg8::cvt_pk_bf16(qg[2], qg[3]); *(LAS v2u*)(lds + GL_QG + t * GL_SQ + dq * 8) = o;
                            o.x = pg8::cvt_pk_bf16(kg[0], kg[1]); o.y = pg8::cvt_pk_bf16(kg[2], kg[3]); *(LAS v2u*)(lds + GL_KG + t * GL_SQ + dq * 8) = o; }
                o.x = pg8::cvt_pk_bf16(kd[0], kd[1]); o.y = pg8::cvt_pk_bf16(kd[2], kd[3]); *(LAS v2u*)(lds + GL_KD + t * GL_SKD + dq * 8) = o; }
            dsum = dsum + tot;
            if (seg == 0) { f32x4 dc; dc.x = __expf(tot.x); dc.y = __expf(tot.y); dc.z = __expf(tot.z); dc.w = __expf(tot.w); *(LAS f32x4*)(lds + GL_DEC + dq * 16) = dc; }
#pragma unroll
            for (int i = 0; i < 4; ++i) { const int idx = tid + 512 * i, sr = idx >> 5, ch = idx & 31; *(LAS v4u*)(lds + GL_VV + sr * GL_SV + ch * 16) = vv[i]; }
            if (c + 1 < nchunks) GLA_LOAD_RAW(r0 + 64);
        }
        LDS_BARRIER();
        for (int qa_ = 0; qa_ < REP_ATT; ++qa_) {
        if (FULL && w < 3) {
            const int bi = w > 0 ? 1 : 0, bj = w > 1 ? 1 : 0;
            f32x16 acc;
#pragma unroll
            for (int i = 0; i < 16; ++i) acc[i] = 0.f;
#pragma unroll
            for (int ks = 0; ks < 8; ++ks) {
                const bf16x8 a = *(const LAS bf16x8*)(lds + GL_QG + (32 * bi + r) * GL_SQ + (16 * ks + 8 * hh) * 2);
                const bf16x8 b = *(const LAS bf16x8*)(lds + GL_KG + (32 * bj + r) * GL_SQ + (16 * ks + 8 * hh) * 2);
                acc = MFMA32(a, b, acc); }
            int pbase = GL_PP + (32 * bi + 4 * hh) * GL_SP + (32 * bj + r) * 2; asm volatile("" : "+v"(pbase));
#pragma unroll
            for (int i = 0; i < 16; ++i) { const int tl = (i & 3) + 8 * (i >> 2) + 4 * hh; float v = acc[i]; if (bi == bj && r > tl) v = 0.f;
                *(LAS unsigned short*)(lds + pbase + ((i & 3) + 8 * (i >> 2)) * GL_SP) = (unsigned short)f2bf(v); }
        }
        if (FULL) LDS_BARRIER();
        }
        f32x16 o[2];
        {
            bf16x8 Bv[4];
#pragma unroll
            for (int ks = 0; ks < 4; ++ks) Bv[ks] = tr_frag(lds + GL_VV + (16 * ks + 8 * hh + tq) * GL_SV + (4 * w + 2 * tblk + (tp >> 1)) * 16 + 8 * (tp & 1), 4 * GL_SV);
            for (int qm_ = 0; qm_ < REP_OMM; ++qm_)
#pragma unroll
            for (int rb = 0; rb < (FULL ? 2 : 0); ++rb) {
#pragma unroll
                for (int i = 0; i < 16; ++i) o[rb][i] = 0.f;
#pragma unroll
                for (int b = 0; b < 4; ++b)
#pragma unroll
                    for (int s2 = 0; s2 < 2; ++s2) {
                        const LAS unsigned char* ap = lds + GL_QG + (32 * rb + r) * GL_SQ + (32 * b + 16 * s2 + 4 * hh) * 2;
                        const s16x4 lo = *(const LAS s16x4*)ap, hi = *(const LAS s16x4*)(ap + 16);
                        const bf16x8 a = __builtin_shufflevector(lo, hi, 0, 1, 2, 3, 4, 5, 6, 7);
                        v4u pk; pk.x = pg8::cvt_pk_bf16(S[b][8 * s2 + 0], S[b][8 * s2 + 1]); pk.y = pg8::cvt_pk_bf16(S[b][8 * s2 + 2], S[b][8 * s2 + 3]);
                        pk.z = pg8::cvt_pk_bf16(S[b][8 * s2 + 4], S[b][8 * s2 + 5]); pk.w = pg8::cvt_pk_bf16(S[b][8 * s2 + 6], S[b][8 * s2 + 7]);
                        o[rb] = MFMA32(a, __builtin_bit_cast(bf16x8, pk), o[rb]); if (s2) asm volatile("" ::: "memory"); }
#pragma unroll
                for (int ks = 0; ks < 4; ++ks) if (ks < 2 || rb == 1) {
                    const bf16x8 a = *(const LAS bf16x8*)(lds + GL_PP + (32 * rb + r) * GL_SP + (16 * ks + 8 * hh) * 2);
                    o[rb] = MFMA32(a, Bv[ks], o[rb]); }
            }
#pragma unroll
            for (int b = 0; b < 4; ++b) {
#pragma unroll
                for (int g4 = 0; g4 < 4; ++g4) { const f32x4 dc = *(const LAS f32x4*)(lds + GL_DEC + (32 * b + 8 * g4 + 4 * hh) * 4);
#pragma unroll
                    for (int j = 0; j < 4; ++j) S[b][4 * g4 + j] *= dc[j]; }
#pragma unroll
                for (int ks = 0; ks < 4; ++ks) {
                    const bf16x8 a = tr_frag(lds + GL_KD + (16 * ks + 8 * hh + tq) * GL_SKD + (4 * b + 2 * tblk + (tp >> 1)) * 16 + 8 * (tp & 1), 4 * GL_SKD);
                    S[b] = MFMA32(a, Bv[ks], S[b]); }
                asm volatile("" ::: "memory");
            }
        }
        LDS_BARRIER();
        if (!FULL) { if (c + 1 < nchunks) GLA_LOAD_V(r0 + 64); }
        if (FULL) for (int qe_ = 0; qe_ < REP_EPI; ++qe_) {
        v4u gpre[4];
#pragma unroll
        for (int i = 0; i < 4; ++i) gpre[i] = *(const v4u*)(PROJ + (size_t)(r0 + (tid >> 3)) * NPJ + C_GO + h * 256 + (tid & 7) * 32 + 8 * i);
        int obase = 4 * hh * GL_SO + (32 * w + r) * 4; asm volatile("" : "+v"(obase));
#pragma unroll
        for (int rb = 0; rb < 2; ++rb)
#pragma unroll
            for (int i = 0; i < 16; ++i) *(LAS float*)(lds + obase + (32 * rb + (i & 3) + 8 * (i >> 2)) * GL_SO) = o[rb][i];
        if (c + 1 < nchunks) GLA_LOAD_V(r0 + 64);
        LDS_BARRIER();
        {
            const int t = tid >> 3, sg = tid & 7, e0 = sg * 32; const size_t row = (size_t)(r0 + t);
            int e0g = e0; asm volatile("" : "+v"(e0g));
            f32x4 ov[8]; float ss = 0.f;
#pragma unroll
            for (int i = 0; i < 8; ++i) { ov[i] = *(const LAS f32x4*)(lds + t * GL_SO + (e0 + 4 * i) * 4); ss += (ov[i].x * ov[i].x + ov[i].y * ov[i].y) + (ov[i].z * ov[i].z + ov[i].w * ov[i].w); }
            ss += __shfl_xor(ss, 1); ss += __shfl_xor(ss, 2); ss += __shfl_xor(ss, 4);
            const float rn = 1.0f / sqrtf(ss * (1.0f / 256.0f) + EPS);
#pragma unroll
            for (int i = 0; i < 4; ++i) { const v4u gw4 = gpre[i];
                const f32x4 ga = *(const f32x4*)(gn + e0g + 8 * i), gb = *(const f32x4*)(gn + e0g + 8 * i + 4);
                const float g0 = bflo(gw4.x), g1 = bfhi(gw4.x), g2 = bflo(gw4.y), g3 = bfhi(gw4.y), g4 = bflo(gw4.z), g5 = bfhi(gw4.z), g6 = bflo(gw4.w), g7 = bfhi(gw4.w);
                const f32x4 oa = ov[2 * i], ob = ov[2 * i + 1]; v4u ow;
                ow.x = pg8::cvt_pk_bf16(oa.x * rn * ga.x * (g0 * sigmoid_f(g0)), oa.y * rn * ga.y * (g1 * sigmoid_f(g1)));
                ow.y = pg8::cvt_pk_bf16(oa.z * rn * ga.z * (g2 * sigmoid_f(g2)), oa.w * rn * ga.w * (g3 * sigmoid_f(g3)));
                ow.z = pg8::cvt_pk_bf16(ob.x * rn * gb.x * (g4 * sigmoid_f(g4)), ob.y * rn * gb.y * (g5 * sigmoid_f(g5)));
                ow.w = pg8::cvt_pk_bf16(ob.z * rn * gb.z * (g6 * sigmoid_f(g6)), ob.w * rn * gb.w * (g7 * sigmoid_f(g7)));
                *(v4u*)(MIXOUT + row * MIXW + h * 256 + e0 + 8 * i) = ow; }
        }
        LDS_BARRIER();
        }
    }
    if (Sout) {
        int lo_ = 4 * hh * 256 + 32 * w + r; asm volatile("" : "+v"(lo_)); float* sop = Sout + lo_;
#pragma unroll
        for (int b = 0; b < 4; ++b) {
#pragma unroll
            for (int i = 0; i < 16; ++i) sop[(32 * b + (i & 3) + 8 * (i >> 2)) * 256] = S[b][i];
            asm volatile("" ::: "memory"); }
    }
    if (Dlog_out && seg == 0) *(f32x4*)(Dlog_out + 4 * dq) = dsum;
#undef GLA_LOAD_RAW
#undef GLA_LOAD_V
}

__device__ __forceinline__ void gla_sample(LAS unsigned char* lds, const bf16* PROJ, const float* GLOG, bf16* MIXOUT, const float* gn, int r0, int h, const float* S0, float* Sout) {
    const int tid = opaque_tid(), lane = tid & 63, w = __builtin_amdgcn_readfirstlane(tid >> 6), r = lane & 31, hh = lane >> 5;
    const int tq = (lane & 15) >> 2, tp = lane & 3, tblk = (lane >> 4) & 1;
    if (tid < 32) {
        const int dq = tid; f32x4 b = (f32x4){0.f, 0.f, 0.f, 0.f}, bs[8];
#pragma unroll
        for (int t = 0; t < 8; ++t) { b = b + *(const f32x4*)(GLOG + (size_t)(r0 + t) * 512 + h * 128 + 4 * dq); bs[t] = b; }
#pragma unroll
        for (int t = 0; t < 8; ++t) { const bf16* pr = PROJ + (size_t)(r0 + t) * NPJ + h * 128 + 4 * dq; const v2u qv = *(const v2u*)(pr + C_Q), kv = *(const v2u*)(pr + C_K);
            const float q4[4] = {bflo(qv.x), bfhi(qv.x), bflo(qv.y), bfhi(qv.y)}, k4[4] = {bflo(kv.x), bfhi(kv.x), bflo(kv.y), bfhi(kv.y)};
            float qg[4], kg[4], kd[4];
#pragma unroll
            for (int j = 0; j < 4; ++j) { qg[j] = q4[j] * __expf(bs[t][j]); kg[j] = k4[j] * __expf(-bs[t][j]); kd[j] = k4[j] * __expf(b[j] - bs[t][j]); }
            v2u o; o.x = pg8::cvt_pk_bf16(qg[0], qg[1]); o.y = pg8::cvt_pk_bf16(qg[2], qg[3]); *(LAS v2u*)(lds + GL_QG + t * GL_SQ + dq * 8) = o;
            o.x = pg8::cvt_pk_bf16(kg[0], kg[1]); o.y = pg8::cvt_pk_bf16(kg[2], kg[3]); *(LAS v2u*)(lds + GL_KG + t * GL_SQ + dq * 8) = o;
            o.x = pg8::cvt_pk_bf16(kd[0], kd[1]); o.y = pg8::cvt_pk_bf16(kd[2], kd[3]); *(LAS v2u*)(lds + GL_KD + t * GL_SKD + dq * 8) = o; }
        f32x4 dc; dc.x = __expf(b.x); dc.y = __expf(b.y); dc.z = __expf(b.z); dc.w = __expf(b.w); *(LAS f32x4*)(lds + GL_DEC + dq * 16) = dc;
    } else if (tid >= 256) {
        const int idx = tid - 256, sr = idx >> 5, ch = idx & 31;
        *(LAS v4u*)(lds + GL_VV + sr * GL_SV + ch * 16) = *(const v4u*)(PROJ + (size_t)(r0 + sr) * NPJ + C_V + h * 256 + ch * 8);
    } else if (tid >= 64) {
        const v4u z = (v4u){0u, 0u, 0u, 0u};
        for (int idx = tid - 64; idx < 256 + 128; idx += 192) {
            if (idx < 256) *(LAS v4u*)(lds + GL_VV + (8 + (idx >> 5)) * GL_SV + (idx & 31) * 16) = z;
            else { const int k2 = idx - 256; *(LAS v4u*)(lds + GL_KD + (8 + (k2 >> 4)) * GL_SKD + (k2 & 15) * 16) = z; } }
    }
    asm volatile("" ::: "memory");
    int lane_off = 4 * hh * 256 + 32 * w + r; asm volatile("" : "+v"(lane_off));
    const float* s0p = S0 + lane_off; float* sop = Sout + lane_off;
    f32x16 S[4];
#pragma unroll
    for (int b = 0; b < 4; ++b) {
#pragma unroll
        for (int i = 0; i < 16; ++i) S[b][i] = s0p[(32 * b + (i & 3) + 8 * (i >> 2)) * 256];
        asm volatile("" ::: "memory"); }
    LDS_BARRIER();
    if (w == 0) {
        f32x16 acc;
#pragma unroll
        for (int i = 0; i < 16; ++i) acc[i] = 0.f;
#pragma unroll
        for (int ks = 0; ks < 8; ++ks) {
            const bf16x8 a = *(const LAS bf16x8*)(lds + GL_QG + r * GL_SQ + (16 * ks + 8 * hh) * 2);
            const bf16x8 b = *(const LAS bf16x8*)(lds + GL_KG + r * GL_SQ + (16 * ks + 8 * hh) * 2);
            acc = MFMA32(a, b, acc); }
#pragma unroll
        for (int i = 0; i < 16; ++i) { const int tl = (i & 3) + 8 * (i >> 2) + 4 * hh; float v = acc[i]; if (r > tl || tl >= 8) v = 0.f;
            if (r < 16) *(LAS unsigned short*)(lds + GL_PP + tl * GL_SP + r * 2) = (unsigned short)f2bf(v); }
    }
    LDS_BARRIER();
    f32x16 o;
    {
        const bf16x8 Bv = tr_frag(lds + GL_VV + (8 * hh + tq) * GL_SV + (4 * w + 2 * tblk + (tp >> 1)) * 16 + 8 * (tp & 1), 4 * GL_SV);
#pragma unroll
        for (int i = 0; i < 16; ++i) o[i] = 0.f;
#pragma unroll
        for (int b = 0; b < 4; ++b)
#pragma unroll
            for (int s2 = 0; s2 < 2; ++s2) {
                const LAS unsigned char* ap = lds + GL_QG + r * GL_SQ + (32 * b + 16 * s2 + 4 * hh) * 2;
                const s16x4 lo = *(const LAS s16x4*)ap, hi = *(const LAS s16x4*)(ap + 16);
                const bf16x8 a = __builtin_shufflevector(lo, hi, 0, 1, 2, 3, 4, 5, 6, 7);
                v4u pk; pk.x = pg8::cvt_pk_bf16(S[b][8 * s2 + 0], S[b][8 * s2 + 1]); pk.y = pg8::cvt_pk_bf16(S[b][8 * s2 + 2], S[b][8 * s2 + 3]);
                pk.z = pg8::cvt_pk_bf16(S[b][8 * s2 + 4], S[b][8 * s2 + 5]); pk.w = pg8::cvt_pk_bf16(S[b][8 * s2 + 6], S[b][8 * s2 + 7]);
                o = MFMA32(a, __builtin_bit_cast(bf16x8, pk), o); }
        { const bf16x8 a = *(const LAS bf16x8*)(lds + GL_PP + r * GL_SP + (8 * hh) * 2); o = MFMA32(a, Bv, o); }
#pragma unroll
        for (int b = 0; b < 4; ++b) {
#pragma unroll
            for (int g4 = 0; g4 < 4; ++g4) { const f32x4 dc = *(const LAS f32x4*)(lds + GL_DEC + (32 * b + 8 * g4 + 4 * hh) * 4);
#pragma unroll
                for (int j = 0; j < 4; ++j) S[b][4 * g4 + j] *= dc[j]; }
            const bf16x8 a = tr_frag(lds + GL_KD + (8 * hh + tq) * GL_SKD + (4 * b + 2 * tblk + (tp >> 1)) * 16 + 8 * (tp & 1), 4 * GL_SKD);
            S[b] = MFMA32(a, Bv, S[b]); }
    }
    LDS_BARRIER();
#pragma unroll
    for (int i = 0; i < 4; ++i) *(LAS float*)(lds + (i + 4 * hh) * GL_SO + (32 * w + r) * 4) = o[i];
    LDS_BARRIER();
    if (tid < 64) {
        const int t = tid >> 3, sg = tid & 7, e0 = sg * 32; const size_t row = (size_t)(r0 + t);
        f32x4 ov[8]; float ss = 0.f;
#pragma unroll
        for (int i = 0; i < 8; ++i) { ov[i] = *(const LAS f32x4*)(lds + t * GL_SO + (e0 + 4 * i) * 4); ss += (ov[i].x * ov[i].x + ov[i].y * ov[i].y) + (ov[i].z * ov[i].z + ov[i].w * ov[i].w); }
        ss += __shfl_xor(ss, 1); ss += __shfl_xor(ss, 2); ss += __shfl_xor(ss, 4);
        const float rn = 1.0f / sqrtf(ss * (1.0f / 256.0f) + EPS);
#pragma unroll
        for (int i = 0; i < 4; ++i) { const v4u gw4 = *(const v4u*)(PROJ + row * NPJ + C_GO + h * 256 + e0 + 8 * i);
            const f32x4 ga = *(const f32x4*)(gn + e0 + 8 * i), gb = *(const f32x4*)(gn + e0 + 8 * i + 4);
            const float g0 = bflo(gw4.x), g1 = bfhi(gw4.x), g2 = bflo(gw4.y), g3 = bfhi(gw4.y), g4 = bflo(gw4.z), g5 = bfhi(gw4.z), g6 = bflo(gw4.w), g7 = bfhi(gw4.w);
            const f32x4 oa = ov[2 * i], ob = ov[2 * i + 1]; v4u ow;
            ow.x = pg8::cvt_pk_bf16(oa.x * rn * ga.x * (g0 * sigmoid_f(g0)), oa.y * rn * ga.y * (g1 * sigmoid_f(g1)));
            ow.y = pg8::cvt_pk_bf16(oa.z * rn * ga.z * (g2 * sigmoid_f(g2)), oa.w * rn * ga.w * (g3 * sigmoid_f(g3)));
            ow.z = pg8::cvt_pk_bf16(ob.x * rn * gb.x * (g4 * sigmoid_f(g4)), ob.y * rn * gb.y * (g5 * sigmoid_f(g5)));
            ow.w = pg8::cvt_pk_bf16(ob.z * rn * gb.z * (g6 * sigmoid_f(g6)), ob.w * rn * gb.w * (g7 * sigmoid_f(g7)));
            *(v4u*)(MIXOUT + row * MIXW + h * 256 + e0 + 8 * i) = ow; }
    }
#pragma unroll
    for (int b = 0; b < 4; ++b) {
#pragma unroll
        for (int i = 0; i < 16; ++i) sop[(32 * b + (i & 3) + 8 * (i >> 2)) * 256] = S[b][i];
        asm volatile("" ::: "memory"); }
    LDS_BARRIER();
}

constexpr int PL_W = 0, PL_A = 40960, PL_SW = 320, PL_SA = 272;
__device__ __forceinline__ void mat128_to_lds(LAS unsigned char* lds, int off, int stride, const float* src, bool tril) {
    const int tid = opaque_tid();
#pragma unroll
    for (int i = 0; i < 8; ++i) { const int idx = tid + 512 * i, row = idx >> 5, c4 = idx & 31; f32x4 v = *(const f32x4*)(src + row * 128 + 4 * c4);
        if (tril) { if (4 * c4 + 0 > row) v.x = 0.f; if (4 * c4 + 1 > row) v.y = 0.f; if (4 * c4 + 2 > row) v.z = 0.f; if (4 * c4 + 3 > row) v.w = 0.f; }
        v2u o; o.x = pg8::cvt_pk_bf16(v.x, v.y); o.y = pg8::cvt_pk_bf16(v.z, v.w); *(LAS v2u*)(lds + off + row * stride + c4 * 8) = o; }
}
template <int G>
__device__ __forceinline__ void pool_tile(LAS unsigned char* lds, const bf16* PROJ, bf16* MIXOUT, const float* scale_g, const float* hist_l, int row0, int pos0, bool sample, int seq0) {
    const int tid = opaque_tid(), lane = tid & 63, w = __builtin_amdgcn_readfirstlane(tid >> 6), r = lane & 31, hh = lane >> 5;
    const int tq = (lane & 15) >> 2, tp = lane & 3, tblk = (lane >> 4) & 1;
    const int c = tid & 127, tqr = tid >> 7, col = C_XP + G * 128 + c;
    constexpr int WIN = 2 << G;
    if (!sample) {
        float P[32]; P[0] = 0.f; float xs[31];
#pragma unroll
        for (int i = 0; i < 31; ++i) { const int p = pos0 + 16 * tqr - 15 + i; xs[i] = p >= 0 ? bf2f(PROJ[(size_t)(row0 - pos0 + p) * NPJ + col]) : 0.f; P[i + 1] = P[i] + xs[i]; }
#pragma unroll
        for (int tt = 0; tt < 16; ++tt) { const int pos = pos0 + 16 * tqr + tt; const int cnt = WIN < pos + 1 ? WIN : pos + 1;
            const float pooled = (P[16 + tt] - P[16 + tt - WIN]) / (float)cnt - xs[15 + tt];
            *(LAS unsigned short*)(lds + PL_A + (16 * tqr + tt) * PL_SA + c * 2) = (unsigned short)f2bf(pooled); }
    } else {
#pragma unroll
        for (int sq = 0; sq < 2; ++sq) { const int seq = seq0 + 2 * tqr + sq;
            float P[24]; P[0] = 0.f; float xs[23];
#pragma unroll
            for (int i = 0; i < 23; ++i) { xs[i] = i < 15 ? hist_l[((size_t)seq * 15 + i) * 512 + G * 128 + c] : bf2f(PROJ[(size_t)(MP + seq * ST + i - 15) * NPJ + col]); P[i + 1] = P[i] + xs[i]; }
#pragma unroll
            for (int tt = 0; tt < 8; ++tt) { const float pooled = (P[16 + tt] - P[16 + tt - WIN]) * (1.0f / (float)WIN) - xs[15 + tt];
                *(LAS unsigned short*)(lds + PL_A + (16 * tqr + 8 * sq + tt) * PL_SA + c * 2) = (unsigned short)f2bf(pooled); } }
    }
    LDS_BARRIER();
    {
        const int rb = w & 1, cb = w >> 1; f32x16 acc;
#pragma unroll
        for (int i = 0; i < 16; ++i) acc[i] = 0.f;
#pragma unroll
        for (int ks = 0; ks < 8; ++ks) {
            const bf16x8 a = *(const LAS bf16x8*)(lds + PL_A + (32 * rb + r) * PL_SA + (16 * ks + 8 * hh) * 2);
            const bf16x8 b = tr_frag(lds + PL_W + (16 * ks + 8 * hh + tq) * PL_SW + (4 * cb + 2 * tblk + (tp >> 1)) * 16 + 8 * (tp & 1), 4 * PL_SW);
            acc = MFMA32(a, b, acc); }
        const float sc = scale_g[32 * cb + r];
#pragma unroll
        for (int i = 0; i < 16; ++i) { const int t = 32 * rb + (i & 3) + 8 * (i >> 2) + 4 * hh;
            MIXOUT[(size_t)(row0 + t) * MIXW + 1024 + G * 128 + 32 * cb + r] = (bf16)f2bf(acc[i] * sc); }
    }
    LDS_BARRIER();
}
constexpr int SG_WT = 0, SG_VI = 34816, SG_SW = 272, SG_SV = 320;
__device__ __forceinline__ void sg_chunk(LAS unsigned char* lds, const bf16* PROJ, bf16* MIXOUT, const float* bs_g, int row0, int g) {
    const int tid = opaque_tid(), lane = tid & 63, w = __builtin_amdgcn_readfirstlane(tid >> 6), r = lane & 31, hh = lane >> 5;
    const int tq = (lane & 15) >> 2, tp = lane & 3, tblk = (lane >> 4) & 1;
#pragma unroll
    for (int i = 0; i < 4; ++i) { const int idx = tid + 512 * i, sr = idx >> 4, ch = idx & 15;
        *(LAS v4u*)(lds + SG_VI + sr * SG_SV + ch * 16) = *(const v4u*)(PROJ + (size_t)(row0 + sr) * NPJ + C_VV + g * 128 + ch * 8); }
    LDS_BARRIER();
    const int dj = w & 3, pair = w >> 2;
#pragma unroll
    for (int pass = 0; pass < 2; ++pass) {
        const int bi = pass == 0 ? pair : 3 - pair, nks = 2 * (bi + 1);
        f32x16 acc;
#pragma unroll
        for (int i = 0; i < 16; ++i) acc[i] = 0.f;
#pragma unroll
        for (int ks = 0; ks < 8; ++ks) if (ks < nks) {
            const bf16x8 a = *(const LAS bf16x8*)(lds + SG_WT + (32 * bi + r) * SG_SW + (16 * ks + 8 * hh) * 2);
            const bf16x8 b = tr_frag(lds + SG_VI + (16 * ks + 8 * hh + tq) * SG_SV + (4 * dj + 2 * tblk + (tp >> 1)) * 16 + 8 * (tp & 1), 4 * SG_SV);
            acc = MFMA32(a, b, acc); }
#pragma unroll
        for (int i = 0; i < 16; ++i) { const int t = 32 * bi + (i & 3) + 8 * (i >> 2) + 4 * hh, d = 32 * dj + r;
            const float u = bf2f(PROJ[(size_t)(row0 + t) * NPJ + C_U + g * 128 + d]);
            MIXOUT[(size_t)(row0 + t) * MIXW + 1536 + g * 128 + d] = (bf16)f2bf(u * (acc[i] + bs_g[t])); }
    }
    LDS_BARRIER();
}

__device__ __forceinline__ void pool_item(LAS unsigned char* lds, const bf16* PROJ, bf16* MIXOUT, const float* wmix, const float* scale, const float* hist  ,
                                          int rowseq0, int tpos0, int nt, int g) {
    const int tid = opaque_tid();
    LAS float* pl = (LAS float*)lds;
    const int w = 2 << g;
    for (int idx = tid; idx < nt * 128; idx += 512) { const int t = idx >> 7, c = idx & 127, pos = tpos0 + t, col = C_XP + g * 128 + c;
        float sum = 0.f;
        for (int i = 0; i < w; ++i) { const int p = pos - i;
            if (p >= 0) sum += bf2f(PROJ[(size_t)(rowseq0 + p) * NPJ + col]);
            else if (hist) sum += hist[(size_t)(15 + p) * 512 + g * 128 + c]; }
        const int cnt = hist ? w : (w < pos + 1 ? w : pos + 1);
        pl[idx] = sum / (float)cnt - bf2f(PROJ[(size_t)(rowseq0 + pos) * NPJ + col]); }
    __syncthreads();
    const int j = tid & 127, tq = __builtin_amdgcn_readfirstlane(tid >> 7), tpq = nt >> 2;
    float acc[4] = {0.f, 0.f, 0.f, 0.f};
    for (int c = 0; c < 128; ++c) { const float wv = wmix[(size_t)(g * 128 + c) * 128 + j];
#pragma unroll
        for (int i = 0; i < 4; ++i) if (i < tpq) acc[i] += pl[(tq * tpq + i) * 128 + c] * wv; }
    const float sc = scale[g * 128 + j];
#pragma unroll
    for (int i = 0; i < 4; ++i) if (i < tpq) MIXOUT[(size_t)(rowseq0 + tpos0 + tq * tpq + i) * MIXW + 1024 + g * 128 + j] = (bf16)f2bf(acc[i] * sc);
    __syncthreads();
}

__device__ __forceinline__ void sg_item(LAS unsigned char* lds, const bf16* PROJ, bf16* MIXOUT, const float* ws, const float* bs, int row0, int L, int g) {
    const int tid = opaque_tid();
    LAS float* vt = (LAS float*)lds;
    LAS float* wt = vt + 128 * 128;
    for (int idx = tid; idx < L * 128; idx += 512) { const int s = idx >> 7, d = idx & 127;
        vt[idx] = bf2f(PROJ[(size_t)(row0 + s) * NPJ + C_VV + g * 128 + d]);
        wt[idx] = ws[(size_t)(g * 128 + s) * 128 + d]; }
    __syncthreads();
    const int d = tid & 127, tq = __builtin_amdgcn_readfirstlane(tid >> 7);
    for (int t = tq; t < L; t += 4) { float acc = 0.f;
        for (int s = 0; s <= t; ++s) acc += wt[t * 128 + s] * vt[s * 128 + d];
        const float u = bf2f(PROJ[(size_t)(row0 + t) * NPJ + C_U + g * 128 + d]);
        MIXOUT[(size_t)(row0 + t) * MIXW + 1536 + g * 128 + d] = (bf16)f2bf(u * (acc + bs[g * 128 + t])); }
    __syncthreads();
}


#ifndef PH
#define PH 0xFFFF
#endif
#if PH & 4096
#define MROWS MP
#else
#define MROWS M
#endif
__global__ void __launch_bounds__(NWAVES * 64, 2) hybrid_fwd(Args args) {
    extern __shared__ __attribute__((aligned(16))) unsigned char lds_raw[];
    LAS unsigned char* lds = (LAS unsigned char*)lds_raw;
    volatile LAS unsigned* MISC = (volatile LAS unsigned*)(lds + MISC_OFF);
    const int G = gridDim.x, bx = blockIdx.x, vcu = (G % 8 == 0) ? (bx % 8) * (G / 8) + bx / 8 : bx;
    unsigned char* ws = args.ws;
    gu32* ctl = (gu32*)(ws + WS_CTL);
    for (int u = threadIdx.x; u < (LDS_BYTES - LDSCTL_OFF) / 4; u += NWAVES * 64) ((LAS unsigned*)(lds + LDSCTL_OFF))[u] = 0u;
    __syncthreads();
    XcdBarrier bar = xcd_barrier_post((unsigned*)(ctl + CW_BAR), MISC + 8, (unsigned)G, true);
    XcdBarrier bar2 = xcd_barrier_post((unsigned*)(ctl + CW_BAR2), MISC + 10, 64u, vcu >= 128 && vcu < 192);
#ifdef USE_CG
#define GRID_BAR() cooperative_groups::this_grid().sync()
#else
#define GRID_BAR() xcd_barrier(bar)
#endif

    bf16* HN = (bf16*)(ws + WS_HN);
    float* GLOG = (float*)(ws + WS_GLOG);
    float* SLOC = (float*)(ws + WS_HN);
    float* DLOG = (float*)(ws + WS_HN + 16 * MiB);
    bf16* MIX = (bf16*)(ws + WS_MIX);
    bf16* PROJ = (bf16*)(ws + WS_PROJ);
    bf16* FFH = (bf16*)(ws + WS_PROJ);
    bf16* FFHS = (bf16*)(ws + WS_FFHS);
    float* SLAB = (float*)(ws + WS_SLAB);
    float* H = args.out + O_Y;
    const float* xp_in = args.in[0]; const float* xs_in = args.in[1];

#if PH & 1
    for (int q_ = 0; q_ < REP_CONV; ++q_) { convert_weights(args, lds, vcu, G);
    __syncthreads(); }
#endif
#if PH & 2
    for (int q_ = 0; q_ < REP_N1; ++q_)
    norm_phase<1>(lds, vcu, G, xp_in, xs_in, args.in[4], HN, GLOG, nullptr, args.in[5], args.in[6], args.in[7]);
#endif
    GRID_BAR();

#ifdef EXP_ONELAYER
    for (int l = 0; l < 1; ++l) {
#else
    for (int l = 0; l < DEPTH; ++l) {
#endif
        unsigned char* wl = ws + WS_W + (size_t)l * W_LAYER;
#if PH & 4
        if (l > 0) {
            norm_phase<1>(lds, vcu, G, H, H + (size_t)MP * D, args.in[4] + l * D, HN, GLOG, nullptr, args.in[5] + (size_t)l * D * IN_COLS, args.in[6] + l * 16 * 512, args.in[7] + l * 512);
            GRID_BAR();
        }
#endif
        for (int rep_ = 0; rep_ < REP_PROJ; ++rep_) {
#if PH & 8
        {
            pg8::Gemm g{HN, (const bf16*)(wl + W_IN), D, D}; pg8::Order S; S.init(M, NPJ, D, G, bx, 1);
            pg8::EpiProj E{PROJ, args.out + O_SGV + (size_t)l * MS * 512, H};
            pg8::gemm_phase<pg8::EpiProj>(lds, g, S, E);
        }
#endif
        GRID_BAR();
        }
        for (int rep_ = 0; rep_ < REP_MIX; ++rep_) {
        {
            const float* gn = args.in[8] + l * 256;
            if (vcu < 96) {
#if PH & 16
                const int nh = vcu / 3, js = vcu - 3 * nh;
                for (int q_ = 0; q_ < REP_P1; ++q_)
                gla_chunked<false>(lds, PROJ, GLOG, MIX, gn, (nh >> 2) * SEQ + js * (SEQ / 4), SEQ / 256, nh & 3, 0, nullptr, nullptr, SLOC + (size_t)(nh * 3 + js) * 128 * 256, DLOG + (nh * 3 + js) * 128);
#endif
            } else {
#if PH & 32
                const float* wmix = args.in[9] + (size_t)l * 4 * 128 * 128; const float* pscale = args.in[10] + l * 512;
                const float* wsp = args.in[11] + (size_t)l * 4 * 128 * 128; const float* bsp = args.in[12] + l * 4 * 128;
                const float* spool = args.in[3] + (size_t)l * SB * 15 * 512;
                for (int rl_ = 0; rl_ < REP_LIGHT; ++rl_) {
                const int j = vcu - 96, NJ = G - 96, g = j & 3, jj = j >> 2, NJJ = NJ >> 2;
                for (int q_ = 0; q_ < REP_GS; ++q_)
                for (int it = j; it < SB * 4; it += NJ) { const int n = it >> 2, h = it & 3; const size_t so = ((size_t)(l * SB + n) * 4 + h) * 128 * 256;
#ifndef SKIP_GS
                    gla_sample(lds, PROJ, GLOG, MIX, gn, MP + n * ST, h, args.in[2] + so, args.out + O_GLAS + so); }
#else
 }
#endif
                if (jj < 16) mat128_to_lds(lds, PL_W, PL_SW, wmix + (size_t)g * 128 * 128, false);
                for (int q_ = 0; q_ < REP_PL; ++q_)
                for (int tile = 256 + jj; tile < 256 + 16; tile += NJJ) {
                    const bool smp = tile >= 256; const int st = tile - 256;
                    const int row0 = smp ? MP + st * 64 : (tile >> 5) * SEQ + (tile & 31) * 64, pos0 = smp ? 0 : (tile & 31) * 64;
#ifndef SKIP_PL
                    if (g == 0) pool_tile<0>(lds, PROJ, MIX, pscale, spool, row0, pos0, smp, st * 8);
                    else if (g == 1) pool_tile<1>(lds, PROJ, MIX, pscale + 128, spool, row0, pos0, smp, st * 8);
                    else if (g == 2) pool_tile<2>(lds, PROJ, MIX, pscale + 256, spool, row0, pos0, smp, st * 8);
                    else pool_tile<3>(lds, PROJ, MIX, pscale + 384, spool, row0, pos0, smp, st * 8);
#endif
                }
                for (int q_ = 0; q_ < REP_SS; ++q_)
                for (int it = j; it < 512 + 136; it += NJ) {
                    int r = it;
                    if (r < 512) { const int g2 = r & 3, n = r >> 2; sg_item(lds, PROJ, MIX, wsp, bsp, MP + n * ST, ST, g2); continue; } r -= 512;
                    const int tid = opaque_tid();
                    if (r < NB) { const int n = r; float* o = args.out + O_POOLP + (size_t)(l * NB + n) * 15 * 512;
                        for (int idx = tid; idx < 15 * 512; idx += 512) { const int i = idx >> 9, c = idx & 511; o[idx] = bf2f(PROJ[(size_t)(n * SEQ + SEQ - 15 + i) * NPJ + C_XP + c]); } }
                    else { const int n = r - NB; float* o = args.out + O_POOLS + (size_t)(l * SB + n) * 15 * 512; const float* hs = spool + (size_t)n * 15 * 512;
                        for (int idx = tid; idx < 15 * 512; idx += 512) { const int i = idx >> 9, c = idx & 511; o[idx] = i < 7 ? hs[(size_t)(8 + i) * 512 + c] : bf2f(PROJ[(size_t)(MP + n * ST + i - 7) * NPJ + C_XP + c]); } }
                }
                }
#endif
            }
        }
        GRID_BAR();
#if PH & 16
        if (vcu < 128) {
            const int nh = vcu >> 2, js = vcu & 3;
            for (int q_ = 0; q_ < REP_P2; ++q_)
            gla_chunked<true>(lds, PROJ, GLOG, MIX, args.in[8] + l * 256, (nh >> 2) * SEQ + js * (SEQ / 4), SEQ / 256, nh & 3, js, SLOC + (size_t)nh * 3 * 128 * 256, DLOG + nh * 3 * 128,
                              js == 3 ? args.out + O_GLAP + ((size_t)(l * NB + (nh >> 2)) * 4 + (nh & 3)) * 128 * 256 : nullptr, nullptr);
#if PH & 32
            {
                const float* wmix = args.in[9] + (size_t)l * 4 * 128 * 128; const float* pscale = args.in[10] + l * 512;
                const int g = vcu & 3, jj = vcu >> 2;
                mat128_to_lds(lds, PL_W, PL_SW, wmix + (size_t)g * 128 * 128, false);
                for (int tile = jj; tile < 256; tile += 32) { const int row0 = (tile >> 5) * SEQ + (tile & 31) * 64, pos0 = (tile & 31) * 64;
                    if (g == 0) pool_tile<0>(lds, PROJ, MIX, pscale, nullptr, row0, pos0, false, 0);
                    else if (g == 1) pool_tile<1>(lds, PROJ, MIX, pscale + 128, nullptr, row0, pos0, false, 0);
                    else if (g == 2) pool_tile<2>(lds, PROJ, MIX, pscale + 256, nullptr, row0, pos0, false, 0);
                    else pool_tile<3>(lds, PROJ, MIX, pscale + 384, nullptr, row0, pos0, false, 0); }
            }
#endif
        }
#endif
#if PH & 32
        if (vcu >= 192) {
            const float* wsp = args.in[11] + (size_t)l * 4 * 128 * 128; const float* bsp = args.in[12] + l * 4 * 128;
            const int j = vcu - 192, g = j & 3, jj = j >> 2;
            mat128_to_lds(lds, SG_WT, SG_SW, wsp + (size_t)g * 128 * 128, true);
            for (int ch = jj; ch < 128; ch += 16) sg_chunk(lds, PROJ, MIX, bsp + g * 128, ch * 128, g);
        }
#endif
#if PH & 4096
        if (vcu >= 128 && vcu < 192) {
            const int c2 = vcu - 128;
#define BAR2() do { for (int qb_ = 0; qb_ < REP_BAR2; ++qb_) xcd_barrier(bar2); } while (0)
            if (c2 < 64) { pg8::Gemm g{MIX, (const bf16*)(wl + W_BR), MIXW, MIXW}; pg8::Order S; S.init(MS, D, MIXW, 64, c2, 3, MP / 256, 4);
                pg8::EpiBranch E{PROJ, HN, SLAB}; pg8::gemm_phase<pg8::EpiBranch>(lds, g, S, E); }
            BAR2();
            {   const int tid = opaque_tid();
                for (int idx = tid; idx < 16 * 256; idx += 512) { const int rr = c2 * 16 + (idx >> 8), c4 = (idx & 255) * 4;
                    f32x4 a = *(const f32x4*)(SLAB + (size_t)rr * D + c4);
#pragma unroll
                    for (int k = 1; k < 4; ++k) a = a + *(const f32x4*)(SLAB + ((size_t)k * MS + rr) * D + c4);
                    v2u o; o.x = pg8::cvt_pk_bf16(a.x, a.y); o.y = pg8::cvt_pk_bf16(a.z, a.w); *(v2u*)(HN + (size_t)(MP + rr) * D + c4) = o; } }
            BAR2();
            if (c2 < 64) { pg8::Gemm g{HN, (const bf16*)(wl + W_OUT), D, D}; pg8::Order S; S.init(MS, D, D, 64, c2, 1, MP / 256, 4);
                pg8::EpiSlab E{SLAB}; pg8::gemm_phase<pg8::EpiSlab>(lds, g, S, E); }
            BAR2();
            for (int half_ = 0; half_ < 2; ++half_)
            {   const int tid = opaque_tid(), lane = tid & 63, wave = __builtin_amdgcn_readfirstlane(tid >> 6), rr = c2 * 16 + half_ * 8 + wave;
                const float* bsrc = (l == 0 ? xs_in : H + (size_t)MP * D) + (size_t)rr * D; float* hrow = H + (size_t)(MP + rr) * D; const float* wn = args.in[17] + l * D;
                f32x4 v[4]; float ss = 0.f;
#pragma unroll
                for (int j = 0; j < 4; ++j) { const int c4 = 4 * lane + 256 * j; f32x4 a = *(const f32x4*)(bsrc + c4);
#pragma unroll
                    for (int k = 0; k < 4; ++k) a = a + *(const f32x4*)(SLAB + ((size_t)k * MS + rr) * D + c4);
                    v[j] = a; *(f32x4*)(hrow + c4) = a; ss += (a.x * a.x + a.y * a.y) + (a.z * a.z + a.w * a.w); }
                const float r = 1.0f / sqrtf(wave_sum(ss) * (1.0f / D) + EPS);
#pragma unroll
                for (int j = 0; j < 4; ++j) { const int c4 = 4 * lane + 256 * j; const f32x4 wv = *(const f32x4*)(wn + c4); const f32x4 y = v[j] * r * wv;
                    v2u o; o.x = pg8::cvt_pk_bf16(y.x, y.y); o.y = pg8::cvt_pk_bf16(y.z, y.w); *(v2u*)(HN + (size_t)(MP + rr) * D + c4) = o; } }
            BAR2();
            for (int q_ = 0; q_ < REP_CH4; ++q_)
            if (c2 < 64) { pg8::Gemm g{HN, (const bf16*)(wl + W_FF1), D, D}; pg8::Order S; S.init(MS, FF, D, 64, c2, 1, MP / 256);
                pg8::EpiRelu2 E{FFHS - (size_t)MP * FF}; pg8::gemm_phase<pg8::EpiRelu2>(lds, g, S, E); }
            BAR2();
            { pg8::Gemm g{FFHS - (size_t)MP * FF, (const bf16*)(wl + W_FF2), FF, FF}; pg8::Order S; S.init(MS, D, FF, 64, c2, 1, MP / 256, 4);
                pg8::EpiSlab E{SLAB}; pg8::gemm_phase<pg8::EpiSlab>(lds, g, S, E); }
            BAR2();
            {   const int tid = opaque_tid();
                for (int idx = tid; idx < 16 * 256; idx += 512) { const int rr = c2 * 16 + (idx >> 8), c4 = (idx & 255) * 4; float* hp_ = H + (size_t)(MP + rr) * D + c4;
                    f32x4 a = *(const f32x4*)hp_;
#pragma unroll
                    for (int k = 0; k < 4; ++k) a = a + *(const f32x4*)(SLAB + ((size_t)k * MS + rr) * D + c4);
                    *(f32x4*)hp_ = a; } }
#undef BAR2
        }
#endif
        GRID_BAR();
        }
#ifdef EXP_COPYGATES
        {   const int tid = opaque_tid();
            for (int row = vcu; row < M; row += G) for (int c = tid; c < 1024; c += 512) H[(size_t)row * D + c] = bf2f(PROJ[(size_t)row * NPJ + C_G + c]);
        }
        GRID_BAR();
#endif
        for (int rep_ = 0; rep_ < REP_BRANCH; ++rep_) {
#if PH & 64
        {
#ifdef EXP_PLAIN_BRANCH
            pg8::Gemm g{MIX, (const bf16*)(wl + W_BR), MIXW, MIXW}; pg8::Order S; S.init(M, D, MIXW, G, bx, 3);
            pg8::EpiPlain E{HN};
            pg8::gemm_phase<pg8::EpiPlain>(lds, g, S, E);
#else
            pg8::Gemm g{MIX, (const bf16*)(wl + W_BR), MIXW, MIXW}; pg8::Order S; S.init(MROWS, D, MIXW, G, bx, 3);
            pg8::EpiBranch E{PROJ, HN, nullptr};
            pg8::gemm_phase<pg8::EpiBranch>(lds, g, S, E);
#endif
        }
#endif
        GRID_BAR();
        }
#if PH & 128
        {
            pg8::Gemm g{HN, (const bf16*)(wl + W_OUT), D, D}; pg8::Order S; S.init(MROWS, D, D, G, bx, 1);
            pg8::EpiResid E{l == 0 ? xp_in : H, l == 0 ? xs_in : H + (size_t)MP * D, H};
            pg8::gemm_phase<pg8::EpiResid>(lds, g, S, E);
        }
#endif
        GRID_BAR();
        for (int rep_ = 0; rep_ < REP_NORM2; ++rep_) {
#if PH & 256
        norm_phase<0>(lds, vcu, G, H, H + (size_t)MP * D, args.in[17] + l * D, HN, nullptr, nullptr, nullptr, nullptr, nullptr, 0, MROWS);
#endif
        GRID_BAR();
        }
        for (int rep_ = 0; rep_ < REP_FFN1; ++rep_) {
#if PH & 512
        {
            pg8::Gemm g{HN, (const bf16*)(wl + W_FF1), D, D}; pg8::Order S; S.init(MROWS, FF, D, G, bx, 1);
            pg8::EpiRelu2 E{FFH};
            pg8::gemm_phase<pg8::EpiRelu2>(lds, g, S, E);
        }
#endif
        GRID_BAR();
        }
#if PH & 1024
        {
            pg8::Gemm g{FFH, (const bf16*)(wl + W_FF2), FF, FF}; pg8::Order S; S.init(MROWS, D, FF, G, bx, 1);
            pg8::EpiResid E{H, H + (size_t)MP * D, H};
            pg8::gemm_phase<pg8::EpiResid>(lds, g, S, E);
        }
#endif
        GRID_BAR();
    }
#if PH & 2048
    norm_phase<2>(lds, vcu, G, H, H + (size_t)MP * D, args.in[20], nullptr, nullptr, H, nullptr, nullptr, nullptr);
#endif
}

extern "C" void kernel_launch(void* const* d_in, const int* in_sizes, int n_in, void* d_out, int out_size, void* d_ws, size_t ws_size, hipStream_t stream) {
    static int grid = 0;
    if (grid == 0) {
        if (n_in != 21 || in_sizes[0] != MP * D || (size_t)out_size != O_END || ws_size < WS_END) {
            fprintf(stderr, "kernel_launch: unexpected shapes: n_in %d in0 %d out %d ws %zu (need %zu)\n", n_in, n_in > 0 ? in_sizes[0] : -1, out_size, ws_size, (size_t)WS_END); grid = -1; return; }
        int dev = 0, cus = 0, per_cu = 0;
        if (hipGetDevice(&dev) != hipSuccess || hipDeviceGetAttribute(&cus, hipDeviceAttributeMultiprocessorCount, dev) != hipSuccess) { grid = -1; return; }
        if (hipFuncSetAttribute((const void*)hybrid_fwd, hipFuncAttributeMaxDynamicSharedMemorySize, LDS_BYTES) != hipSuccess) { fprintf(stderr, "kernel_launch: hipFuncSetAttribute failed\n"); grid = -1; return; }
        if (hipOccupancyMaxActiveBlocksPerMultiprocessor(&per_cu, (const void*)hybrid_fwd, NWAVES * 64, LDS_BYTES) != hipSuccess || per_cu < 1) {
            fprintf(stderr, "kernel_launch: occupancy query reports %d blocks per CU\n", per_cu); (void)hipGetLastError(); grid = -1; return; }
        grid = cus;
    }
    if (grid < 0) return;
    if (hipMemsetAsync((char*)d_ws + WS_CTL, 0, CTL_ZERO_BYTES, stream) != hipSuccess) { fprintf(stderr, "kernel_launch: memset failed\n"); return; }
    Args a{};
    for (int i = 0; i < 21; ++i) a.in[i] = (const float*)d_in[i];
    a.out = (float*)d_out; a.ws = (unsigned char*)d_ws;
    void* kargs[] = {&a};
    hipError_t e = hipLaunchCooperativeKernel((const void*)hybrid_fwd, dim3(grid), dim3(NWAVES * 64), kargs, LDS_BYTES, stream);
    if (e != hipSuccess) fprintf(stderr, "kernel_launch: cooperative launch failed: %s (grid %d)\n", hipGetErrorString(e), grid);
}
```

```cpp
#include <hip/hip_runtime.h>
#include <hip/hip_cooperative_groups.h>
#include <cstdio>
#include <cstdint>
#ifndef REP_BAR2
#define REP_BAR2 1
#endif
#ifndef REP_CONV
#define REP_CONV 1
#endif
#ifndef REP_N1
#define REP_N1 1
#endif
#ifndef REP_PL2
#define REP_PL2 1
#endif
#ifndef REP_P1
#define REP_P1 1
#endif
#ifndef REP_GS
#define REP_GS 1
#endif
#ifndef REP_PL
#define REP_PL 1
#endif
#ifndef REP_SG
#define REP_SG 1
#endif
#ifndef REP_SS
#define REP_SS 1
#endif
#ifndef REP_P2
#define REP_P2 1
#endif
#ifndef REP_CH1
#define REP_CH1 1
#endif
#ifndef REP_CH4
#define REP_CH4 1
#endif
#ifndef REP_ATT
#define REP_ATT 1
#endif
#ifndef REP_OMM
#define REP_OMM 1
#endif
#ifndef REP_EPI
#define REP_EPI 1
#endif
#ifndef REP_GLAP
#define REP_GLAP 1
#endif
#ifndef REP_LIGHT
#define REP_LIGHT 1
#endif
#ifndef REP_PROJ
#define REP_PROJ 1
#endif
#ifndef REP_MIX
#define REP_MIX 1
#endif
#ifndef REP_BRANCH
#define REP_BRANCH 1
#endif
#ifndef REP_NORM2
#define REP_NORM2 1
#endif
#ifndef REP_FFN1
#define REP_FFN1 1
#endif

constexpr int D = 1024, NB = 8, SEQ = 2048, DEPTH = 2, SB = 128, ST = 8;
constexpr int MP = NB * SEQ;
constexpr int MS = SB * ST;
constexpr int M = MP + MS;
constexpr int IN_COLS = 7696;
constexpr int NPJ = 7680;
constexpr int FF = 4096;
constexpr float EPS = 1e-6f;
constexpr int C_Q = 0, C_K = 512, C_V = 1024, C_GO = 2048, C_XP = 3072, C_U = 3584, C_VV = 4096, C_G = 4608;
constexpr int MIXW = 2048;

constexpr size_t MiB = 1u << 20;
constexpr size_t WS_CTL = 0, CTL_ZERO_BYTES = 1 * MiB;
constexpr size_t WS_W = 2 * MiB;
constexpr size_t W_LAYER = 37 * MiB, W_IN = 0, W_BR = 15 * MiB, W_OUT = 19 * MiB, W_FF1 = 21 * MiB, W_FF2 = 29 * MiB;
constexpr size_t WS_HN = 76 * MiB;
constexpr size_t WS_GLOG = 110 * MiB;
constexpr size_t WS_MIX = 144 * MiB;
constexpr size_t WS_PROJ = 212 * MiB;
constexpr size_t WS_FFHS = 468 * MiB;
constexpr size_t WS_SLAB = 476 * MiB;
constexpr size_t WS_END = 508 * MiB;
static_assert(WS_PROJ + (size_t)M * NPJ * 2 <= WS_FFHS, "ws map");
static_assert(WS_MIX + (size_t)M * MIXW * 2 <= WS_PROJ, "ws map");
static_assert(WS_GLOG + (size_t)M * 512 * 4 <= WS_MIX, "ws map");
static_assert(WS_HN + (size_t)M * D * 2 <= WS_GLOG, "ws map");
static_assert(WS_W + 2 * W_LAYER <= WS_HN, "ws map");
constexpr int CW_BAR = 4096, CW_BAR2 = 8192;

constexpr size_t O_Y = 0;
constexpr size_t O_GLAP = (size_t)M * D;
constexpr size_t O_GLAS = O_GLAP + (size_t)DEPTH * NB * 4 * 128 * 256;
constexpr size_t O_POOLP = O_GLAS + (size_t)DEPTH * SB * 4 * 128 * 256;
constexpr size_t O_POOLS = O_POOLP + (size_t)DEPTH * NB * 15 * 512;
constexpr size_t O_SGV = O_POOLS + (size_t)DEPTH * SB * 15 * 512;
constexpr size_t O_END = O_SGV + (size_t)DEPTH * SB * ST * 512;
static_assert(O_END == 56614912, "output size");

constexpr int RING_BYTES = 131072;
constexpr int LDSCTL_OFF = RING_BYTES, MISC_OFF = LDSCTL_OFF + 320;
constexpr int LDS_BYTES = 147456;
constexpr int NWAVES = 8;

#define GAS __attribute__((address_space(1)))
#define LAS __attribute__((address_space(3)))
typedef unsigned short bf16;
typedef unsigned v4u __attribute__((ext_vector_type(4)));
typedef unsigned v2u __attribute__((ext_vector_type(2)));
typedef float f32x4 __attribute__((ext_vector_type(4)));
typedef short bf16x8 __attribute__((ext_vector_type(8)));
typedef GAS unsigned gu32;
#define RLX_AGENT __ATOMIC_RELAXED, __HIP_MEMORY_SCOPE_AGENT
#define LDS_WAIT() asm volatile("s_waitcnt lgkmcnt(0)" ::: "memory")
#define LDS_BARRIER() do { asm volatile("s_waitcnt lgkmcnt(0)" ::: "memory"); __builtin_amdgcn_s_barrier(); asm volatile("" ::: "memory"); } while (0)

__device__ __forceinline__ unsigned f2bf(float f) { unsigned u = __builtin_bit_cast(unsigned, f); return (u + 0x7fffu + ((u >> 16) & 1u)) >> 16; }
__device__ __forceinline__ unsigned pk2(float lo, float hi) { return f2bf(lo) | (f2bf(hi) << 16); }
__device__ __forceinline__ float bf2f(unsigned short x) { return __builtin_bit_cast(float, (unsigned)x << 16); }
__device__ __forceinline__ float bflo(unsigned w) { return __builtin_bit_cast(float, w << 16); }
__device__ __forceinline__ float bfhi(unsigned w) { return __builtin_bit_cast(float, w & 0xffff0000u); }
__device__ __forceinline__ float sigmoid_f(float x) { return __builtin_amdgcn_rcpf(1.0f + __builtin_amdgcn_exp2f(-1.4426950409f * x)); }
__device__ __forceinline__ float gelu_tanh(float x) { const float z = 1.5957691216f * x * (1.0f + 0.044715f * x * x); return x * sigmoid_f(z); }
__device__ __forceinline__ int opaque_tid() { int t = threadIdx.x; asm volatile("" : "+v"(t)); return t; }
template <int CTRL> __device__ __forceinline__ float dpp_f(float v) { return __builtin_bit_cast(float, __builtin_amdgcn_update_dpp(0, __builtin_bit_cast(int, v), CTRL, 0xf, 0xf, false)); }
__device__ __forceinline__ float wave_sum(float v) {
    v += dpp_f<0xB1>(v);
    v += dpp_f<0x4E>(v);
    v += dpp_f<0x141>(v);
    v += dpp_f<0x140>(v);
    const int iv = __builtin_bit_cast(int, v);
    return (__builtin_bit_cast(float, __builtin_amdgcn_readlane(iv, 0)) + __builtin_bit_cast(float, __builtin_amdgcn_readlane(iv, 16)))
         + (__builtin_bit_cast(float, __builtin_amdgcn_readlane(iv, 32)) + __builtin_bit_cast(float, __builtin_amdgcn_readlane(iv, 48)));
}

namespace pg8 {
#define PG8_LAS __attribute__((address_space(3)))
typedef unsigned short bf16_t;
typedef unsigned u32x4 __attribute__((ext_vector_type(4)));
constexpr int BM = 256, BK = 64, HALF = 128, HTB = HALF * BK * 2, STAGE_BYTES = 8 * HTB, NXCD = 8, WGM = 8;

__host__ __device__ __forceinline__ int lds_byte(int r, int c) { const int st = (r >> 4) * 2 + (c >> 5), rr = r & 15, cc = c & 31, ob = rr * 64 + cc * 2; return st * 1024 + (ob ^ (((ob >> 9) & 1) << 5)); }
__host__ __device__ __forceinline__ void stage_rc(int b, int& R, int& C) { const int st = b / 1024, sb = b % 1024, swz = sb ^ (((sb >> 9) & 1) << 5); R = (st >> 1) * 16 + swz / 64; C = (st & 1) * 32 + (swz % 64) / 2; }
__host__ __device__ __forceinline__ int perm32(int rho) { const int n = rho >> 4, i = rho & 15; return 8 * (i >> 2) + 4 * n + (i & 3); }

struct Unit { int pm, pn, k0, nt, sub, keep, ks; };
struct Gemm { const bf16_t* A; const bf16_t* Bt; int lda, ldb; };

struct Order {
    int nM, nN, nwg, G, c, nsub, ntk, pm_off, ksplit;
    __device__ void init(int M_, int N_, int K_, int G_, int c_, int nsub_, int pm_off_ = 0, int ksplit_ = 1) { nM = M_ / BM; nN = N_ / BM; nwg = nM * nN; G = G_; c = c_; nsub = nsub_; ntk = K_ / BK; pm_off = pm_off_; ksplit = ksplit_; }
    __device__ bool next(int i, Unit& u) const {
        const int ti = i / nsub, sub = i - ti * nsub;
        long L = (long)ti * G + c; if (L >= (long)nwg * ksplit) return false;
        const int ksr = (int)(L % ksplit); L /= ksplit;
        int wgid = (int)L; { const int q = nwg / NXCD, r = nwg % NXCD, xcd = wgid % NXCD, off = wgid / NXCD; wgid = (xcd < r ? xcd * (q + 1) : r * (q + 1) + (xcd - r) * q) + off; }
        const int nig = WGM * nN, gid = wgid / nig, fm = gid * WGM, gsz = (nM - fm) < WGM ? (nM - fm) : WGM;
        u.pm = pm_off + fm + ((wgid % nig) % gsz); u.pn = (wgid % nig) / gsz; u.sub = sub; u.ks = ksr;
        if (nsub == 1) { u.nt = ntk / ksplit; u.k0 = ksr * u.nt * BK; u.keep = 0; }
        else { const int len = (sub == 0 ? 1024 : 512) / ksplit; u.k0 = (sub == 0 ? 0 : (sub == 1 ? 1024 : 1536)) + ksr * len; u.nt = len / BK; u.keep = sub < 2 ? 1 : 0; }
        return true;
    }
};

typedef __bf16 bf16x2_t __attribute__((ext_vector_type(2)));
typedef float f32x2_t __attribute__((ext_vector_type(2)));
__device__ __forceinline__ unsigned cvt_pk_bf16(float lo, float hi) { const f32x2_t v = {lo, hi}; const bf16x2_t b = __builtin_convertvector(v, bf16x2_t); return __builtin_bit_cast(unsigned, b); }

typedef f32x4 acc_t[2][2][4][2];

template <int ACT> __device__ __forceinline__ float act_f(float x) {
    if (ACT == 1) return x * 0.08838834764831845f;
    if (ACT == 2) return gelu_tanh(x);
    if (ACT == 3) return sigmoid_f(x);
    if (ACT == 4) { const float r = x > 0.f ? x : 0.f; return r * r; }
    return x;
}
template <int ACT> __device__ __forceinline__ void store_bf16_tile(const acc_t& acc, bf16_t* O, int ldc, int row0, int col0, float* sgv  , int sgcol0) {
#pragma unroll
    for (int ai = 0; ai < 2; ++ai)
#pragma unroll
        for (int m = 0; m < 4; ++m) { const int row = row0 + ai * HALF + m * 16; bf16_t* rowp = O + (size_t)row * ldc + col0;
#pragma unroll
            for (int bj = 0; bj < 2; ++bj) { f32x4 v0 = acc[ai][bj][m][0], v1 = acc[ai][bj][m][1];
#pragma unroll
                for (int j = 0; j < 4; ++j) { v0[j] = act_f<ACT>(v0[j]); v1[j] = act_f<ACT>(v1[j]); }
                u32x4 w; w.x = cvt_pk_bf16(v0[0], v0[1]); w.y = cvt_pk_bf16(v0[2], v0[3]); w.z = cvt_pk_bf16(v1[0], v1[1]); w.w = cvt_pk_bf16(v1[2], v1[3]);
                *(u32x4*)(rowp + bj * HALF) = w;
                if (ACT == 2 && sgv) { float* sp = sgv + (size_t)(row - MP) * 512 + sgcol0 + bj * HALF; *(f32x4*)sp = v0; *(f32x4*)(sp + 4) = v1; }
                if (ACT == 3 && sgv) { float* sp = sgv + (size_t)row * D + sgcol0 + bj * HALF; *(f32x4*)sp = v0; *(f32x4*)(sp + 4) = v1; } } }
}

struct EpiProj {
    static constexpr bool PERM = true;
    bf16_t* O; float* sgv; float* dbg;
    __device__ __forceinline__ void operator()(acc_t& acc, const Unit& u, int wr, int wc, int fr, int fq) const {
        const int row0 = u.pm * BM + wr * 64 + fr, col0 = u.pn * BM + wc * 32 + 8 * fq, pn = u.pn;
        if (pn < 2) store_bf16_tile<1>(acc, O, NPJ, row0, col0, nullptr, 0);
        else if (pn < 14) store_bf16_tile<0>(acc, O, NPJ, row0, col0, nullptr, 0);
        else if (pn < 18) store_bf16_tile<2>(acc, O, NPJ, row0, col0, (pn >= 16 && u.pm >= MP / BM) ? sgv : nullptr, col0 - C_VV);
#ifdef EXP_GATEOUT
        else store_bf16_tile<3>(acc, O, NPJ, row0, col0, (pn >= 26) ? dbg : nullptr, col0 - C_G - 2048);
#else
        else store_bf16_tile<3>(acc, O, NPJ, row0, col0, nullptr, 0);
#endif
    }
};
struct EpiPlain {
    static constexpr bool PERM = true;
    bf16_t* O;
    __device__ __forceinline__ void operator()(acc_t& acc, const Unit& u, int wr, int wc, int fr, int fq) const {
        if (u.keep) return;
        store_bf16_tile<0>(acc, O, D, u.pm * BM + wr * 64 + fr, u.pn * BM + wc * 32 + 8 * fq, nullptr, 0);
    }
};
struct EpiRelu2 {
    static constexpr bool PERM = true;
    bf16_t* O;
    __device__ __forceinline__ void operator()(acc_t& acc, const Unit& u, int wr, int wc, int fr, int fq) const {
        store_bf16_tile<4>(acc, O, FF, u.pm * BM + wr * 64 + fr, u.pn * BM + wc * 32 + 8 * fq, nullptr, 0);
    }
};
struct EpiBranch {
    static constexpr bool PERM = true;
    const bf16_t* P; bf16_t* O; float* slab;
    __device__ __forceinline__ void operator()(acc_t& acc, const Unit& u, int wr, int wc, int fr, int fq) const {
        const int row0 = u.pm * BM + wr * 64 + fr, col0 = u.pn * BM + wc * 32 + 8 * fq, sub = u.sub;
        const bool two = sub < 2;
        u32x4 ga[2], gb[2];
        { const bf16_t* gp = P + (size_t)row0 * NPJ + C_G + col0 + sub * 1024;
          ga[0] = *(const u32x4*)gp; ga[1] = *(const u32x4*)(gp + HALF);
          if (two) { gb[0] = *(const u32x4*)(gp + 1024); gb[1] = *(const u32x4*)(gp + 1024 + HALF); } else { gb[0] = ga[0]; gb[1] = ga[1]; } }
#pragma unroll
        for (int it = 0; it < 8; ++it) { const int ai = it >> 2, m = it & 3, row = row0 + ai * HALF + m * 16;
            u32x4 na[2], nb[2];
            if (it < 7) { const int nrow = row0 + ((it + 1) >> 2) * HALF + ((it + 1) & 3) * 16; const bf16_t* gp = P + (size_t)nrow * NPJ + C_G + col0 + sub * 1024;
                na[0] = *(const u32x4*)gp; na[1] = *(const u32x4*)(gp + HALF);
                if (two) { nb[0] = *(const u32x4*)(gp + 1024); nb[1] = *(const u32x4*)(gp + 1024 + HALF); } else { nb[0] = na[0]; nb[1] = na[1]; } }
            else { na[0] = ga[0]; na[1] = ga[1]; nb[0] = gb[0]; nb[1] = gb[1]; }
#pragma unroll
            for (int bj = 0; bj < 2; ++bj) {
                const u32x4 g1 = ga[bj], g2 = gb[bj];
                float f[8];
                f[0] = bflo(g1.x); f[1] = bfhi(g1.x); f[2] = bflo(g1.y); f[3] = bfhi(g1.y); f[4] = bflo(g1.z); f[5] = bfhi(g1.z); f[6] = bflo(g1.w); f[7] = bfhi(g1.w);
#pragma unroll
                for (int j = 0; j < 8; ++j) f[j] = f[j] > 1e-30f ? f[j] : 1e-30f;
                if (two) {
                    float d[8];
                    d[0] = bflo(g2.x); d[1] = bfhi(g2.x); d[2] = bflo(g2.y); d[3] = bfhi(g2.y); d[4] = bflo(g2.z); d[5] = bfhi(g2.z); d[6] = bflo(g2.w); d[7] = bfhi(g2.w);
#pragma unroll
                    for (int j = 0; j < 8; ++j) { d[j] = d[j] > 1e-30f ? d[j] : 1e-30f; f[j] = f[j] * __builtin_amdgcn_rcpf(d[j]); }
                }
                f32x4 v0 = acc[ai][bj][m][0], v1 = acc[ai][bj][m][1];
#pragma unroll
                for (int j = 0; j < 4; ++j) { v0[j] *= f[j]; v1[j] *= f[4 + j]; }
                acc[ai][bj][m][0] = v0; acc[ai][bj][m][1] = v1;
                if (sub == 2) {
                    if (slab) { float* sp = slab + ((size_t)u.ks * MS + (row - MP)) * D + col0 + bj * HALF; *(f32x4*)sp = v0; *(f32x4*)(sp + 4) = v1; }
                    else { u32x4 w; w.x = cvt_pk_bf16(v0[0], v0[1]); w.y = cvt_pk_bf16(v0[2], v0[3]); w.z = cvt_pk_bf16(v1[0], v1[1]); w.w = cvt_pk_bf16(v1[2], v1[3]);
                        *(u32x4*)(O + (size_t)row * D + col0 + bj * HALF) = w; } }
            }
            ga[0] = na[0]; ga[1] = na[1]; gb[0] = nb[0]; gb[1] = nb[1];
            asm volatile("" ::: "memory");
        }
    }
};
struct EpiResid {
    static constexpr bool PERM = false;
    const float* bp; const float* bs; float* out;
    __device__ __forceinline__ void operator()(acc_t& acc, const Unit& u, int wr, int wc, int fr, int fq) const {
        const int row0 = u.pm * BM + wr * 64 + fr, col0 = u.pn * BM + wc * 32 + 4 * fq;
        const bool smp = u.pm >= MP / BM;
#pragma unroll
        for (int ai = 0; ai < 2; ++ai)
#pragma unroll
            for (int m = 0; m < 4; ++m) { const int row = row0 + ai * HALF + m * 16;
                const float* b = smp ? bs + (size_t)(row - MP) * D + col0 : bp + (size_t)row * D + col0; float* o = out + (size_t)row * D + col0;
#pragma unroll
                for (int bj = 0; bj < 2; ++bj)
#pragma unroll
                    for (int n = 0; n < 2; ++n) { const f32x4 bv = *(const f32x4*)(b + bj * HALF + n * 16); *(f32x4*)(o + bj * HALF + n * 16) = bv + acc[ai][bj][m][n]; }
                if (m == 3) asm volatile("" ::: "memory"); }
    }
};

struct EpiSlab {
    static constexpr bool PERM = false;
    float* slab;
    __device__ __forceinline__ void operator()(acc_t& acc, const Unit& u, int wr, int wc, int fr, int fq) const {
        const int row0 = u.pm * BM + wr * 64 + fr - MP, col0 = u.pn * BM + wc * 32 + 4 * fq;
        float* base = slab + (size_t)u.ks * MS * D;
#pragma unroll
        for (int ai = 0; ai < 2; ++ai)
#pragma unroll
            for (int m = 0; m < 4; ++m) { float* o = base + (size_t)(row0 + ai * HALF + m * 16) * D + col0;
#pragma unroll
                for (int bj = 0; bj < 2; ++bj)
#pragma unroll
                    for (int n = 0; n < 2; ++n) *(f32x4*)(o + bj * HALF + n * 16) = acc[ai][bj][m][n]; }
    }
};

template <class Epi>
__device__ __forceinline__ void gemm_phase(PG8_LAS unsigned char* lds, const Gemm g, const Order& S, const Epi& E) {
    int tid_ = threadIdx.x; asm volatile("" : "+v"(tid_));
    const int tid = tid_, wid = __builtin_amdgcn_readfirstlane(tid >> 6), lane = tid & 63, wr = wid >> 2, wc = wid & 3, fr = lane & 15, fq = lane >> 4;
    unsigned voffA[2], voffB[2];
#pragma unroll
    for (int i = 0; i < 2; ++i) { int R, C; stage_rc(tid * 16 + i * 8192, R, C); const int Rb = Epi::PERM ? ((R & ~31) + perm32(R & 31)) : R;
        voffA[i] = (unsigned)(R * g.lda + C) * 2u; voffB[i] = (unsigned)(Rb * g.ldb + C) * 2u; }
    const size_t kstep = (size_t)(BK * 2);
    const size_t hstepA = (size_t)HALF * g.lda * 2, hstepB = (size_t)HALF * g.ldb * 2;
    const size_t tstepA = 2 * hstepA, tstepB = 2 * hstepB;
    const unsigned ldsw = (unsigned)wid * 1024u;
    const int aoff = lds_byte(wr * 64 + fr, fq * 8), boff = lds_byte(wc * 32 + fr, fq * 8);
#define PG8_SA(b, h) (((b) * 2 + (h)) * HTB)
#define PG8_SB(b, h) ((4 + (b) * 2 + (h)) * HTB)
#define PG8_STAGE(bufoff, gbase, voff) do { _Pragma("unroll") for (int _i = 0; _i < 2; ++_i) \
        __builtin_amdgcn_global_load_lds((const unsigned*)((const char*)(gbase) + (voff)[_i]), (PG8_LAS unsigned*)(lds + (bufoff) + ldsw + _i * 8192), 16, 0, 0); } while (0)
#define PG8_LDA(dst, b, h) do { _Pragma("unroll") for (int m = 0; m < 4; ++m) _Pragma("unroll") for (int k = 0; k < 2; ++k) dst[m][k] = *(const PG8_LAS bf16x8*)(lds + PG8_SA(b, h) + aoff + m * 2048 + k * 1024); } while (0)
#define PG8_LDB(dst, b, h) do { _Pragma("unroll") for (int n = 0; n < 2; ++n) _Pragma("unroll") for (int k = 0; k < 2; ++k) dst[n][k] = *(const PG8_LAS bf16x8*)(lds + PG8_SB(b, h) + boff + n * 2048 + k * 1024); } while (0)
#define PG8_MMA(ai, bj, At, Bt) do { __builtin_amdgcn_s_setprio(1); _Pragma("unroll") for (int m = 0; m < 4; ++m) _Pragma("unroll") for (int n = 0; n < 2; ++n) _Pragma("unroll") for (int k = 0; k < 2; ++k) \
        acc[ai][bj][m][n] = __builtin_amdgcn_mfma_f32_16x16x32_bf16(Bt[n][k], At[m][k], acc[ai][bj][m][n], 0, 0, 0); __builtin_amdgcn_s_setprio(0); } while (0)
#define PG8_WAIT_V(n) asm volatile("s_waitcnt vmcnt(" #n ")" ::: "memory")
#define PG8_WAIT_L(n) asm volatile("s_waitcnt lgkmcnt(" #n ")" ::: "memory")
#define PG8_BAR __builtin_amdgcn_s_barrier()
#define PG8_SCHED __builtin_amdgcn_sched_barrier(0)
    Unit cur, nxt; int ui = 0;
    if (!S.next(0, cur)) return;
    f32x4 acc[2][2][4][2];
#pragma unroll
    for (int a = 0; a < 2; ++a)
#pragma unroll
        for (int b = 0; b < 2; ++b)
#pragma unroll
            for (int m = 0; m < 4; ++m)
#pragma unroll
                for (int n = 0; n < 2; ++n) acc[a][b][m][n] = (f32x4){0.f, 0.f, 0.f, 0.f};
    bf16x8 At[4][2], B0[2][2], B1[2][2];
    const char* cA = (const char*)g.A + (size_t)cur.pm * tstepA + (size_t)cur.k0 * 2; const char* cB = (const char*)g.Bt + (size_t)cur.pn * tstepB + (size_t)cur.k0 * 2;
    PG8_STAGE(PG8_SB(0, 0), cB, voffB); PG8_STAGE(PG8_SB(0, 1), cB + hstepB, voffB); PG8_STAGE(PG8_SA(0, 0), cA, voffA); PG8_STAGE(PG8_SA(0, 1), cA + hstepA, voffA);
    if (wr == 1) PG8_BAR;
    PG8_WAIT_V(2); PG8_BAR;
    PG8_STAGE(PG8_SB(1, 0), cB + kstep, voffB); PG8_STAGE(PG8_SA(1, 0), cA + kstep, voffA); PG8_STAGE(PG8_SB(1, 1), cB + hstepB + kstep, voffB);
    PG8_WAIT_V(6); PG8_BAR;
    for (;;) {
        const bool has_next = S.next(ui + 1, nxt);
        const char* nA = has_next ? (const char*)g.A + (size_t)nxt.pm * tstepA + (size_t)nxt.k0 * 2 : cA; const char* nB = has_next ? (const char*)g.Bt + (size_t)nxt.pn * tstepB + (size_t)nxt.k0 * 2 : cB;
        const int nt = cur.nt;
        for (int t = 0; t < nt; t += 2) {
            const bool last = (t == nt - 2);
            const char* a1 = cA + (size_t)(t + 1) * kstep;
            const char* a2 = last ? nA : cA + (size_t)(t + 2) * kstep; const char* b2 = last ? nB : cB + (size_t)(t + 2) * kstep;
            const char* a3 = a2 + kstep; const char* b3 = b2 + kstep;
            PG8_LDB(B0, 0, 0); PG8_LDB(B1, 0, 1); PG8_SCHED; PG8_LDA(At, 0, 0); PG8_STAGE(PG8_SA(1, 1), a1 + hstepA, voffA);
            PG8_WAIT_V(8); PG8_WAIT_L(0); PG8_BAR; PG8_MMA(0, 0, At, B0); PG8_MMA(0, 1, At, B1); PG8_BAR; PG8_SCHED;
            PG8_LDA(At, 0, 1); PG8_STAGE(PG8_SB(0, 0), b2, voffB); PG8_STAGE(PG8_SB(0, 1), b2 + hstepB, voffB); PG8_STAGE(PG8_SA(0, 0), a2, voffA);
            PG8_WAIT_V(8); PG8_WAIT_L(0); PG8_BAR; PG8_MMA(1, 0, At, B0); PG8_MMA(1, 1, At, B1); PG8_BAR; PG8_SCHED;
            PG8_LDB(B0, 1, 0); PG8_LDB(B1, 1, 1); PG8_SCHED; PG8_LDA(At, 1, 0); PG8_STAGE(PG8_SA(0, 1), a2 + hstepA, voffA);
            PG8_WAIT_V(8); PG8_WAIT_L(0); PG8_BAR; PG8_MMA(0, 0, At, B0); PG8_MMA(0, 1, At, B1); PG8_BAR; PG8_SCHED;
            PG8_LDA(At, 1, 1); PG8_STAGE(PG8_SB(1, 0), b3, voffB); PG8_STAGE(PG8_SB(1, 1), b3 + hstepB, voffB); PG8_STAGE(PG8_SA(1, 0), a3, voffA);
            PG8_WAIT_V(8); PG8_WAIT_L(0); PG8_BAR; PG8_MMA(1, 0, At, B0); PG8_MMA(1, 1, At, B1); PG8_BAR; PG8_SCHED;
        }
        if (wr == 0) PG8_BAR;
        E(acc, cur, wr, wc, fr, fq);
        if (!has_next) break;
        if (!cur.keep) {
#pragma unroll
            for (int a = 0; a < 2; ++a)
#pragma unroll
                for (int b = 0; b < 2; ++b)
#pragma unroll
                    for (int m = 0; m < 4; ++m)
#pragma unroll
                        for (int n = 0; n < 2; ++n) acc[a][b][m][n] = (f32x4){0.f, 0.f, 0.f, 0.f};
        }
        cur = nxt; cA = nA; cB = nB; ++ui;
        if (wr == 1) PG8_BAR;
    }
    PG8_WAIT_V(0);
    PG8_BAR;
#undef PG8_SA
#undef PG8_SB
#undef PG8_STAGE
#undef PG8_LDA
#undef PG8_LDB
#undef PG8_MMA
#undef PG8_WAIT_V
#undef PG8_WAIT_L
#undef PG8_BAR
#undef PG8_SCHED
}
}

#define XB_TMO      128
#define XB_XCNT(j)  (256  + 64 * (j))
#define XB_XSUB(j)  (1280 + 64 * (j))
#define XB_XGEN(j)  (2304 + 64 * (j))
#define XB_TOP      3328
#define XB_TOPGEN   3392
#define XCD_BAR_WORDS 3456
#define XB_SPIN_CAP (1u << 20)

__device__ __forceinline__ unsigned xb_ld(unsigned* p)              { return __hip_atomic_load(p, __ATOMIC_RELAXED, __HIP_MEMORY_SCOPE_AGENT); }
__device__ __forceinline__ unsigned xb_add(unsigned* p, unsigned v) { return __hip_atomic_fetch_add(p, v, __ATOMIC_RELAXED, __HIP_MEMORY_SCOPE_AGENT); }
__device__ __forceinline__ unsigned xb_xcc_id() { return (unsigned)__builtin_amdgcn_s_getreg((3 << 11) | 20) & 0xFu; }
#define XB_SPIN(cond, bar) do { unsigned _sp = 0; while (cond) { __builtin_amdgcn_s_sleep(1); \
    if ((++_sp & 255u) == 0u) { if (xb_ld(&(bar)[XB_TMO])) break; if (_sp > XB_SPIN_CAP) { atomicAdd(&(bar)[XB_TMO], 1u); break; } } } } while (0)

struct XcdBarrier { unsigned* bar; unsigned x; volatile LAS unsigned* st; unsigned np; };

__device__ __forceinline__ XcdBarrier xcd_barrier_post(unsigned* bar, volatile LAS unsigned* st, unsigned np, bool member) {
    XcdBarrier b; b.bar = bar; b.x = 0; b.st = st; b.np = np;
    if (member && threadIdx.x == 0) (void)xb_add(&bar[XB_XCNT(xb_xcc_id())], 1u);
    return b;
}
__device__ __forceinline__ void xcd_barrier_complete(unsigned* bar, unsigned x, unsigned G, unsigned& nloc, unsigned& nx) {
    unsigned sum, cnt, mine, sp = 0u;
    for (;;) {
        sum = 0u; cnt = 0u; mine = 0u;
#pragma unroll
        for (unsigned j = 0; j < 16; ++j) { const unsigned c = xb_ld(&bar[XB_XCNT(j)]); sum += c; cnt += (c > 0u) ? 1u : 0u; mine = (j == x) ? c : mine; }
        if (sum == G) break;
        __builtin_amdgcn_s_sleep(1);
        if ((++sp & 255u) == 0u) { if (xb_ld(&bar[XB_TMO])) break; if (sp > XB_SPIN_CAP) { atomicAdd(&bar[XB_TMO], 1u); break; } }
    }
    nloc = mine > 0u ? mine : 1u; nx = cnt > 0u ? cnt : 1u;
}
__device__ __forceinline__ void xcd_barrier(const XcdBarrier& b) {
    asm volatile("s_waitcnt vmcnt(0)" ::: "memory");
    __syncthreads();
    if (threadIdx.x == 0) {
        unsigned* bar = b.bar;
        unsigned xo = 0; asm volatile("s_mov_b32 %0, 0" : "=s"(xo));
        bar += xo;
        const unsigned bx_ = xb_xcc_id();
        __builtin_amdgcn_s_waitcnt(0);
        unsigned nloc = b.st[0], nx = b.st[1];
        if (nloc == 0u) { xcd_barrier_complete(bar, bx_, b.np, nloc, nx); b.st[0] = nloc; b.st[1] = nx; }
        const unsigned old = xb_add(&bar[XB_XSUB(bx_)], 1u);
        const unsigned gen = old / nloc;
        if (old + 1u == (gen + 1u) * nloc) {
            __builtin_amdgcn_fence(__ATOMIC_RELEASE, "agent");
            asm volatile("s_waitcnt vmcnt(0)" ::: "memory");
            const unsigned og = xb_add(&bar[XB_TOP], 1u);
            const unsigned tg = og / nx;
            if (og + 1u == (tg + 1u) * nx) xb_add(&bar[XB_TOPGEN], 1u);
            else XB_SPIN(xb_ld(&bar[XB_TOPGEN]) == tg, bar);
            __builtin_amdgcn_fence(__ATOMIC_ACQUIRE, "agent");
            xb_add(&bar[XB_XGEN(bx_)], 1u);
            asm volatile("s_waitcnt vmcnt(0)" ::: "memory");
        } else {
            XB_SPIN(xb_ld(&bar[XB_XGEN(bx_)]) == gen, bar);
            __builtin_amdgcn_fence(__ATOMIC_ACQUIRE, "agent");
            asm volatile("s_waitcnt vmcnt(0)" ::: "memory");
        }
    }
    __syncthreads();
}

struct Args {
    const float* in[21];
    float* out; unsigned char* ws;
};

__device__ __forceinline__ void transpose_item(const float* W, int ldw, int ncols, bf16* WT, int ldd, int row_off, int col_off, LAS float* scr, int item, int lane) {
    const int nblk = ncols / 32, kb = item / nblk, nb = item % nblk, k0 = 64 * kb, n0 = 32 * nb;
#pragma unroll 8
    for (int i = 0; i < 32; ++i) { const int kk = 2 * i + (lane >> 5); scr[kk * 33 + (lane & 31)] = W[(size_t)(k0 + kk) * ldw + n0 + (lane & 31)]; }
    LDS_WAIT(); asm volatile("" ::: "memory");
    const int c = lane & 7;
#pragma unroll
    for (int j = 0; j < 4; ++j) { const int n = (lane >> 3) + 8 * j; const LAS float* s = scr + (8 * c) * 33 + n;
        v4u o; o.x = pk2(s[0 * 33], s[1 * 33]); o.y = pk2(s[2 * 33], s[3 * 33]); o.z = pk2(s[4 * 33], s[5 * 33]); o.w = pk2(s[6 * 33], s[7 * 33]);
        *(GAS v4u*)(WT + (size_t)(row_off + n0 + n) * ldd + col_off + k0 + 8 * c) = o; }
    LDS_WAIT(); asm volatile("" ::: "memory");
}

__device__ __forceinline__ void convert_weights(const Args& a, LAS unsigned char* lds, int vcu, int G) {
    const int tid = opaque_tid(), lane = tid & 63, wave = __builtin_amdgcn_readfirstlane(tid >> 6), gw = vcu * NWAVES + wave, NGW = G * NWAVES;
    LAS float* scr = (LAS float*)(lds + wave * 16384);
    constexpr int I_IN1 = 16 * 96, I_IN2 = 16 * 144, I_BA = 16 * 32, I_BB = 8 * 32, I_BC = 8 * 32, I_O = 16 * 32, I_F1 = 16 * 128, I_F2 = 64 * 32;
    constexpr int PER_LAYER = I_IN1 + I_IN2 + I_BA + I_BB + I_BC + I_O + I_F1 + I_F2;
    for (int it = gw; it < 2 * PER_LAYER; it += NGW) {
        const int l = it / PER_LAYER; int r = it - l * PER_LAYER;
        unsigned char* wl = a.ws + WS_W + (size_t)l * W_LAYER;
        const float* w_in = a.in[5] + (size_t)l * D * IN_COLS;
        if (r < I_IN1) { transpose_item(w_in, IN_COLS, 3072, (bf16*)(wl + W_IN), D, 0, 0, scr, r, lane); continue; } r -= I_IN1;
        if (r < I_IN2) { transpose_item(w_in + 3088, IN_COLS, 4608, (bf16*)(wl + W_IN), D, 3072, 0, scr, r, lane); continue; } r -= I_IN2;
        if (r < I_BA) { transpose_item(a.in[13] + (size_t)l * 1024 * 1024, 1024, 1024, (bf16*)(wl + W_BR), 2048, 0, 0, scr, r, lane); continue; } r -= I_BA;
        if (r < I_BB) { transpose_item(a.in[14] + (size_t)l * 512 * 1024, 1024, 1024, (bf16*)(wl + W_BR), 2048, 0, 1024, scr, r, lane); continue; } r -= I_BB;
        if (r < I_BC) { transpose_item(a.in[15] + (size_t)l * 512 * 1024, 1024, 1024, (bf16*)(wl + W_BR), 2048, 0, 1536, scr, r, lane); continue; } r -= I_BC;
        if (r < I_O) { transpose_item(a.in[16] + (size_t)l * 1024 * 1024, 1024, 1024, (bf16*)(wl + W_OUT), 1024, 0, 0, scr, r, lane); continue; } r -= I_O;
        if (r < I_F1) { transpose_item(a.in[18] + (size_t)l * 1024 * FF, FF, FF, (bf16*)(wl + W_FF1), 1024, 0, 0, scr, r, lane); continue; } r -= I_F1;
        transpose_item(a.in[19] + (size_t)l * FF * 1024, 1024, 1024, (bf16*)(wl + W_FF2), FF, 0, 0, scr, r, lane);
    }
}

template <int MODE>
__device__ __forceinline__ void norm_phase(LAS unsigned char* lds, int vcu, int G,
                                           const float* hp, const float* hs, const float* w, bf16* HN, float* GLOG, float* outf,
                                           const float* w_in_l, const float* w_gk2_l, const float* b_gk_l, int mlo = 0, int mhi = M) {
    const int tid = opaque_tid(), lane = tid & 63, wave = __builtin_amdgcn_readfirstlane(tid >> 6), gw = vcu * NWAVES + wave, NGW = G * NWAVES;
    LAS float* Wg = (LAS float*)lds;
    LAS float* Wk = Wg + 16 * 1024;
    if (MODE == 1) {
        for (int idx = tid; idx < 16 * 1024; idx += 512) { const int k = idx >> 4, c = idx & 15; Wg[c * 1024 + k] = w_in_l[(size_t)k * IN_COLS + 3072 + c]; }
        for (int idx = tid; idx < 16 * 512; idx += 512) Wk[idx] = w_gk2_l[idx];
        __syncthreads();
    }
    f32x4 wv[4];
#pragma unroll
    for (int j = 0; j < 4; ++j) wv[j] = *(const f32x4*)(w + 4 * lane + 256 * j);
    f32x4 nv[4];
    { const int m0 = mlo + gw;
      if (m0 < mhi) { const float* xr = (m0 < MP) ? hp + (size_t)m0 * D : hs + (size_t)(m0 - MP) * D;
#pragma unroll
          for (int j = 0; j < 4; ++j) nv[j] = *(const f32x4*)(xr + 4 * lane + 256 * j); } }
    for (int m = mlo + gw; m < mhi; m += NGW) {
        f32x4 v[4]; float ss = 0.f;
#pragma unroll
        for (int j = 0; j < 4; ++j) v[j] = nv[j];
        { const int mn = m + NGW;
          if (mn < mhi) { const float* xn = (mn < MP) ? hp + (size_t)mn * D : hs + (size_t)(mn - MP) * D;
#pragma unroll
              for (int j = 0; j < 4; ++j) nv[j] = *(const f32x4*)(xn + 4 * lane + 256 * j); } }
#pragma unroll
        for (int j = 0; j < 4; ++j) ss += (v[j].x * v[j].x + v[j].y * v[j].y) + (v[j].z * v[j].z + v[j].w * v[j].w);
        const float r = 1.0f / sqrtf(wave_sum(ss) * (1.0f / D) + EPS);
#pragma unroll
        for (int j = 0; j < 4; ++j) v[j] = v[j] * r * wv[j];
        if (MODE == 2) {
#pragma unroll
            for (int j = 0; j < 4; ++j) *(f32x4*)(outf + (size_t)m * D + 4 * lane + 256 * j) = v[j];
        } else {
#pragma unroll
            for (int j = 0; j < 4; ++j) { v2u o; o.x = pk2(v[j].x, v[j].y); o.y = pk2(v[j].z, v[j].w); *(v2u*)(HN + (size_t)m * D + 4 * lane + 256 * j) = o; }
        }
        if (MODE == 1) {
            float gl[16];
#pragma unroll
            for (int c = 0; c < 16; ++c) { float p = 0.f;
#pragma unroll
                for (int j = 0; j < 4; ++j) { const f32x4 wg = *(const LAS f32x4*)(Wg + c * 1024 + 4 * lane + 256 * j); p += (v[j].x * wg.x + v[j].y * wg.y) + (v[j].z * wg.z + v[j].w * wg.w); }
                gl[c] = wave_sum(p); if ((c & 3) == 3) asm volatile("" ::: "memory"); }
#pragma unroll
            for (int hb = 0; hb < 2; ++hb) { const int d0 = 4 * lane + 256 * hb;
                f32x4 acc = *(const f32x4*)(b_gk_l + d0);
#pragma unroll
                for (int c = 0; c < 16; ++c) { const f32x4 wk = *(const LAS f32x4*)(Wk + c * 512 + d0); acc = acc + wk * gl[c]; }
                f32x4 o;
#pragma unroll
                for (int i = 0; i < 4; ++i) { const float x = acc[i]; const float ls = (x < 0.f ? x : 0.f) - __logf(1.0f + __expf(-fabsf(x))); o[i] = ls * (1.0f / 16.0f); }
                *(f32x4*)(GLOG + (size_t)m * 512 + d0) = o; }
        }
    }
    if (MODE == 1) __syncthreads();
}

__device__ __forceinline__ void gla_seq(LAS unsigned char* lds, const bf16* PROJ, const float* GLOG, bf16* MIXOUT, const float* gn,
                                        int row0, int T, int h, const float* S0, float* Sout) {
    const int tid = opaque_tid(), lane = tid & 63, wave = __builtin_amdgcn_readfirstlane(tid >> 6);
    LAS float* qs = (LAS float*)lds;
    LAS float* ks = qs + 16 * 128;
    LAS float* as = ks + 16 * 128;
    LAS float* op = as + 16 * 128;
    const int e = tid & 255, dh = __builtin_amdgcn_readfirstlane(tid >> 8);
    float S[64];
#pragma unroll
    for (int i = 0; i < 64; ++i) S[i] = S0 ? S0[(size_t)(dh * 64 + i) * 256 + e] : 0.f;
    const int TB = T < 16 ? T : 16;
    for (int t0 = 0; t0 < T; t0 += TB) {
        __syncthreads();
        for (int idx = tid; idx < TB * 128; idx += 512) { const int t = idx >> 7, d = idx & 127; const size_t row = (size_t)(row0 + t0 + t);
            qs[idx] = bf2f(PROJ[row * NPJ + C_Q + h * 128 + d]); ks[idx] = bf2f(PROJ[row * NPJ + C_K + h * 128 + d]); as[idx] = __expf(GLOG[row * 512 + h * 128 + d]); }
        __syncthreads();
        for (int t = 0; t < TB; ++t) {
            const float v = bf2f(PROJ[(size_t)(row0 + t0 + t) * NPJ + C_V + h * 256 + e]);
            const LAS float* qp = qs + t * 128 + dh * 64; const LAS float* kp = ks + t * 128 + dh * 64; const LAS float* ap = as + t * 128 + dh * 64;
            float o = 0.f;
#pragma unroll
            for (int i4 = 0; i4 < 16; ++i4) { const f32x4 q4 = *(const LAS f32x4*)(qp + 4 * i4), k4 = *(const LAS f32x4*)(kp + 4 * i4), a4 = *(const LAS f32x4*)(ap + 4 * i4);
#pragma unroll
                for (int j = 0; j < 4; ++j) { const int i = 4 * i4 + j; S[i] = a4[j] * S[i] + k4[j] * v; o += q4[j] * S[i]; } }
            op[(t * 2 + dh) * 256 + e] = o;
        }
        __syncthreads();
#pragma unroll
        for (int tt = 0; tt < 2; ++tt) { const int t = wave * 2 + tt;
            if (t < TB) { const int e4 = lane * 4; const size_t row = (size_t)(row0 + t0 + t);
                const f32x4 o = *(const LAS f32x4*)(op + (t * 2) * 256 + e4) + *(const LAS f32x4*)(op + (t * 2 + 1) * 256 + e4);
                const float ss = wave_sum((o.x * o.x + o.y * o.y) + (o.z * o.z + o.w * o.w));
                const float r = 1.0f / sqrtf(ss * (1.0f / 256.0f) + EPS);
                const v2u gw2 = *(const v2u*)(PROJ + row * NPJ + C_GO + h * 256 + e4);
                const f32x4 g4 = *(const f32x4*)(gn + e4);
                const float g0 = bflo(gw2.x), g1 = bfhi(gw2.x), g2 = bflo(gw2.y), g3 = bfhi(gw2.y);
                v2u ow; ow.x = pk2(o.x * r * g4.x * (g0 * sigmoid_f(g0)), o.y * r * g4.y * (g1 * sigmoid_f(g1))); ow.y = pk2(o.z * r * g4.z * (g2 * sigmoid_f(g2)), o.w * r * g4.w * (g3 * sigmoid_f(g3)));
                *(v2u*)(MIXOUT + row * MIXW + h * 256 + e4) = ow; } }
    }
#pragma unroll
    for (int i = 0; i < 64; ++i) Sout[(size_t)(dh * 64 + i) * 256 + e] = S[i];
    __syncthreads();
}

typedef float f32x16 __attribute__((ext_vector_type(16)));
typedef short s16x4 __attribute__((ext_vector_type(4)));
#define MFMA32(a, b, c) __builtin_amdgcn_mfma_f32_32x32x16_bf16((a), (b), (c), 0, 0, 0)
constexpr int GL_QG = 0, GL_KG = 17408, GL_KD = 34816, GL_VV = 55296, GL_PP = 92160, GL_DEC = 101376, GL_TOT = 101888, GL_END = 110080;
constexpr int GL_SQ = 272, GL_SKD = 320, GL_SV = 576, GL_SP = 144, GL_SO = 1040;
static_assert(GL_END <= RING_BYTES && 64 * GL_SO <= GL_PP, "gla lds map");
__device__ __forceinline__ bf16x8 tr_frag(LAS unsigned char* p, int rowstride4) {
    const s16x4 lo = __builtin_amdgcn_ds_read_tr16_b64_v4i16((LAS s16x4*)p), hi = __builtin_amdgcn_ds_read_tr16_b64_v4i16((LAS s16x4*)(p + rowstride4));
    return __builtin_shufflevector(lo, hi, 0, 1, 2, 3, 4, 5, 6, 7);
}
template <bool FULL>
__device__ __forceinline__ void gla_chunked(LAS unsigned char* lds, const bf16* PROJ, const float* GLOG, bf16* MIXOUT, const float* gn, int row0, int nchunks, int h,
                                            int nprev, const float* Sloc_prev, const float* Dlog_prev, float* Sout, float* Dlog_out) {
    const int tid = opaque_tid(), lane = tid & 63, w = __builtin_amdgcn_readfirstlane(tid >> 6), r = lane & 31, hh = lane >> 5;
    const int tq = (lane & 15) >> 2, tp = lane & 3, tblk = (lane >> 4) & 1;
    const int dq = tid & 31, seg = tid >> 5;
    f32x16 S[4];
#pragma unroll
    for (int b = 0; b < 4; ++b)
#pragma unroll
        for (int i = 0; i < 16; ++i) S[b][i] = 0.f;
    for (int pi = 0; pi < nprev; ++pi) {
        int lo_ = 4 * hh * 256 + 32 * w + r; asm volatile("" : "+v"(lo_));
        const float* sp = Sloc_prev + (size_t)pi * 128 * 256 + lo_; const float* dp = Dlog_prev + pi * 128 + 4 * hh;
#pragma unroll
        for (int b = 0; b < 4; ++b) {
#pragma unroll
            for (int i = 0; i < 16; ++i) { const int dr = 32 * b + (i & 3) + 8 * (i >> 2); S[b][i] = __expf(dp[dr]) * S[b][i] + sp[dr * 256]; }
            asm volatile("" ::: "memory"); }
    }
    f32x4 dsum = (f32x4){0.f, 0.f, 0.f, 0.f};
    f32x4 gr[4]; v2u qv[4], kv[4]; v4u vv[4];
#define GLA_LOAD_RAW(R0) do { _Pragma("unroll") for (int i = 0; i < 4; ++i) { gr[i] = *(const f32x4*)(GLOG + (size_t)((R0) + 4 * seg + i) * 512 + h * 128 + 4 * dq); \
        const bf16* pr = PROJ + (size_t)((R0) + 4 * seg + i) * NPJ + h * 128 + 4 * dq; qv[i] = *(const v2u*)(pr + C_Q); kv[i] = *(const v2u*)(pr + C_K); } } while (0)
#define GLA_LOAD_V(R0) do { _Pragma("unroll") for (int i = 0; i < 4; ++i) { \
        const int idx = tid + 512 * i, sr = idx >> 5, ch = idx & 31; vv[i] = *(const v4u*)(PROJ + (size_t)((R0) + sr) * NPJ + C_V + h * 256 + ch * 8); } } while (0)
    GLA_LOAD_RAW(row0); GLA_LOAD_V(row0);
    for (int c = 0; c < nchunks; ++c) {
        const int r0 = row0 + 64 * c;
        {
            f32x4 cs[4];
#pragma unroll
            for (int i = 0; i < 4; ++i) { cs[i] = gr[i]; if (i) cs[i] = cs[i] + cs[i - 1]; }
            *(LAS f32x4*)(lds + GL_TOT + (seg * 128 + 4 * dq) * 4) = cs[3];
            LDS_BARRIER();
            f32x4 pre = (f32x4){0.f, 0.f, 0.f, 0.f}, tot = (f32x4){0.f, 0.f, 0.f, 0.f};
#pragma unroll
            for (int s2 = 0; s2 < 16; ++s2) { const f32x4 tv = *(const LAS f32x4*)(lds + GL_TOT + (s2 * 128 + 4 * dq) * 4); tot = tot + tv; if (s2 < seg) pre = pre + tv; }
#pragma unroll
            for (int i = 0; i < 4; ++i) { const f32x4 b = pre + cs[i]; const int t = 4 * seg + i;
                float q4[4] = {bflo(qv[i].x), bfhi(qv[i].x), bflo(qv[i].y), bfhi(qv[i].y)}, k4[4] = {bflo(kv[i].x), bfhi(kv[i].x), bflo(kv[i].y), bfhi(kv[i].y)};
                float qg[4], kg[4], kd[4];
#pragma unroll
                for (int j = 0; j < 4; ++j) { qg[j] = q4[j] * __expf(b[j]); kg[j] = k4[j] * __expf(-b[j]); kd[j] = k4[j] * __expf(tot[j] - b[j]); }
                v2u o;
                if (FULL) { o.x = pg8::cvt_pk_bf16(qg[0], qg[1]); o.y = pg8::cvt_pk_bf16(qg[2], qg[3]); *(LAS v2u*)(lds + GL_QG + t * GL_SQ + dq * 8) = o;
                            o.x = pg8::cvt_pk_bf16(kg[0], kg[1]); o.y = pg8::cvt_pk_bf16(kg[2], kg[3]); *(LAS v2u*)(lds + GL_KG + t * GL_SQ + dq * 8) = o; }
                o.x = pg8::cvt_pk_bf16(kd[0], kd[1]); o.y = pg8::cvt_pk_bf16(kd[2], kd[3]); *(LAS v2u*)(lds + GL_KD + t * GL_SKD + dq * 8) = o; }
            dsum = dsum + tot;
            if (seg == 0) { f32x4 dc; dc.x = __expf(tot.x); dc.y = __expf(tot.y); dc.z = __expf(tot.z); dc.w = __expf(tot.w); *(LAS f32x4*)(lds + GL_DEC + dq * 16) = dc; }
#pragma unroll
            for (int i = 0; i < 4; ++i) { const int idx = tid + 512 * i, sr = idx >> 5, ch = idx & 31; *(LAS v4u*)(lds + GL_VV + sr * GL_SV + ch * 16) = vv[i]; }
            if (c + 1 < nchunks) GLA_LOAD_RAW(r0 + 64);
        }
        LDS_BARRIER();
        for (int qa_ = 0; qa_ < REP_ATT; ++qa_) {
        if (FULL && w < 3) {
            const int bi = w > 0 ? 1 : 0, bj = w > 1 ? 1 : 0;
            f32x16 acc;
#pragma unroll
            for (int i = 0; i < 16; ++i) acc[i] = 0.f;
#pragma unroll
            for (int ks = 0; ks < 8; ++ks) {
                const bf16x8 a = *(const LAS bf16x8*)(lds + GL_QG + (32 * bi + r) * GL_SQ + (16 * ks + 8 * hh) * 2);
                const bf16x8 b = *(const LAS bf16x8*)(lds + GL_KG + (32 * bj + r) * GL_SQ + (16 * ks + 8 * hh) * 2);
                acc = MFMA32(a, b, acc); }
            int pbase = GL_PP + (32 * bi + 4 * hh) * GL_SP + (32 * bj + r) * 2; asm volatile("" : "+v"(pbase));
#pragma unroll
            for (int i = 0; i < 16; ++i) { const int tl = (i & 3) + 8 * (i >> 2) + 4 * hh; float v = acc[i]; if (bi == bj && r > tl) v = 0.f;
                *(LAS unsigned short*)(lds + pbase + ((i & 3) + 8 * (i >> 2)) * GL_SP) = (unsigned short)f2bf(v); }
        }
        if (FULL) LDS_BARRIER();
        }
        f32x16 o[2];
        {
            bf16x8 Bv[4];
#pragma unroll
            for (int ks = 0; ks < 4; ++ks) Bv[ks] = tr_frag(lds + GL_VV + (16 * ks + 8 * hh + tq) * GL_SV + (4 * w + 2 * tblk + (tp >> 1)) * 16 + 8 * (tp & 1), 4 * GL_SV);
            for (int qm_ = 0; qm_ < REP_OMM; ++qm_)
#pragma unroll
            for (int rb = 0; rb < (FULL ? 2 : 0); ++rb) {
#pragma unroll
                for (int i = 0; i < 16; ++i) o[rb][i] = 0.f;
#pragma unroll
                for (int b = 0; b < 4; ++b)
#pragma unroll
                    for (int s2 = 0; s2 < 2; ++s2) {
                        const LAS unsigned char* ap = lds + GL_QG + (32 * rb + r) * GL_SQ + (32 * b + 16 * s2 + 4 * hh) * 2;
                        const s16x4 lo = *(const LAS s16x4*)ap, hi = *(const LAS s16x4*)(ap + 16);
                        const bf16x8 a = __builtin_shufflevector(lo, hi, 0, 1, 2, 3, 4, 5, 6, 7);
                        v4u pk; pk.x = pg8::cvt_pk_bf16(S[b][8 * s2 + 0], S[b][8 * s2 + 1]); pk.y = pg8::cvt_pk_bf16(S[b][8 * s2 + 2], S[b][8 * s2 + 3]);
                        pk.z = pg8::cvt_pk_bf16(S[b][8 * s2 + 4], S[b][8 * s2 + 5]); pk.w = pg8::cvt_pk_bf16(S[b][8 * s2 + 6], S[b][8 * s2 + 7]);
                        o[rb] = MFMA32(a, __builtin_bit_cast(bf16x8, pk), o[rb]); if (s2) asm volatile("" ::: "memory"); }
#pragma unroll
                for (int ks = 0; ks < 4; ++ks) if (ks < 2 || rb == 1) {
                    const bf16x8 a = *(const LAS bf16x8*)(lds + GL_PP + (32 * rb + r) * GL_SP + (16 * ks + 8 * hh) * 2);
                    o[rb] = MFMA32(a, Bv[ks], o[rb]); }
            }
#pragma unroll
            for (int b = 0; b < 4; ++b) {
#pragma unroll
                for (int g4 = 0; g4 < 4; ++g4) { const f32x4 dc = *(const LAS f32x4*)(lds + GL_DEC + (32 * b + 8 * g4 + 4 * hh) * 4);
#pragma unroll
                    for (int j = 0; j < 4; ++j) S[b][4 * g4 + j] *= dc[j]; }
#pragma unroll
                for (int ks = 0; ks < 4; ++ks) {
                    const bf16x8 a = tr_frag(lds + GL_KD + (16 * ks + 8 * hh + tq) * GL_SKD + (4 * b + 2 * tblk + (tp >> 1)) * 16 + 8 * (tp & 1), 4 * GL_SKD);
                    S[b] = MFMA32(a, Bv[ks], S[b]); }
                asm volatile("" ::: "memory");
            }
        }
        LDS_BARRIER();
        if (!FULL) { if (c + 1 < nchunks) GLA_LOAD_V(r0 + 64); }
        if (FULL) for (int qe_ = 0; qe_ < REP_EPI; ++qe_) {
        v4u gpre[4];
#pragma unroll
        for (int i = 0; i < 4; ++i) gpre[i] = *(const v4u*)(PROJ + (size_t)(r0 + (tid >> 3)) * NPJ + C_GO + h * 256 + (tid & 7) * 32 + 8 * i);
        int obase = 4 * hh * GL_SO + (32 * w + r) * 4; asm volatile("" : "+v"(obase));
#pragma unroll
        for (int rb = 0; rb < 2; ++rb)
#pragma unroll
            for (int i = 0; i < 16; ++i) *(LAS float*)(lds + obase + (32 * rb + (i & 3) + 8 * (i >> 2)) * GL_SO) = o[rb][i];
        if (c + 1 < nchunks) GLA_LOAD_V(r0 + 64);
        LDS_BARRIER();
        {
            const int t = tid >> 3, sg = tid & 7, e0 = sg * 32; const size_t row = (size_t)(r0 + t);
            int e0g = e0; asm volatile("" : "+v"(e0g));
            f32x4 ov[8]; float ss = 0.f;
#pragma unroll
            for (int i = 0; i < 8; ++i) { ov[i] = *(const LAS f32x4*)(lds + t * GL_SO + (e0 + 4 * i) * 4); ss += (ov[i].x * ov[i].x + ov[i].y * ov[i].y) + (ov[i].z * ov[i].z + ov[i].w * ov[i].w); }
            ss += __shfl_xor(ss, 1); ss += __shfl_xor(ss, 2); ss += __shfl_xor(ss, 4);
            const float rn = 1.0f / sqrtf(ss * (1.0f / 256.0f) + EPS);
#pragma unroll
            for (int i = 0; i < 4; ++i) { const v4u gw4 = gpre[i];
                const f32x4 ga = *(const f32x4*)(gn + e0g + 8 * i), gb = *(const f32x4*)(gn + e0g + 8 * i + 4);
                const float g0 = bflo(gw4.x), g1 = bfhi(gw4.x), g2 = bflo(gw4.y), g3 = bfhi(gw4.y), g4 = bflo(gw4.z), g5 = bfhi(gw4.z), g6 = bflo(gw4.w), g7 = bfhi(gw4.w);
                const f32x4 oa = ov[2 * i], ob = ov[2 * i + 1]; v4u ow;
                ow.x = pg8::cvt_pk_bf16(oa.x * rn * ga.x * (g0 * sigmoid_f(g0)), oa.y * rn * ga.y * (g1 * sigmoid_f(g1)));
                ow.y = pg8::cvt_pk_bf16(oa.z * rn * ga.z * (g2 * sigmoid_f(g2)), oa.w * rn * ga.w * (g3 * sigmoid_f(g3)));
                ow.z = pg8::cvt_pk_bf16(ob.x * rn * gb.x * (g4 * sigmoid_f(g4)), ob.y * rn * gb.y * (g5 * sigmoid_f(g5)));
                ow.w = pg8::cvt_pk_bf16(ob.z * rn * gb.z * (g6 * sigmoid_f(g6)), ob.w * rn * gb.w * (g7 * sigmoid_f(g7)));
                *(v4u*)(MIXOUT + row * MIXW + h * 256 + e0 + 8 * i) = ow; }
        }
        LDS_BARRIER();
        }
    }
    if (Sout) {
        int lo_ = 4 * hh * 256 + 32 * w + r; asm volatile("" : "+v"(lo_)); float* sop = Sout + lo_;
#pragma unroll
        for (int b = 0; b < 4; ++b) {
#pragma unroll
            for (int i = 0; i < 16; ++i) sop[(32 * b + (i & 3) + 8 * (i >> 2)) * 256] = S[b][i];
            asm volatile("" ::: "memory"); }
    }
    if (Dlog_out && seg == 0) *(f32x4*)(Dlog_out + 4 * dq) = dsum;
#undef GLA_LOAD_RAW
#undef GLA_LOAD_V
}

__device__ __forceinline__ void gla_sample(LAS unsigned char* lds, const bf16* PROJ, const float* GLOG, bf16* MIXOUT, const float* gn, int r0, int h, const float* S0, float* Sout) {
    const int tid = opaque_tid(), lane = tid & 63, w = __builtin_amdgcn_readfirstlane(tid >> 6), r = lane & 31, hh = lane >> 5;
    const int tq = (lane & 15) >> 2, tp = lane & 3, tblk = (lane >> 4) & 1;
    int lane_off = 4 * hh * 256 + 32 * w + r; asm volatile("" : "+v"(lane_off));
    const float* s0p = S0 + lane_off; float* sop = Sout + lane_off;
    f32x16 S[4];
#pragma unroll
    for (int b = 0; b < 4; ++b) {
#pragma unroll
        for (int i = 0; i < 16; ++i) S[b][i] = s0p[(32 * b + (i & 3) + 8 * (i >> 2)) * 256];
        asm volatile("" ::: "memory"); }
    if (tid < 32) {
        const int dq = tid; f32x4 b = (f32x4){0.f, 0.f, 0.f, 0.f}, bs[8];
#pragma unroll
        for (int t = 0; t < 8; ++t) { b = b + *(const f32x4*)(GLOG + (size_t)(r0 + t) * 512 + h * 128 + 4 * dq); bs[t] = b; }
#pragma unroll
        for (int t = 0; t < 8; ++t) { const bf16* pr = PROJ + (size_t)(r0 + t) * NPJ + h * 128 + 4 * dq; const v2u qv = *(const v2u*)(pr + C_Q), kv = *(const v2u*)(pr + C_K);
            const float q4[4] = {bflo(qv.x), bfhi(qv.x), bflo(qv.y), bfhi(qv.y)}, k4[4] = {bflo(kv.x), bfhi(kv.x), bflo(kv.y), bfhi(kv.y)};
            float qg[4], kg[4], kd[4];
#pragma unroll
            for (int j = 0; j < 4; ++j) { qg[j] = q4[j] * __expf(bs[t][j]); kg[j] = k4[j] * __expf(-bs[t][j]); kd[j] = k4[j] * __expf(b[j] - bs[t][j]); }
            v2u o; o.x = pg8::cvt_pk_bf16(qg[0], qg[1]); o.y = pg8::cvt_pk_bf16(qg[2], qg[3]); *(LAS v2u*)(lds + GL_QG + t * GL_SQ + dq * 8) = o;
            o.x = pg8::cvt_pk_bf16(kg[0], kg[1]); o.y = pg8::cvt_pk_bf16(kg[2], kg[3]); *(LAS v2u*)(lds + GL_KG + t * GL_SQ + dq * 8) = o;
            o.x = pg8::cvt_pk_bf16(kd[0], kd[1]); o.y = pg8::cvt_pk_bf16(kd[2], kd[3]); *(LAS v2u*)(lds + GL_KD + t * GL_SKD + dq * 8) = o; }
        f32x4 dc; dc.x = __expf(b.x); dc.y = __expf(b.y); dc.z = __expf(b.z); dc.w = __expf(b.w); *(LAS f32x4*)(lds + GL_DEC + dq * 16) = dc;
    } else if (tid >= 256) {
        const int idx = tid - 256, sr = idx >> 5, ch = idx & 31;
        *(LAS v4u*)(lds + GL_VV + sr * GL_SV + ch * 16) = *(const v4u*)(PROJ + (size_t)(r0 + sr) * NPJ + C_V + h * 256 + ch * 8);
    } else if (tid >= 64) {
        const v4u z = (v4u){0u, 0u, 0u, 0u};
        for (int idx = tid - 64; idx < 256 + 128; idx += 192) {
            if (idx < 256) *(LAS v4u*)(lds + GL_VV + (8 + (idx >> 5)) * GL_SV + (idx & 31) * 16) = z;
            else { const int k2 = idx - 256; *(LAS v4u*)(lds + GL_KD + (8 + (k2 >> 4)) * GL_SKD + (k2 & 15) * 16) = z; } }
    }
    LDS_BARRIER();
    if (w == 0) {
        f32x16 acc;
#pragma unroll
        for (int i = 0; i < 16; ++i) acc[i] = 0.f;
#pragma unroll
        for (int ks = 0; ks < 8; ++ks) {
            const bf16x8 a = *(const LAS bf16x8*)(lds + GL_QG + r * GL_SQ + (16 * ks + 8 * hh) * 2);
            const bf16x8 b = *(const LAS bf16x8*)(lds + GL_KG + r * GL_SQ + (16 * ks + 8 * hh) * 2);
            acc = MFMA32(a, b, acc); }
#pragma unroll
        for (int i = 0; i < 16; ++i) { const int tl = (i & 3) + 8 * (i >> 2) + 4 * hh; float v = acc[i]; if (r > tl || tl >= 8) v = 0.f;
            if (r < 16) *(LAS unsigned short*)(lds + GL_PP + tl * GL_SP + r * 2) = (unsigned short)f2bf(v); }
    }
    LDS_BARRIER();
    f32x16 o;
    {
        const bf16x8 Bv = tr_frag(lds + GL_VV + (8 * hh + tq) * GL_SV + (4 * w + 2 * tblk + (tp >> 1)) * 16 + 8 * (tp & 1), 4 * GL_SV);
#pragma unroll
        for (int i = 0; i < 16; ++i) o[i] = 0.f;
#pragma unroll
        for (int b = 0; b < 4; ++b)
#pragma unroll
            for (int s2 = 0; s2 < 2; ++s2) {
                const LAS unsigned char* ap = lds + GL_QG + r * GL_SQ + (32 * b + 16 * s2 + 4 * hh) * 2;
                const s16x4 lo = *(const LAS s16x4*)ap, hi = *(const LAS s16x4*)(ap + 16);
                const bf16x8 a = __builtin_shufflevector(lo, hi, 0, 1, 2, 3, 4, 5, 6, 7);
                v4u pk; pk.x = pg8::cvt_pk_bf16(S[b][8 * s2 + 0], S[b][8 * s2 + 1]); pk.y = pg8::cvt_pk_bf16(S[b][8 * s2 + 2], S[b][8 * s2 + 3]);
                pk.z = pg8::cvt_pk_bf16(S[b][8 * s2 + 4], S[b][8 * s2 + 5]); pk.w = pg8::cvt_pk_bf16(S[b][8 * s2 + 6], S[b][8 * s2 + 7]);
                o = MFMA32(a, __builtin_bit_cast(bf16x8, pk), o); }
        { const bf16x8 a = *(const LAS bf16x8*)(lds + GL_PP + r * GL_SP + (8 * hh) * 2); o = MFMA32(a, Bv, o); }
#pragma unroll
        for (int b = 0; b < 4; ++b) {
#pragma unroll
            for (int g4 = 0; g4 < 4; ++g4) { const f32x4 dc = *(const LAS f32x4*)(lds + GL_DEC + (32 * b + 8 * g4 + 4 * hh) * 4);
#pragma unroll
                for (int j = 0; j < 4; ++j) S[b][4 * g4 + j] *= dc[j]; }
            const bf16x8 a = tr_frag(lds + GL_KD + (8 * hh + tq) * GL_SKD + (4 * b + 2 * tblk + (tp >> 1)) * 16 + 8 * (tp & 1), 4 * GL_SKD);
            S[b] = MFMA32(a, Bv, S[b]); }
    }
    LDS_BARRIER();
#pragma unroll
    for (int i = 0; i < 4; ++i) *(LAS float*)(lds + (i + 4 * hh) * GL_SO + (32 * w + r) * 4) = o[i];
    LDS_BARRIER();
    if (tid < 64) {
        const int t = tid >> 3, sg = tid & 7, e0 = sg * 32; const size_t row = (size_t)(r0 + t);
        f32x4 ov[8]; float ss = 0.f;
#pragma unroll
        for (int i = 0; i < 8; ++i) { ov[i] = *(const LAS f32x4*)(lds + t * GL_SO + (e0 + 4 * i) * 4); ss += (ov[i].x * ov[i].x + ov[i].y * ov[i].y) + (ov[i].z * ov[i].z + ov[i].w * ov[i].w); }
        ss += __shfl_xor(ss, 1); ss += __shfl_xor(ss, 2); ss += __shfl_xor(ss, 4);
        const float rn = 1.0f / sqrtf(ss * (1.0f / 256.0f) + EPS);
#pragma unroll
        for (int i = 0; i < 4; ++i) { const v4u gw4 = *(const v4u*)(PROJ + row * NPJ + C_GO + h * 256 + e0 + 8 * i);
            const f32x4 ga = *(const f32x4*)(gn + e0 + 8 * i), gb = *(const f32x4*)(gn + e0 + 8 * i + 4);
            const float g0 = bflo(gw4.x), g1 = bfhi(gw4.x), g2 = bflo(gw4.y), g3 = bfhi(gw4.y), g4 = bflo(gw4.z), g5 = bfhi(gw4.z), g6 = bflo(gw4.w), g7 = bfhi(gw4.w);
            const f32x4 oa = ov[2 * i], ob = ov[2 * i + 1]; v4u ow;
            ow.x = pg8::cvt_pk_bf16(oa.x * rn * ga.x * (g0 * sigmoid_f(g0)), oa.y * rn * ga.y * (g1 * sigmoid_f(g1)));
            ow.y = pg8::cvt_pk_bf16(oa.z * rn * ga.z * (g2 * sigmoid_f(g2)), oa.w * rn * ga.w * (g3 * sigmoid_f(g3)));
            ow.z = pg8::cvt_pk_bf16(ob.x * rn * gb.x * (g4 * sigmoid_f(g4)), ob.y * rn * gb.y * (g5 * sigmoid_f(g5)));
            ow.w = pg8::cvt_pk_bf16(ob.z * rn * gb.z * (g6 * sigmoid_f(g6)), ob.w * rn * gb.w * (g7 * sigmoid_f(g7)));
            *(v4u*)(MIXOUT + row * MIXW + h * 256 + e0 + 8 * i) = ow; }
    }
#pragma unroll
    for (int b = 0; b < 4; ++b) {
#pragma unroll
        for (int i = 0; i < 16; ++i) sop[(32 * b + (i & 3) + 8 * (i >> 2)) * 256] = S[b][i];
        asm volatile("" ::: "memory"); }
    LDS_BARRIER();
}

constexpr int PL_W = 0, PL_A = 40960, PL_SW = 320, PL_SA = 272, PL_X = 58368  , PL_O = 78592  ;
__device__ __forceinline__ void mat128_to_lds(LAS unsigned char* lds, int off, int stride, const float* src, bool tril) {
    const int tid = opaque_tid();
#pragma unroll
    for (int i = 0; i < 8; ++i) { const int idx = tid + 512 * i, row = idx >> 5, c4 = idx & 31; f32x4 v = *(const f32x4*)(src + row * 128 + 4 * c4);
        if (tril) { if (4 * c4 + 0 > row) v.x = 0.f; if (4 * c4 + 1 > row) v.y = 0.f; if (4 * c4 + 2 > row) v.z = 0.f; if (4 * c4 + 3 > row) v.w = 0.f; }
        v2u o; o.x = pg8::cvt_pk_bf16(v.x, v.y); o.y = pg8::cvt_pk_bf16(v.z, v.w); *(LAS v2u*)(lds + off + row * stride + c4 * 8) = o; }
}
template <int G>
__device__ __forceinline__ void pool_tile(LAS unsigned char* lds, const bf16* PROJ, bf16* MIXOUT, const float* scale_g, const float* hist_l, int row0, int pos0, bool sample, int seq0) {
    const int tid = opaque_tid(), lane = tid & 63, w = __builtin_amdgcn_readfirstlane(tid >> 6), r = lane & 31, hh = lane >> 5;
    const int tq = (lane & 15) >> 2, tp = lane & 3, tblk = (lane >> 4) & 1;
    const int c = tid & 127, tqr = tid >> 7, col = C_XP + G * 128 + c;
    constexpr int WIN = 2 << G;
    if (!sample) {
#pragma unroll
        for (int i = 0; i < 3; ++i) { const int idx = tid + 512 * i, rr = idx >> 4, ch = idx & 15;
            if (rr < 79) { const int p = pos0 - 15 + rr; v4u xv = (v4u){0u, 0u, 0u, 0u};
                if (p >= 0) xv = *(const v4u*)(PROJ + (size_t)(row0 - pos0 + p) * NPJ + C_XP + G * 128 + ch * 8);
                *(LAS v4u*)(lds + PL_X + rr * 256 + ch * 16) = xv; } }
        LDS_BARRIER();
        float P[32]; P[0] = 0.f; float xs[31];
#pragma unroll
        for (int i = 0; i < 31; ++i) { xs[i] = bf2f(*(const LAS unsigned short*)(lds + PL_X + (16 * tqr + i) * 256 + c * 2)); P[i + 1] = P[i] + xs[i]; }
#pragma unroll
        for (int tt = 0; tt < 16; ++tt) { const int pos = pos0 + 16 * tqr + tt; const int cnt = WIN < pos + 1 ? WIN : pos + 1;
            const float pooled = (P[16 + tt] - P[16 + tt - WIN]) / (float)cnt - xs[15 + tt];
            *(LAS unsigned short*)(lds + PL_A + (16 * tqr + tt) * PL_SA + c * 2) = (unsigned short)f2bf(pooled); }
    } else {
#pragma unroll
        for (int sq = 0; sq < 2; ++sq) { const int seq = seq0 + 2 * tqr + sq;
            float P[24]; P[0] = 0.f; float xs[23];
#pragma unroll
            for (int i = 0; i < 23; ++i) { xs[i] = i < 15 ? hist_l[((size_t)seq * 15 + i) * 512 + G * 128 + c] : bf2f(PROJ[(size_t)(MP + seq * ST + i - 15) * NPJ + col]); P[i + 1] = P[i] + xs[i]; }
#pragma unroll
            for (int tt = 0; tt < 8; ++tt) { const float pooled = (P[16 + tt] - P[16 + tt - WIN]) * (1.0f / (float)WIN) - xs[15 + tt];
                *(LAS unsigned short*)(lds + PL_A + (16 * tqr + 8 * sq + tt) * PL_SA + c * 2) = (unsigned short)f2bf(pooled); } }
    }
    LDS_BARRIER();
    {
        const int rb = w & 1, cb = w >> 1; f32x16 acc;
#pragma unroll
        for (int i = 0; i < 16; ++i) acc[i] = 0.f;
#pragma unroll
        for (int ks = 0; ks < 8; ++ks) {
            const bf16x8 a = *(const LAS bf16x8*)(lds + PL_A + (32 * rb + r) * PL_SA + (16 * ks + 8 * hh) * 2);
            const bf16x8 b = tr_frag(lds + PL_W + (16 * ks + 8 * hh + tq) * PL_SW + (4 * cb + 2 * tblk + (tp >> 1)) * 16 + 8 * (tp & 1), 4 * PL_SW);
            acc = MFMA32(a, b, acc); }
        const float sc = scale_g[32 * cb + r];
        int obase = PL_O + (32 * rb + 4 * hh) * PL_SA + (32 * cb + r) * 2; asm volatile("" : "+v"(obase));
#pragma unroll
        for (int i = 0; i < 16; ++i) *(LAS unsigned short*)(lds + obase + ((i & 3) + 8 * (i >> 2)) * PL_SA) = (unsigned short)f2bf(acc[i] * sc);
    }
    LDS_BARRIER();
#pragma unroll
    for (int i = 0; i < 2; ++i) { const int idx = tid + 512 * i, t = idx >> 4, ch = idx & 15;
        *(v4u*)(MIXOUT + (size_t)(row0 + t) * MIXW + 1024 + G * 128 + ch * 8) = *(const LAS v4u*)(lds + PL_O + t * PL_SA + ch * 16); }
    LDS_BARRIER();
}
constexpr int SG_WT = 0, SG_VI = 34816, SG_SW = 272, SG_SV = 320;
__device__ __forceinline__ void sg_chunk(LAS unsigned char* lds, const bf16* PROJ, bf16* MIXOUT, const float* bs_g, int row0, int g) {
    const int tid = opaque_tid(), lane = tid & 63, w = __builtin_amdgcn_readfirstlane(tid >> 6), r = lane & 31, hh = lane >> 5;
    const int tq = (lane & 15) >> 2, tp = lane & 3, tblk = (lane >> 4) & 1;
#pragma unroll
    for (int i = 0; i < 4; ++i) { const int idx = tid + 512 * i, sr = idx >> 4, ch = idx & 15;
        *(LAS v4u*)(lds + SG_VI + sr * SG_SV + ch * 16) = *(const v4u*)(PROJ + (size_t)(row0 + sr) * NPJ + C_VV + g * 128 + ch * 8); }
    LDS_BARRIER();
    const int dj = w & 3, pair = w >> 2;
#pragma unroll
    for (int pass = 0; pass < 2; ++pass) {
        const int bi = pass == 0 ? pair : 3 - pair, nks = 2 * (bi + 1);
        f32x16 acc;
#pragma unroll
        for (int i = 0; i < 16; ++i) acc[i] = 0.f;
#pragma unroll
        for (int ks = 0; ks < 8; ++ks) if (ks < nks) {
            const bf16x8 a = *(const LAS bf16x8*)(lds + SG_WT + (32 * bi + r) * SG_SW + (16 * ks + 8 * hh) * 2);
            const bf16x8 b = tr_frag(lds + SG_VI + (16 * ks + 8 * hh + tq) * SG_SV + (4 * dj + 2 * tblk + (tp >> 1)) * 16 + 8 * (tp & 1), 4 * SG_SV);
            acc = MFMA32(a, b, acc); }
#pragma unroll
        for (int i = 0; i < 16; ++i) { const int t = 32 * bi + (i & 3) + 8 * (i >> 2) + 4 * hh, d = 32 * dj + r;
            const float u = bf2f(PROJ[(size_t)(row0 + t) * NPJ + C_U + g * 128 + d]);
            MIXOUT[(size_t)(row0 + t) * MIXW + 1536 + g * 128 + d] = (bf16)f2bf(u * (acc[i] + bs_g[t])); }
    }
    LDS_BARRIER();
}

__device__ __forceinline__ void pool_item(LAS unsigned char* lds, const bf16* PROJ, bf16* MIXOUT, const float* wmix, const float* scale, const float* hist  ,
                                          int rowseq0, int tpos0, int nt, int g) {
    const int tid = opaque_tid();
    LAS float* pl = (LAS float*)lds;
    const int w = 2 << g;
    for (int idx = tid; idx < nt * 128; idx += 512) { const int t = idx >> 7, c = idx & 127, pos = tpos0 + t, col = C_XP + g * 128 + c;
        float sum = 0.f;
        for (int i = 0; i < w; ++i) { const int p = pos - i;
            if (p >= 0) sum += bf2f(PROJ[(size_t)(rowseq0 + p) * NPJ + col]);
            else if (hist) sum += hist[(size_t)(15 + p) * 512 + g * 128 + c]; }
        const int cnt = hist ? w : (w < pos + 1 ? w : pos + 1);
        pl[idx] = sum / (float)cnt - bf2f(PROJ[(size_t)(rowseq0 + pos) * NPJ + col]); }
    __syncthreads();
    const int j = tid & 127, tq = __builtin_amdgcn_readfirstlane(tid >> 7), tpq = nt >> 2;
    float acc[4] = {0.f, 0.f, 0.f, 0.f};
    for (int c = 0; c < 128; ++c) { const float wv = wmix[(size_t)(g * 128 + c) * 128 + j];
#pragma unroll
        for (int i = 0; i < 4; ++i) if (i < tpq) acc[i] += pl[(tq * tpq + i) * 128 + c] * wv; }
    const float sc = scale[g * 128 + j];
#pragma unroll
    for (int i = 0; i < 4; ++i) if (i < tpq) MIXOUT[(size_t)(rowseq0 + tpos0 + tq * tpq + i) * MIXW + 1024 + g * 128 + j] = (bf16)f2bf(acc[i] * sc);
    __syncthreads();
}

__device__ __forceinline__ void sg_item(LAS unsigned char* lds, const bf16* PROJ, bf16* MIXOUT, const float* ws, const float* bs, int row0, int L, int g) {
    const int tid = opaque_tid();
    LAS float* vt = (LAS float*)lds;
    LAS float* wt = vt + 128 * 128;
    for (int idx = tid; idx < L * 128; idx += 512) { const int s = idx >> 7, d = idx & 127;
        vt[idx] = bf2f(PROJ[(size_t)(row0 + s) * NPJ + C_VV + g * 128 + d]);
        wt[idx] = ws[(size_t)(g * 128 + s) * 128 + d]; }
    __syncthreads();
    const int d = tid & 127, tq = __builtin_amdgcn_readfirstlane(tid >> 7);
    for (int t = tq; t < L; t += 4) { float acc = 0.f;
        for (int s = 0; s <= t; ++s) acc += wt[t * 128 + s] * vt[s * 128 + d];
        const float u = bf2f(PROJ[(size_t)(row0 + t) * NPJ + C_U + g * 128 + d]);
        MIXOUT[(size_t)(row0 + t) * MIXW + 1536 + g * 128 + d] = (bf16)f2bf(u * (acc + bs[g * 128 + t])); }
    __syncthreads();
}


#ifndef PH
#define PH 0xFFFF
#endif
#if PH & 4096
#define MROWS MP
#else
#define MROWS M
#endif
__global__ void __launch_bounds__(NWAVES * 64, 2) hybrid_fwd(Args args) {
    extern __shared__ __attribute__((aligned(16))) unsigned char lds_raw[];
    LAS unsigned char* lds = (LAS unsigned char*)lds_raw;
    volatile LAS unsigned* MISC = (volatile LAS unsigned*)(lds + MISC_OFF);
    const int G = gridDim.x, bx = blockIdx.x, vcu = (G % 8 == 0) ? (bx % 8) * (G / 8) + bx / 8 : bx;
    unsigned char* ws = args.ws;
    gu32* ctl = (gu32*)(ws + WS_CTL);
    for (int u = threadIdx.x; u < (LDS_BYTES - LDSCTL_OFF) / 4; u += NWAVES * 64) ((LAS unsigned*)(lds + LDSCTL_OFF))[u] = 0u;
    __syncthreads();
    XcdBarrier bar = xcd_barrier_post((unsigned*)(ctl + CW_BAR), MISC + 8, (unsigned)G, true);
    XcdBarrier bar2 = xcd_barrier_post((unsigned*)(ctl + CW_BAR2), MISC + 10, 64u, vcu >= 128 && vcu < 192);
#ifdef USE_CG
#define GRID_BAR() cooperative_groups::this_grid().sync()
#else
#define GRID_BAR() xcd_barrier(bar)
#endif

    bf16* HN = (bf16*)(ws + WS_HN);
    float* GLOG = (float*)(ws + WS_GLOG);
    float* SLOC = (float*)(ws + WS_HN);
    float* DLOG = (float*)(ws + WS_HN + 16 * MiB);
    bf16* MIX = (bf16*)(ws + WS_MIX);
    bf16* PROJ = (bf16*)(ws + WS_PROJ);
    bf16* FFH = (bf16*)(ws + WS_PROJ);
    bf16* FFHS = (bf16*)(ws + WS_FFHS);
    float* SLAB = (float*)(ws + WS_SLAB);
    float* H = args.out + O_Y;
    const float* xp_in = args.in[0]; const float* xs_in = args.in[1];

#if PH & 1
    for (int q_ = 0; q_ < REP_CONV; ++q_) { convert_weights(args, lds, vcu, G);
    __syncthreads(); }
#endif
#if PH & 2
    for (int q_ = 0; q_ < REP_N1; ++q_)
    norm_phase<1>(lds, vcu, G, xp_in, xs_in, args.in[4], HN, GLOG, nullptr, args.in[5], args.in[6], args.in[7]);
#endif
    GRID_BAR();

#ifdef EXP_ONELAYER
    for (int l = 0; l < 1; ++l) {
#else
    for (int l = 0; l < DEPTH; ++l) {
#endif
        unsigned char* wl = ws + WS_W + (size_t)l * W_LAYER;
#if PH & 4
        if (l > 0) {
            norm_phase<1>(lds, vcu, G, H, H + (size_t)MP * D, args.in[4] + l * D, HN, GLOG, nullptr, args.in[5] + (size_t)l * D * IN_COLS, args.in[6] + l * 16 * 512, args.in[7] + l * 512);
            GRID_BAR();
        }
#endif
        for (int rep_ = 0; rep_ < REP_PROJ; ++rep_) {
#if PH & 8
        {
            pg8::Gemm g{HN, (const bf16*)(wl + W_IN), D, D}; pg8::Order S; S.init(M, NPJ, D, G, bx, 1);
            pg8::EpiProj E{PROJ, args.out + O_SGV + (size_t)l * MS * 512, H};
            pg8::gemm_phase<pg8::EpiProj>(lds, g, S, E);
        }
#endif
        GRID_BAR();
        }
        for (int rep_ = 0; rep_ < REP_MIX; ++rep_) {
        {
            const float* gn = args.in[8] + l * 256;
            if (vcu < 96) {
#if PH & 16
                const int nh = vcu / 3, js = vcu - 3 * nh;
                for (int q_ = 0; q_ < REP_P1; ++q_)
                gla_chunked<false>(lds, PROJ, GLOG, MIX, gn, (nh >> 2) * SEQ + js * (SEQ / 4), SEQ / 256, nh & 3, 0, nullptr, nullptr, SLOC + (size_t)(nh * 3 + js) * 128 * 256, DLOG + (nh * 3 + js) * 128);
#endif
            } else {
#if PH & 32
                const float* wmix = args.in[9] + (size_t)l * 4 * 128 * 128; const float* pscale = args.in[10] + l * 512;
                const float* wsp = args.in[11] + (size_t)l * 4 * 128 * 128; const float* bsp = args.in[12] + l * 4 * 128;
                const float* spool = args.in[3] + (size_t)l * SB * 15 * 512;
                for (int rl_ = 0; rl_ < REP_LIGHT; ++rl_) {
                const int j = vcu - 96, NJ = G - 96, g = j & 3, jj = j >> 2, NJJ = NJ >> 2;
                for (int q_ = 0; q_ < REP_GS; ++q_)
                for (int it = j; it < SB * 4; it += NJ) { const int n = it >> 2, h = it & 3; const size_t so = ((size_t)(l * SB + n) * 4 + h) * 128 * 256;
#ifndef SKIP_GS
                    gla_sample(lds, PROJ, GLOG, MIX, gn, MP + n * ST, h, args.in[2] + so, args.out + O_GLAS + so); }
#else
 }
#endif
                if (jj < 16) mat128_to_lds(lds, PL_W, PL_SW, wmix + (size_t)g * 128 * 128, false);
                for (int q_ = 0; q_ < REP_PL; ++q_)
                for (int tile = 256 + jj; tile < 256 + 16; tile += NJJ) {
                    const bool smp = tile >= 256; const int st = tile - 256;
                    const int row0 = smp ? MP + st * 64 : (tile >> 5) * SEQ + (tile & 31) * 64, pos0 = smp ? 0 : (tile & 31) * 64;
#ifndef SKIP_PL
                    if (g == 0) pool_tile<0>(lds, PROJ, MIX, pscale, spool, row0, pos0, smp, st * 8);
                    else if (g == 1) pool_tile<1>(lds, PROJ, MIX, pscale + 128, spool, row0, pos0, smp, st * 8);
                    else if (g == 2) pool_tile<2>(lds, PROJ, MIX, pscale + 256, spool, row0, pos0, smp, st * 8);
                    else pool_tile<3>(lds, PROJ, MIX, pscale + 384, spool, row0, pos0, smp, st * 8);
#endif
                }
                for (int q_ = 0; q_ < REP_SS; ++q_)
                for (int it = j; it < 512 + 136; it += NJ) {
                    int r = it;
                    if (r < 512) { const int g2 = r & 3, n = r >> 2; sg_item(lds, PROJ, MIX, wsp, bsp, MP + n * ST, ST, g2); continue; } r -= 512;
                    const int tid = opaque_tid();
                    if (r < NB) { const int n = r; float* o = args.out + O_POOLP + (size_t)(l * NB + n) * 15 * 512;
                        for (int idx = tid; idx < 15 * 512; idx += 512) { const int i = idx >> 9, c = idx & 511; o[idx] = bf2f(PROJ[(size_t)(n * SEQ + SEQ - 15 + i) * NPJ + C_XP + c]); } }
                    else { const int n = r - NB; float* o = args.out + O_POOLS + (size_t)(l * SB + n) * 15 * 512; const float* hs = spool + (size_t)n * 15 * 512;
                        for (int idx = tid; idx < 15 * 512; idx += 512) { const int i = idx >> 9, c = idx & 511; o[idx] = i < 7 ? hs[(size_t)(8 + i) * 512 + c] : bf2f(PROJ[(size_t)(MP + n * ST + i - 7) * NPJ + C_XP + c]); } }
                }
                }
#endif
            }
        }
        GRID_BAR();
#if PH & 16
        if (vcu < 128) {
            const int nh = vcu >> 2, js = vcu & 3;
            for (int q_ = 0; q_ < REP_P2; ++q_)
            gla_chunked<true>(lds, PROJ, GLOG, MIX, args.in[8] + l * 256, (nh >> 2) * SEQ + js * (SEQ / 4), SEQ / 256, nh & 3, js, SLOC + (size_t)nh * 3 * 128 * 256, DLOG + nh * 3 * 128,
                              js == 3 ? args.out + O_GLAP + ((size_t)(l * NB + (nh >> 2)) * 4 + (nh & 3)) * 128 * 256 : nullptr, nullptr);
#if PH & 32
            {
                const float* wmix = args.in[9] + (size_t)l * 4 * 128 * 128; const float* pscale = args.in[10] + l * 512;
                const int g = vcu & 3, jj = vcu >> 2;
                mat128_to_lds(lds, PL_W, PL_SW, wmix + (size_t)g * 128 * 128, false);
                for (int q_ = 0; q_ < REP_PL2; ++q_)
                for (int tile = jj; tile < 256; tile += 32) { const int row0 = (tile >> 5) * SEQ + (tile & 31) * 64, pos0 = (tile & 31) * 64;
                    if (g == 0) pool_tile<0>(lds, PROJ, MIX, pscale, nullptr, row0, pos0, false, 0);
                    else if (g == 1) pool_tile<1>(lds, PROJ, MIX, pscale + 128, nullptr, row0, pos0, false, 0);
                    else if (g == 2) pool_tile<2>(lds, PROJ, MIX, pscale + 256, nullptr, row0, pos0, false, 0);
                    else pool_tile<3>(lds, PROJ, MIX, pscale + 384, nullptr, row0, pos0, false, 0); }
            }
#endif
        }
#endif
#if PH & 32
        if (vcu >= 192) {
            const float* wsp = args.in[11] + (size_t)l * 4 * 128 * 128; const float* bsp = args.in[12] + l * 4 * 128;
            const int j = vcu - 192, g = j & 3, jj = j >> 2;
            mat128_to_lds(lds, SG_WT, SG_SW, wsp + (size_t)g * 128 * 128, true);
            for (int ch = jj; ch < 128; ch += 16) sg_chunk(lds, PROJ, MIX, bsp + g * 128, ch * 128, g);
        }
#endif
#if PH & 4096
        if (vcu >= 128 && vcu < 192) {
            const int c2 = vcu - 128;
#define BAR2() do { for (int qb_ = 0; qb_ < REP_BAR2; ++qb_) xcd_barrier(bar2); } while (0)
            if (c2 < 64) { pg8::Gemm g{MIX, (const bf16*)(wl + W_BR), MIXW, MIXW}; pg8::Order S; S.init(MS, D, MIXW, 64, c2, 3, MP / 256, 4);
                pg8::EpiBranch E{PROJ, HN, SLAB}; pg8::gemm_phase<pg8::EpiBranch>(lds, g, S, E); }
            BAR2();
            {   const int tid = opaque_tid();
#pragma unroll 4
                for (int idx = tid; idx < 16 * 256; idx += 512) { const int rr = c2 * 16 + (idx >> 8), c4 = (idx & 255) * 4;
                    f32x4 a = *(const f32x4*)(SLAB + (size_t)rr * D + c4);
#pragma unroll
                    for (int k = 1; k < 4; ++k) a = a + *(const f32x4*)(SLAB + ((size_t)k * MS + rr) * D + c4);
                    v2u o; o.x = pg8::cvt_pk_bf16(a.x, a.y); o.y = pg8::cvt_pk_bf16(a.z, a.w); *(v2u*)(HN + (size_t)(MP + rr) * D + c4) = o; } }
            BAR2();
            if (c2 < 64) { pg8::Gemm g{HN, (const bf16*)(wl + W_OUT), D, D}; pg8::Order S; S.init(MS, D, D, 64, c2, 1, MP / 256, 4);
                pg8::EpiSlab E{SLAB}; pg8::gemm_phase<pg8::EpiSlab>(lds, g, S, E); }
            BAR2();
            for (int half_ = 0; half_ < 2; ++half_)
            {   const int tid = opaque_tid(), lane = tid & 63, wave = __builtin_amdgcn_readfirstlane(tid >> 6), rr = c2 * 16 + half_ * 8 + wave;
                const float* bsrc = (l == 0 ? xs_in : H + (size_t)MP * D) + (size_t)rr * D; float* hrow = H + (size_t)(MP + rr) * D; const float* wn = args.in[17] + l * D;
                f32x4 v[4]; float ss = 0.f;
#pragma unroll
                for (int j = 0; j < 4; ++j) { const int c4 = 4 * lane + 256 * j; f32x4 a = *(const f32x4*)(bsrc + c4);
#pragma unroll
                    for (int k = 0; k < 4; ++k) a = a + *(const f32x4*)(SLAB + ((size_t)k * MS + rr) * D + c4);
                    v[j] = a; *(f32x4*)(hrow + c4) = a; ss += (a.x * a.x + a.y * a.y) + (a.z * a.z + a.w * a.w); }
                const float r = 1.0f / sqrtf(wave_sum(ss) * (1.0f / D) + EPS);
#pragma unroll
                for (int j = 0; j < 4; ++j) { const int c4 = 4 * lane + 256 * j; const f32x4 wv = *(const f32x4*)(wn + c4); const f32x4 y = v[j] * r * wv;
                    v2u o; o.x = pg8::cvt_pk_bf16(y.x, y.y); o.y = pg8::cvt_pk_bf16(y.z, y.w); *(v2u*)(HN + (size_t)(MP + rr) * D + c4) = o; } }
            BAR2();
            for (int q_ = 0; q_ < REP_CH4; ++q_)
            if (c2 < 64) { pg8::Gemm g{HN, (const bf16*)(wl + W_FF1), D, D}; pg8::Order S; S.init(MS, FF, D, 64, c2, 1, MP / 256);
                pg8::EpiRelu2 E{FFHS - (size_t)MP * FF}; pg8::gemm_phase<pg8::EpiRelu2>(lds, g, S, E); }
            BAR2();
            { pg8::Gemm g{FFHS - (size_t)MP * FF, (const bf16*)(wl + W_FF2), FF, FF}; pg8::Order S; S.init(MS, D, FF, 64, c2, 1, MP / 256, 4);
                pg8::EpiSlab E{SLAB}; pg8::gemm_phase<pg8::EpiSlab>(lds, g, S, E); }
            BAR2();
            {   const int tid = opaque_tid();
#pragma unroll 4
                for (int idx = tid; idx < 16 * 256; idx += 512) { const int rr = c2 * 16 + (idx >> 8), c4 = (idx & 255) * 4; float* hp_ = H + (size_t)(MP + rr) * D + c4;
                    f32x4 a = *(const f32x4*)hp_;
#pragma unroll
                    for (int k = 0; k < 4; ++k) a = a + *(const f32x4*)(SLAB + ((size_t)k * MS + rr) * D + c4);
                    *(f32x4*)hp_ = a; } }
#undef BAR2
        }
#endif
        GRID_BAR();
        }
#ifdef EXP_COPYGATES
        {   const int tid = opaque_tid();
            for (int row = vcu; row < M; row += G) for (int c = tid; c < 1024; c += 512) H[(size_t)row * D + c] = bf2f(PROJ[(size_t)row * NPJ + C_G + c]);
        }
        GRID_BAR();
#endif
        for (int rep_ = 0; rep_ < REP_BRANCH; ++rep_) {
#if PH & 64
        {
#ifdef EXP_PLAIN_BRANCH
            pg8::Gemm g{MIX, (const bf16*)(wl + W_BR), MIXW, MIXW}; pg8::Order S; S.init(M, D, MIXW, G, bx, 3);
            pg8::EpiPlain E{HN};
            pg8::gemm_phase<pg8::EpiPlain>(lds, g, S, E);
#else
            pg8::Gemm g{MIX, (const bf16*)(wl + W_BR), MIXW, MIXW}; pg8::Order S; S.init(MROWS, D, MIXW, G, bx, 3);
            pg8::EpiBranch E{PROJ, HN, nullptr};
            pg8::gemm_phase<pg8::EpiBranch>(lds, g, S, E);
#endif
        }
#endif
        GRID_BAR();
        }
#if PH & 128
        {
            pg8::Gemm g{HN, (const bf16*)(wl + W_OUT), D, D}; pg8::Order S; S.init(MROWS, D, D, G, bx, 1);
            pg8::EpiResid E{l == 0 ? xp_in : H, l == 0 ? xs_in : H + (size_t)MP * D, H};
            pg8::gemm_phase<pg8::EpiResid>(lds, g, S, E);
        }
#endif
        GRID_BAR();
        for (int rep_ = 0; rep_ < REP_NORM2; ++rep_) {
#if PH & 256
        norm_phase<0>(lds, vcu, G, H, H + (size_t)MP * D, args.in[17] + l * D, HN, nullptr, nullptr, nullptr, nullptr, nullptr, 0, MROWS);
#endif
        GRID_BAR();
        }
        for (int rep_ = 0; rep_ < REP_FFN1; ++rep_) {
#if PH & 512
        {
            pg8::Gemm g{HN, (const bf16*)(wl + W_FF1), D, D}; pg8::Order S; S.init(MROWS, FF, D, G, bx, 1);
            pg8::EpiRelu2 E{FFH};
            pg8::gemm_phase<pg8::EpiRelu2>(lds, g, S, E);
        }
#endif
        GRID_BAR();
        }
#if PH & 1024
        {
            pg8::Gemm g{FFH, (const bf16*)(wl + W_FF2), FF, FF}; pg8::Order S; S.init(MROWS, D, FF, G, bx, 1);
            pg8::EpiResid E{H, H + (size_t)MP * D, H};
            pg8::gemm_phase<pg8::EpiResid>(lds, g, S, E);
        }
#endif
        GRID_BAR();
    }
#if PH & 2048
    norm_phase<2>(lds, vcu, G, H, H + (size_t)MP * D, args.in[20], nullptr, nullptr, H, nullptr, nullptr, nullptr);
#endif
}

extern "C" void kernel_launch(void* const* d_in, const int* in_sizes, int n_in, void* d_out, int out_size, void* d_ws, size_t ws_size, hipStream_t stream) {
    static int grid = 0;
    if (grid == 0) {
        if (n_in != 21 || in_sizes[0] != MP * D || (size_t)out_size != O_END || ws_size < WS_END) {
            fprintf(stderr, "kernel_launch: unexpected shapes: n_in %d in0 %d out %d ws %zu (need %zu)\n", n_in, n_in > 0 ? in_sizes[0] : -1, out_size, ws_size, (size_t)WS_END); grid = -1; return; }
        int dev = 0, cus = 0, per_cu = 0;
        if (hipGetDevice(&dev) != hipSuccess || hipDeviceGetAttribute(&cus, hipDeviceAttributeMultiprocessorCount, dev) != hipSuccess) { grid = -1; return; }
        if (hipFuncSetAttribute((const void*)hybrid_fwd, hipFuncAttributeMaxDynamicSharedMemorySize, LDS_BYTES) != hipSuccess) { fprintf(stderr, "kernel_launch: hipFuncSetAttribute failed\n"); grid = -1; return; }
        if (hipOccupancyMaxActiveBlocksPerMultiprocessor(&per_cu, (const void*)hybrid_fwd, NWAVES * 64, LDS_BYTES) != hipSuccess || per_cu < 1) {
            fprintf(stderr, "kernel_launch: occupancy query reports %d blocks per CU\n", per_cu); (void)hipGetLastError(); grid = -1; return; }
        grid = cus;
    }
    if (grid < 0) return;
    if (hipMemsetAsync((char*)d_ws + WS_CTL, 0, CTL_ZERO_BYTES, stream) != hipSuccess) { fprintf(stderr, "kernel_launch: memset failed\n"); return; }
    Args a{};
    for (int i = 0; i < 21; ++i) a.in[i] = (const float*)d_in[i];
    a.out = (float*)d_out; a.ws = (unsigned char*)d_ws;
    void* kargs[] = {&a};
    hipError_t e = hipLaunchCooperativeKernel((const void*)hybrid_fwd, dim3(grid), dim3(NWAVES * 64), kargs, LDS_BYTES, stream);
    if (e != hipSuccess) fprintf(stderr, "kernel_launch: cooperative launch failed: %s (grid %d)\n", hipGetErrorString(e), grid);
}
```

```cpp
#include <hip/hip_runtime.h>
#include <hip/hip_cooperative_groups.h>
#include <cstdio>
#include <cstdint>
#ifndef REP_BAR2
#define REP_BAR2 1
#endif
#ifndef REP_CONV
#define REP_CONV 1
#endif
#ifndef REP_N1
#define REP_N1 1
#endif
#ifndef REP_PL2
#define REP_PL2 1
#endif
#ifndef REP_P1
#define REP_P1 1
#endif
#ifndef REP_GS
#define REP_GS 1
#endif
#ifndef REP_PL
#define REP_PL 1
#endif
#ifndef REP_SG
#define REP_SG 1
#endif
#ifndef REP_SS
#define REP_SS 1
#endif
#ifndef REP_P2
#define REP_P2 1
#endif
#ifndef REP_CH1
#define REP_CH1 1
#endif
#ifndef REP_CH4
#define REP_CH4 1
#endif
#ifndef REP_ATT
#define REP_ATT 1
#endif
#ifndef REP_OMM
#define REP_OMM 1
#endif
#ifndef REP_EPI
#define REP_EPI 1
#endif
#ifndef REP_GLAP
#define REP_GLAP 1
#endif
#ifndef REP_LIGHT
#define REP_LIGHT 1
#endif
#ifndef REP_PROJ
#define REP_PROJ 1
#endif
#ifndef REP_MIX
#define REP_MIX 1
#endif
#ifndef REP_BRANCH
#define REP_BRANCH 1
#endif
#ifndef REP_NORM2
#define REP_NORM2 1
#endif
#ifndef REP_FFN1
#define REP_FFN1 1
#endif

constexpr int D = 1024, NB = 8, SEQ = 2048, DEPTH = 2, SB = 128, ST = 8;
constexpr int MP = NB * SEQ;
constexpr int MS = SB * ST;
constexpr int M = MP + MS;
constexpr int IN_COLS = 7696;
constexpr int NPJ = 7680;
constexpr int FF = 4096;
constexpr float EPS = 1e-6f;
constexpr int C_Q = 0, C_K = 512, C_V = 1024, C_GO = 2048, C_XP = 3072, C_U = 3584, C_VV = 4096, C_G = 4608;
constexpr int MIXW = 2048;

constexpr size_t MiB = 1u << 20;
constexpr size_t WS_CTL = 0, CTL_ZERO_BYTES = 1 * MiB;
constexpr size_t WS_W = 2 * MiB;
constexpr size_t W_LAYER = 37 * MiB, W_IN = 0, W_BR = 15 * MiB, W_OUT = 19 * MiB, W_FF1 = 21 * MiB, W_FF2 = 29 * MiB;
constexpr size_t WS_HN = 76 * MiB;
constexpr size_t WS_GLOG = 110 * MiB;
constexpr size_t WS_MIX = 144 * MiB;
constexpr size_t WS_PROJ = 212 * MiB;
constexpr size_t WS_FFHS = 468 * MiB;
constexpr size_t WS_SLAB = 476 * MiB;
constexpr size_t WS_END = 508 * MiB;
static_assert(WS_PROJ + (size_t)M * NPJ * 2 <= WS_FFHS, "ws map");
static_assert(WS_MIX + (size_t)M * MIXW * 2 <= WS_PROJ, "ws map");
static_assert(WS_GLOG + (size_t)M * 512 * 4 <= WS_MIX, "ws map");
static_assert(WS_HN + (size_t)M * D * 2 <= WS_GLOG, "ws map");
static_assert(WS_W + 2 * W_LAYER <= WS_HN, "ws map");
constexpr int CW_BAR = 4096, CW_BAR2 = 8192, CW_BAR3 = 12288;
constexpr int POOL_EARLY = 112;

constexpr size_t O_Y = 0;
constexpr size_t O_GLAP = (size_t)M * D;
constexpr size_t O_GLAS = O_GLAP + (size_t)DEPTH * NB * 4 * 128 * 256;
constexpr size_t O_POOLP = O_GLAS + (size_t)DEPTH * SB * 4 * 128 * 256;
constexpr size_t O_POOLS = O_POOLP + (size_t)DEPTH * NB * 15 * 512;
constexpr size_t O_SGV = O_POOLS + (size_t)DEPTH * SB * 15 * 512;
constexpr size_t O_END = O_SGV + (size_t)DEPTH * SB * ST * 512;
static_assert(O_END == 56614912, "output size");

constexpr int RING_BYTES = 131072;
constexpr int LDSCTL_OFF = RING_BYTES, MISC_OFF = LDSCTL_OFF + 320;
constexpr int LDS_BYTES = 147456;
constexpr int NWAVES = 8;

#define GAS __attribute__((address_space(1)))
#define LAS __attribute__((address_space(3)))
typedef unsigned short bf16;
typedef unsigned v4u __attribute__((ext_vector_type(4)));
typedef unsigned v2u __attribute__((ext_vector_type(2)));
typedef float f32x4 __attribute__((ext_vector_type(4)));
typedef short bf16x8 __attribute__((ext_vector_type(8)));
typedef GAS unsigned gu32;
#define RLX_AGENT __ATOMIC_RELAXED, __HIP_MEMORY_SCOPE_AGENT
#define LDS_WAIT() asm volatile("s_waitcnt lgkmcnt(0)" ::: "memory")
#define LDS_BARRIER() do { asm volatile("s_waitcnt lgkmcnt(0)" ::: "memory"); __builtin_amdgcn_s_barrier(); asm volatile("" ::: "memory"); } while (0)

__device__ __forceinline__ unsigned f2bf(float f) { unsigned u = __builtin_bit_cast(unsigned, f); return (u + 0x7fffu + ((u >> 16) & 1u)) >> 16; }
__device__ __forceinline__ unsigned pk2(float lo, float hi) { return f2bf(lo) | (f2bf(hi) << 16); }
__device__ __forceinline__ float bf2f(unsigned short x) { return __builtin_bit_cast(float, (unsigned)x << 16); }
__device__ __forceinline__ float bflo(unsigned w) { return __builtin_bit_cast(float, w << 16); }
__device__ __forceinline__ float bfhi(unsigned w) { return __builtin_bit_cast(float, w & 0xffff0000u); }
__device__ __forceinline__ float sigmoid_f(float x) { return __builtin_amdgcn_rcpf(1.0f + __builtin_amdgcn_exp2f(-1.4426950409f * x)); }
__device__ __forceinline__ float gelu_tanh(float x) { const float z = 1.5957691216f * x * (1.0f + 0.044715f * x * x); return x * sigmoid_f(z); }
__device__ __forceinline__ int opaque_tid() { int t = threadIdx.x; asm volatile("" : "+v"(t)); return t; }
template <int CTRL> __device__ __forceinline__ float dpp_f(float v) { return __builtin_bit_cast(float, __builtin_amdgcn_update_dpp(0, __builtin_bit_cast(int, v), CTRL, 0xf, 0xf, false)); }
__device__ __forceinline__ float wave_sum(float v) {
    v += dpp_f<0xB1>(v);
    v += dpp_f<0x4E>(v);
    v += dpp_f<0x141>(v);
    v += dpp_f<0x140>(v);
    const int iv = __builtin_bit_cast(int, v);
    return (__builtin_bit_cast(float, __builtin_amdgcn_readlane(iv, 0)) + __builtin_bit_cast(float, __builtin_amdgcn_readlane(iv, 16)))
         + (__builtin_bit_cast(float, __builtin_amdgcn_readlane(iv, 32)) + __builtin_bit_cast(float, __builtin_amdgcn_readlane(iv, 48)));
}

namespace pg8 {
#define PG8_LAS __attribute__((address_space(3)))
typedef unsigned short bf16_t;
typedef unsigned u32x4 __attribute__((ext_vector_type(4)));
constexpr int BM = 256, BK = 64, HALF = 128, HTB = HALF * BK * 2, STAGE_BYTES = 8 * HTB, NXCD = 8, WGM = 8;

__host__ __device__ __forceinline__ int lds_byte(int r, int c) { const int st = (r >> 4) * 2 + (c >> 5), rr = r & 15, cc = c & 31, ob = rr * 64 + cc * 2; return st * 1024 + (ob ^ (((ob >> 9) & 1) << 5)); }
__host__ __device__ __forceinline__ void stage_rc(int b, int& R, int& C) { const int st = b / 1024, sb = b % 1024, swz = sb ^ (((sb >> 9) & 1) << 5); R = (st >> 1) * 16 + swz / 64; C = (st & 1) * 32 + (swz % 64) / 2; }
__host__ __device__ __forceinline__ int perm32(int rho) { const int n = rho >> 4, i = rho & 15; return 8 * (i >> 2) + 4 * n + (i & 3); }

struct Unit { int pm, pn, k0, nt, sub, keep, ks; };
struct Gemm { const bf16_t* A; const bf16_t* Bt; int lda, ldb; };

struct Order {
    int nM, nN, nwg, G, c, nsub, ntk, pm_off, ksplit;
    __device__ void init(int M_, int N_, int K_, int G_, int c_, int nsub_, int pm_off_ = 0, int ksplit_ = 1) { nM = M_ / BM; nN = N_ / BM; nwg = nM * nN; G = G_; c = c_; nsub = nsub_; ntk = K_ / BK; pm_off = pm_off_; ksplit = ksplit_; }
    __device__ bool next(int i, Unit& u) const {
        const int ti = i / nsub, sub = i - ti * nsub;
        long L = (long)ti * G + c; if (L >= (long)nwg * ksplit) return false;
        const int ksr = (int)(L % ksplit); L /= ksplit;
        int wgid = (int)L; { const int q = nwg / NXCD, r = nwg % NXCD, xcd = wgid % NXCD, off = wgid / NXCD; wgid = (xcd < r ? xcd * (q + 1) : r * (q + 1) + (xcd - r) * q) + off; }
        const int nig = WGM * nN, gid = wgid / nig, fm = gid * WGM, gsz = (nM - fm) < WGM ? (nM - fm) : WGM;
        u.pm = pm_off + fm + ((wgid % nig) % gsz); u.pn = (wgid % nig) / gsz; u.sub = sub; u.ks = ksr;
        if (nsub == 1) { u.nt = ntk / ksplit; u.k0 = ksr * u.nt * BK; u.keep = 0; }
        else { const int len = (sub == 0 ? 1024 : 512) / ksplit; u.k0 = (sub == 0 ? 0 : (sub == 1 ? 1024 : 1536)) + ksr * len; u.nt = len / BK; u.keep = sub < 2 ? 1 : 0; }
        return true;
    }
};

typedef __bf16 bf16x2_t __attribute__((ext_vector_type(2)));
typedef float f32x2_t __attribute__((ext_vector_type(2)));
__device__ __forceinline__ unsigned cvt_pk_bf16(float lo, float hi) { const f32x2_t v = {lo, hi}; const bf16x2_t b = __builtin_convertvector(v, bf16x2_t); return __builtin_bit_cast(unsigned, b); }

typedef f32x4 acc_t[2][2][4][2];

template <int ACT> __device__ __forceinline__ float act_f(float x) {
    if (ACT == 1) return x * 0.08838834764831845f;
    if (ACT == 2) return gelu_tanh(x);
    if (ACT == 3) return sigmoid_f(x);
    if (ACT == 4) { const float r = x > 0.f ? x : 0.f; return r * r; }
    return x;
}
template <int ACT> __device__ __forceinline__ void store_bf16_tile(const acc_t& acc, bf16_t* O, int ldc, int row0, int col0, float* sgv  , int sgcol0) {
#pragma unroll
    for (int ai = 0; ai < 2; ++ai)
#pragma unroll
        for (int m = 0; m < 4; ++m) { const int row = row0 + ai * HALF + m * 16; bf16_t* rowp = O + (size_t)row * ldc + col0;
#pragma unroll
            for (int bj = 0; bj < 2; ++bj) { f32x4 v0 = acc[ai][bj][m][0], v1 = acc[ai][bj][m][1];
#pragma unroll
                for (int j = 0; j < 4; ++j) { v0[j] = act_f<ACT>(v0[j]); v1[j] = act_f<ACT>(v1[j]); }
                u32x4 w; w.x = cvt_pk_bf16(v0[0], v0[1]); w.y = cvt_pk_bf16(v0[2], v0[3]); w.z = cvt_pk_bf16(v1[0], v1[1]); w.w = cvt_pk_bf16(v1[2], v1[3]);
                *(u32x4*)(rowp + bj * HALF) = w;
                if (ACT == 2 && sgv) { float* sp = sgv + (size_t)(row - MP) * 512 + sgcol0 + bj * HALF; *(f32x4*)sp = v0; *(f32x4*)(sp + 4) = v1; }
                if (ACT == 3 && sgv) { float* sp = sgv + (size_t)row * D + sgcol0 + bj * HALF; *(f32x4*)sp = v0; *(f32x4*)(sp + 4) = v1; } } }
}

struct EpiProj {
    static constexpr bool PERM = true;
    bf16_t* O; float* sgv; float* dbg;
    __device__ __forceinline__ void operator()(acc_t& acc, const Unit& u, int wr, int wc, int fr, int fq) const {
        const int row0 = u.pm * BM + wr * 64 + fr, col0 = u.pn * BM + wc * 32 + 8 * fq, pn = u.pn;
        if (pn < 2) store_bf16_tile<1>(acc, O, NPJ, row0, col0, nullptr, 0);
        else if (pn < 14) store_bf16_tile<0>(acc, O, NPJ, row0, col0, nullptr, 0);
        else if (pn < 18) store_bf16_tile<2>(acc, O, NPJ, row0, col0, (pn >= 16 && u.pm >= MP / BM) ? sgv : nullptr, col0 - C_VV);
#ifdef EXP_GATEOUT
        else store_bf16_tile<3>(acc, O, NPJ, row0, col0, (pn >= 26) ? dbg : nullptr, col0 - C_G - 2048);
#else
        else store_bf16_tile<3>(acc, O, NPJ, row0, col0, nullptr, 0);
#endif
    }
};
struct EpiPlain {
    static constexpr bool PERM = true;
    bf16_t* O;
    __device__ __forceinline__ void operator()(acc_t& acc, const Unit& u, int wr, int wc, int fr, int fq) const {
        if (u.keep) return;
        store_bf16_tile<0>(acc, O, D, u.pm * BM + wr * 64 + fr, u.pn * BM + wc * 32 + 8 * fq, nullptr, 0);
    }
};
struct EpiRelu2 {
    static constexpr bool PERM = true;
    bf16_t* O;
    __device__ __forceinline__ void operator()(acc_t& acc, const Unit& u, int wr, int wc, int fr, int fq) const {
        store_bf16_tile<4>(acc, O, FF, u.pm * BM + wr * 64 + fr, u.pn * BM + wc * 32 + 8 * fq, nullptr, 0);
    }
};
struct EpiBranch {
    static constexpr bool PERM = true;
    const bf16_t* P; bf16_t* O; float* slab;
    __device__ __forceinline__ void operator()(acc_t& acc, const Unit& u, int wr, int wc, int fr, int fq) const {
        const int row0 = u.pm * BM + wr * 64 + fr, col0 = u.pn * BM + wc * 32 + 8 * fq, sub = u.sub;
        const bool two = sub < 2;
        u32x4 ga[2], gb[2];
        { const bf16_t* gp = P + (size_t)row0 * NPJ + C_G + col0 + sub * 1024;
          ga[0] = *(const u32x4*)gp; ga[1] = *(const u32x4*)(gp + HALF);
          if (two) { gb[0] = *(const u32x4*)(gp + 1024); gb[1] = *(const u32x4*)(gp + 1024 + HALF); } else { gb[0] = ga[0]; gb[1] = ga[1]; } }
#pragma unroll
        for (int it = 0; it < 8; ++it) { const int ai = it >> 2, m = it & 3, row = row0 + ai * HALF + m * 16;
            u32x4 na[2], nb[2];
            if (it < 7) { const int nrow = row0 + ((it + 1) >> 2) * HALF + ((it + 1) & 3) * 16; const bf16_t* gp = P + (size_t)nrow * NPJ + C_G + col0 + sub * 1024;
                na[0] = *(const u32x4*)gp; na[1] = *(const u32x4*)(gp + HALF);
                if (two) { nb[0] = *(const u32x4*)(gp + 1024); nb[1] = *(const u32x4*)(gp + 1024 + HALF); } else { nb[0] = na[0]; nb[1] = na[1]; } }
            else { na[0] = ga[0]; na[1] = ga[1]; nb[0] = gb[0]; nb[1] = gb[1]; }
#pragma unroll
            for (int bj = 0; bj < 2; ++bj) {
                const u32x4 g1 = ga[bj], g2 = gb[bj];
                float f[8];
                f[0] = bflo(g1.x); f[1] = bfhi(g1.x); f[2] = bflo(g1.y); f[3] = bfhi(g1.y); f[4] = bflo(g1.z); f[5] = bfhi(g1.z); f[6] = bflo(g1.w); f[7] = bfhi(g1.w);
#pragma unroll
                for (int j = 0; j < 8; ++j) f[j] = f[j] > 1e-30f ? f[j] : 1e-30f;
                if (two) {
                    float d[8];
                    d[0] = bflo(g2.x); d[1] = bfhi(g2.x); d[2] = bflo(g2.y); d[3] = bfhi(g2.y); d[4] = bflo(g2.z); d[5] = bfhi(g2.z); d[6] = bflo(g2.w); d[7] = bfhi(g2.w);
#pragma unroll
                    for (int j = 0; j < 8; ++j) { d[j] = d[j] > 1e-30f ? d[j] : 1e-30f; f[j] = f[j] * __builtin_amdgcn_rcpf(d[j]); }
                }
                f32x4 v0 = acc[ai][bj][m][0], v1 = acc[ai][bj][m][1];
#pragma unroll
                for (int j = 0; j < 4; ++j) { v0[j] *= f[j]; v1[j] *= f[4 + j]; }
                acc[ai][bj][m][0] = v0; acc[ai][bj][m][1] = v1;
                if (sub == 2) {
                    if (slab) { float* sp = slab + ((size_t)u.ks * MS + (row - MP)) * D + col0 + bj * HALF; *(f32x4*)sp = v0; *(f32x4*)(sp + 4) = v1; }
                    else { u32x4 w; w.x = cvt_pk_bf16(v0[0], v0[1]); w.y = cvt_pk_bf16(v0[2], v0[3]); w.z = cvt_pk_bf16(v1[0], v1[1]); w.w = cvt_pk_bf16(v1[2], v1[3]);
                        *(u32x4*)(O + (size_t)row * D + col0 + bj * HALF) = w; } }
            }
            ga[0] = na[0]; ga[1] = na[1]; gb[0] = nb[0]; gb[1] = nb[1];
            asm volatile("" ::: "memory");
        }
    }
};
struct EpiResid {
    static constexpr bool PERM = false;
    const float* bp; const float* bs; float* out;
    __device__ __forceinline__ void operator()(acc_t& acc, const Unit& u, int wr, int wc, int fr, int fq) const {
        const int row0 = u.pm * BM + wr * 64 + fr, col0 = u.pn * BM + wc * 32 + 4 * fq;
        const bool smp = u.pm >= MP / BM;
#pragma unroll
        for (int ai = 0; ai < 2; ++ai)
#pragma unroll
            for (int m = 0; m < 4; ++m) { const int row = row0 + ai * HALF + m * 16;
                const float* b = smp ? bs + (size_t)(row - MP) * D + col0 : bp + (size_t)row * D + col0; float* o = out + (size_t)row * D + col0;
#pragma unroll
                for (int bj = 0; bj < 2; ++bj)
#pragma unroll
                    for (int n = 0; n < 2; ++n) { const f32x4 bv = *(const f32x4*)(b + bj * HALF + n * 16); *(f32x4*)(o + bj * HALF + n * 16) = bv + acc[ai][bj][m][n]; }
                if (m == 3) asm volatile("" ::: "memory"); }
    }
};

struct EpiSlab {
    static constexpr bool PERM = false;
    float* slab;
    __device__ __forceinline__ void operator()(acc_t& acc, const Unit& u, int wr, int wc, int fr, int fq) const {
        const int row0 = u.pm * BM + wr * 64 + fr - MP, col0 = u.pn * BM + wc * 32 + 4 * fq;
        float* base = slab + (size_t)u.ks * MS * D;
#pragma unroll
        for (int ai = 0; ai < 2; ++ai)
#pragma unroll
            for (int m = 0; m < 4; ++m) { float* o = base + (size_t)(row0 + ai * HALF + m * 16) * D + col0;
#pragma unroll
                for (int bj = 0; bj < 2; ++bj)
#pragma unroll
                    for (int n = 0; n < 2; ++n) *(f32x4*)(o + bj * HALF + n * 16) = acc[ai][bj][m][n]; }
    }
};

template <class Epi>
__device__ __forceinline__ void gemm_phase(PG8_LAS unsigned char* lds, const Gemm g, const Order& S, const Epi& E) {
    int tid_ = threadIdx.x; asm volatile("" : "+v"(tid_));
    const int tid = tid_, wid = __builtin_amdgcn_readfirstlane(tid >> 6), lane = tid & 63, wr = wid >> 2, wc = wid & 3, fr = lane & 15, fq = lane >> 4;
    unsigned voffA[2], voffB[2];
#pragma unroll
    for (int i = 0; i < 2; ++i) { int R, C; stage_rc(tid * 16 + i * 8192, R, C); const int Rb = Epi::PERM ? ((R & ~31) + perm32(R & 31)) : R;
        voffA[i] = (unsigned)(R * g.lda + C) * 2u; voffB[i] = (unsigned)(Rb * g.ldb + C) * 2u; }
    const size_t kstep = (size_t)(BK * 2);
    const size_t hstepA = (size_t)HALF * g.lda * 2, hstepB = (size_t)HALF * g.ldb * 2;
    const size_t tstepA = 2 * hstepA, tstepB = 2 * hstepB;
    const unsigned ldsw = (unsigned)wid * 1024u;
    const int aoff = lds_byte(wr * 64 + fr, fq * 8), boff = lds_byte(wc * 32 + fr, fq * 8);
#define PG8_SA(b, h) (((b) * 2 + (h)) * HTB)
#define PG8_SB(b, h) ((4 + (b) * 2 + (h)) * HTB)
#define PG8_STAGE(bufoff, gbase, voff) do { _Pragma("unroll") for (int _i = 0; _i < 2; ++_i) \
        __builtin_amdgcn_global_load_lds((const unsigned*)((const char*)(gbase) + (voff)[_i]), (PG8_LAS unsigned*)(lds + (bufoff) + ldsw + _i * 8192), 16, 0, 0); } while (0)
#define PG8_LDA(dst, b, h) do { _Pragma("unroll") for (int m = 0; m < 4; ++m) _Pragma("unroll") for (int k = 0; k < 2; ++k) dst[m][k] = *(const PG8_LAS bf16x8*)(lds + PG8_SA(b, h) + aoff + m * 2048 + k * 1024); } while (0)
#define PG8_LDB(dst, b, h) do { _Pragma("unroll") for (int n = 0; n < 2; ++n) _Pragma("unroll") for (int k = 0; k < 2; ++k) dst[n][k] = *(const PG8_LAS bf16x8*)(lds + PG8_SB(b, h) + boff + n * 2048 + k * 1024); } while (0)
#define PG8_MMA(ai, bj, At, Bt) do { __builtin_amdgcn_s_setprio(1); _Pragma("unroll") for (int m = 0; m < 4; ++m) _Pragma("unroll") for (int n = 0; n < 2; ++n) _Pragma("unroll") for (int k = 0; k < 2; ++k) \
        acc[ai][bj][m][n] = __builtin_amdgcn_mfma_f32_16x16x32_bf16(Bt[n][k], At[m][k], acc[ai][bj][m][n], 0, 0, 0); __builtin_amdgcn_s_setprio(0); } while (0)
#define PG8_WAIT_V(n) asm volatile("s_waitcnt vmcnt(" #n ")" ::: "memory")
#define PG8_WAIT_L(n) asm volatile("s_waitcnt lgkmcnt(" #n ")" ::: "memory")
#define PG8_BAR __builtin_amdgcn_s_barrier()
#define PG8_SCHED __builtin_amdgcn_sched_barrier(0)
    Unit cur, nxt; int ui = 0;
    if (!S.next(0, cur)) return;
    f32x4 acc[2][2][4][2];
#pragma unroll
    for (int a = 0; a < 2; ++a)
#pragma unroll
        for (int b = 0; b < 2; ++b)
#pragma unroll
            for (int m = 0; m < 4; ++m)
#pragma unroll
                for (int n = 0; n < 2; ++n) acc[a][b][m][n] = (f32x4){0.f, 0.f, 0.f, 0.f};
    bf16x8 At[4][2], B0[2][2], B1[2][2];
    const char* cA = (const char*)g.A + (size_t)cur.pm * tstepA + (size_t)cur.k0 * 2; const char* cB = (const char*)g.Bt + (size_t)cur.pn * tstepB + (size_t)cur.k0 * 2;
    PG8_STAGE(PG8_SB(0, 0), cB, voffB); PG8_STAGE(PG8_SB(0, 1), cB + hstepB, voffB); PG8_STAGE(PG8_SA(0, 0), cA, voffA); PG8_STAGE(PG8_SA(0, 1), cA + hstepA, voffA);
    if (wr == 1) PG8_BAR;
    PG8_WAIT_V(2); PG8_BAR;
    PG8_STAGE(PG8_SB(1, 0), cB + kstep, voffB); PG8_STAGE(PG8_SA(1, 0), cA + kstep, voffA); PG8_STAGE(PG8_SB(1, 1), cB + hstepB + kstep, voffB);
    PG8_WAIT_V(6); PG8_BAR;
    for (;;) {
        const bool has_next = S.next(ui + 1, nxt);
        const char* nA = has_next ? (const char*)g.A + (size_t)nxt.pm * tstepA + (size_t)nxt.k0 * 2 : cA; const char* nB = has_next ? (const char*)g.Bt + (size_t)nxt.pn * tstepB + (size_t)nxt.k0 * 2 : cB;
        const int nt = cur.nt;
        for (int t = 0; t < nt; t += 2) {
            const bool last = (t == nt - 2);
            const char* a1 = cA + (size_t)(t + 1) * kstep;
            const char* a2 = last ? nA : cA + (size_t)(t + 2) * kstep; const char* b2 = last ? nB : cB + (size_t)(t + 2) * kstep;
            const char* a3 = a2 + kstep; const char* b3 = b2 + kstep;
            PG8_LDB(B0, 0, 0); PG8_LDB(B1, 0, 1); PG8_SCHED; PG8_LDA(At, 0, 0); PG8_STAGE(PG8_SA(1, 1), a1 + hstepA, voffA);
            PG8_WAIT_V(8); PG8_WAIT_L(0); PG8_BAR; PG8_MMA(0, 0, At, B0); PG8_MMA(0, 1, At, B1); PG8_BAR; PG8_SCHED;
            PG8_LDA(At, 0, 1); PG8_STAGE(PG8_SB(0, 0), b2, voffB); PG8_STAGE(PG8_SB(0, 1), b2 + hstepB, voffB); PG8_STAGE(PG8_SA(0, 0), a2, voffA);
            PG8_WAIT_V(8); PG8_WAIT_L(0); PG8_BAR; PG8_MMA(1, 0, At, B0); PG8_MMA(1, 1, At, B1); PG8_BAR; PG8_SCHED;
            PG8_LDB(B0, 1, 0); PG8_LDB(B1, 1, 1); PG8_SCHED; PG8_LDA(At, 1, 0); PG8_STAGE(PG8_SA(0, 1), a2 + hstepA, voffA);
            PG8_WAIT_V(8); PG8_WAIT_L(0); PG8_BAR; PG8_MMA(0, 0, At, B0); PG8_MMA(0, 1, At, B1); PG8_BAR; PG8_SCHED;
            PG8_LDA(At, 1, 1); PG8_STAGE(PG8_SB(1, 0), b3, voffB); PG8_STAGE(PG8_SB(1, 1), b3 + hstepB, voffB); PG8_STAGE(PG8_SA(1, 0), a3, voffA);
            PG8_WAIT_V(8); PG8_WAIT_L(0); PG8_BAR; PG8_MMA(1, 0, At, B0); PG8_MMA(1, 1, At, B1); PG8_BAR; PG8_SCHED;
        }
        if (wr == 0) PG8_BAR;
        E(acc, cur, wr, wc, fr, fq);
        if (!has_next) break;
        if (!cur.keep) {
#pragma unroll
            for (int a = 0; a < 2; ++a)
#pragma unroll
                for (int b = 0; b < 2; ++b)
#pragma unroll
                    for (int m = 0; m < 4; ++m)
#pragma unroll
                        for (int n = 0; n < 2; ++n) acc[a][b][m][n] = (f32x4){0.f, 0.f, 0.f, 0.f};
        }
        cur = nxt; cA = nA; cB = nB; ++ui;
        if (wr == 1) PG8_BAR;
    }
    PG8_WAIT_V(0);
    PG8_BAR;
#undef PG8_SA
#undef PG8_SB
#undef PG8_STAGE
#undef PG8_LDA
#undef PG8_LDB
#undef PG8_MMA
#undef PG8_WAIT_V
#undef PG8_WAIT_L
#undef PG8_BAR
#undef PG8_SCHED
}
}

#define XB_TMO      128
#define XB_XCNT(j)  (256  + 64 * (j))
#define XB_XSUB(j)  (1280 + 64 * (j))
#define XB_XGEN(j)  (2304 + 64 * (j))
#define XB_TOP      3328
#define XB_TOPGEN   3392
#define XCD_BAR_WORDS 3456
#define XB_SPIN_CAP (1u << 20)

__device__ __forceinline__ unsigned xb_ld(unsigned* p)              { return __hip_atomic_load(p, __ATOMIC_RELAXED, __HIP_MEMORY_SCOPE_AGENT); }
__device__ __forceinline__ unsigned xb_add(unsigned* p, unsigned v) { return __hip_atomic_fetch_add(p, v, __ATOMIC_RELAXED, __HIP_MEMORY_SCOPE_AGENT); }
__device__ __forceinline__ unsigned xb_xcc_id() { return (unsigned)__builtin_amdgcn_s_getreg((3 << 11) | 20) & 0xFu; }
#define XB_SPIN(cond, bar) do { unsigned _sp = 0; while (cond) { __builtin_amdgcn_s_sleep(1); \
    if ((++_sp & 255u) == 0u) { if (xb_ld(&(bar)[XB_TMO])) break; if (_sp > XB_SPIN_CAP) { atomicAdd(&(bar)[XB_TMO], 1u); break; } } } } while (0)

struct XcdBarrier { unsigned* bar; unsigned x; volatile LAS unsigned* st; unsigned np; };

__device__ __forceinline__ XcdBarrier xcd_barrier_post(unsigned* bar, volatile LAS unsigned* st, unsigned np, bool member) {
    XcdBarrier b; b.bar = bar; b.x = 0; b.st = st; b.np = np;
    if (member && threadIdx.x == 0) (void)xb_add(&bar[XB_XCNT(xb_xcc_id())], 1u);
    return b;
}
__device__ __forceinline__ void xcd_barrier_complete(unsigned* bar, unsigned x, unsigned G, unsigned& nloc, unsigned& nx) {
    unsigned sum, cnt, mine, sp = 0u;
    for (;;) {
        sum = 0u; cnt = 0u; mine = 0u;
#pragma unroll
        for (unsigned j = 0; j < 16; ++j) { const unsigned c = xb_ld(&bar[XB_XCNT(j)]); sum += c; cnt += (c > 0u) ? 1u : 0u; mine = (j == x) ? c : mine; }
        if (sum == G) break;
        __builtin_amdgcn_s_sleep(1);
        if ((++sp & 255u) == 0u) { if (xb_ld(&bar[XB_TMO])) break; if (sp > XB_SPIN_CAP) { atomicAdd(&bar[XB_TMO], 1u); break; } }
    }
    nloc = mine > 0u ? mine : 1u; nx = cnt > 0u ? cnt : 1u;
}
__device__ __forceinline__ void xcd_barrier(const XcdBarrier& b) {
    asm volatile("s_waitcnt vmcnt(0)" ::: "memory");
    __syncthreads();
    if (threadIdx.x == 0) {
        unsigned* bar = b.bar;
        unsigned xo = 0; asm volatile("s_mov_b32 %0, 0" : "=s"(xo));
        bar += xo;
        const unsigned bx_ = xb_xcc_id();
        __builtin_amdgcn_s_waitcnt(0);
        unsigned nloc = b.st[0], nx = b.st[1];
        if (nloc == 0u) { xcd_barrier_complete(bar, bx_, b.np, nloc, nx); b.st[0] = nloc; b.st[1] = nx; }
        const unsigned old = xb_add(&bar[XB_XSUB(bx_)], 1u);
        const unsigned gen = old / nloc;
        if (old + 1u == (gen + 1u) * nloc) {
            __builtin_amdgcn_fence(__ATOMIC_RELEASE, "agent");
            asm volatile("s_waitcnt vmcnt(0)" ::: "memory");
            const unsigned og = xb_add(&bar[XB_TOP], 1u);
            const unsigned tg = og / nx;
            if (og + 1u == (tg + 1u) * nx) xb_add(&bar[XB_TOPGEN], 1u);
            else XB_SPIN(xb_ld(&bar[XB_TOPGEN]) == tg, bar);
            __builtin_amdgcn_fence(__ATOMIC_ACQUIRE, "agent");
            xb_add(&bar[XB_XGEN(bx_)], 1u);
            asm volatile("s_waitcnt vmcnt(0)" ::: "memory");
        } else {
            XB_SPIN(xb_ld(&bar[XB_XGEN(bx_)]) == gen, bar);
            __builtin_amdgcn_fence(__ATOMIC_ACQUIRE, "agent");
            asm volatile("s_waitcnt vmcnt(0)" ::: "memory");
        }
    }
    __syncthreads();
}

struct Args {
    const float* in[21];
    float* out; unsigned char* ws;
};

__device__ __forceinline__ void transpose_item(const float* W, int ldw, int ncols, bf16* WT, int ldd, int row_off, int col_off, LAS float* scr, int item, int lane) {
    const int nblk = ncols / 32, kb = item / nblk, nb = item % nblk, k0 = 64 * kb, n0 = 32 * nb;
#pragma unroll 8
    for (int i = 0; i < 32; ++i) { const int kk = 2 * i + (lane >> 5); scr[kk * 33 + (lane & 31)] = W[(size_t)(k0 + kk) * ldw + n0 + (lane & 31)]; }
    LDS_WAIT(); asm volatile("" ::: "memory");
    const int c = lane & 7;
#pragma unroll
    for (int j = 0; j < 4; ++j) { const int n = (lane >> 3) + 8 * j; const LAS float* s = scr + (8 * c) * 33 + n;
        v4u o; o.x = pk2(s[0 * 33], s[1 * 33]); o.y = pk2(s[2 * 33], s[3 * 33]); o.z = pk2(s[4 * 33], s[5 * 33]); o.w = pk2(s[6 * 33], s[7 * 33]);
        *(GAS v4u*)(WT + (size_t)(row_off + n0 + n) * ldd + col_off + k0 + 8 * c) = o; }
    LDS_WAIT(); asm volatile("" ::: "memory");
}

__device__ __forceinline__ void convert_weights(const Args& a, LAS unsigned char* lds, int vcu, int G) {
    const int tid = opaque_tid(), lane = tid & 63, wave = __builtin_amdgcn_readfirstlane(tid >> 6), gw = vcu * NWAVES + wave, NGW = G * NWAVES;
    LAS float* scr = (LAS float*)(lds + wave * 16384);
    constexpr int I_IN1 = 16 * 96, I_IN2 = 16 * 144, I_BA = 16 * 32, I_BB = 8 * 32, I_BC = 8 * 32, I_O = 16 * 32, I_F1 = 16 * 128, I_F2 = 64 * 32;
    constexpr int PER_LAYER = I_IN1 + I_IN2 + I_BA + I_BB + I_BC + I_O + I_F1 + I_F2;
    for (int it = gw; it < 2 * PER_LAYER; it += NGW) {
        const int l = it / PER_LAYER; int r = it - l * PER_LAYER;
        unsigned char* wl = a.ws + WS_W + (size_t)l * W_LAYER;
        const float* w_in = a.in[5] + (size_t)l * D * IN_COLS;
        if (r < I_IN1) { transpose_item(w_in, IN_COLS, 3072, (bf16*)(wl + W_IN), D, 0, 0, scr, r, lane); continue; } r -= I_IN1;
        if (r < I_IN2) { transpose_item(w_in + 3088, IN_COLS, 4608, (bf16*)(wl + W_IN), D, 3072, 0, scr, r, lane); continue; } r -= I_IN2;
        if (r < I_BA) { transpose_item(a.in[13] + (size_t)l * 1024 * 1024, 1024, 1024, (bf16*)(wl + W_BR), 2048, 0, 0, scr, r, lane); continue; } r -= I_BA;
        if (r < I_BB) { transpose_item(a.in[14] + (size_t)l * 512 * 1024, 1024, 1024, (bf16*)(wl + W_BR), 2048, 0, 1024, scr, r, lane); continue; } r -= I_BB;
        if (r < I_BC) { transpose_item(a.in[15] + (size_t)l * 512 * 1024, 1024, 1024, (bf16*)(wl + W_BR), 2048, 0, 1536, scr, r, lane); continue; } r -= I_BC;
        if (r < I_O) { transpose_item(a.in[16] + (size_t)l * 1024 * 1024, 1024, 1024, (bf16*)(wl + W_OUT), 1024, 0, 0, scr, r, lane); continue; } r -= I_O;
        if (r < I_F1) { transpose_item(a.in[18] + (size_t)l * 1024 * FF, FF, FF, (bf16*)(wl + W_FF1), 1024, 0, 0, scr, r, lane); continue; } r -= I_F1;
        transpose_item(a.in[19] + (size_t)l * FF * 1024, 1024, 1024, (bf16*)(wl + W_FF2), FF, 0, 0, scr, r, lane);
    }
}

template <int MODE>
__device__ __forceinline__ void norm_phase(LAS unsigned char* lds, int vcu, int G,
                                           const float* hp, const float* hs, const float* w, bf16* HN, float* GLOG, float* outf,
                                           const float* w_in_l, const float* w_gk2_l, const float* b_gk_l, int mlo = 0, int mhi = M) {
    const int tid = opaque_tid(), lane = tid & 63, wave = __builtin_amdgcn_readfirstlane(tid >> 6), gw = vcu * NWAVES + wave, NGW = G * NWAVES;
    LAS float* Wg = (LAS float*)lds;
    LAS float* Wk = Wg + 16 * 1024;
    if (MODE == 1) {
        for (int idx = tid; idx < 16 * 1024; idx += 512) { const int k = idx >> 4, c = idx & 15; Wg[c * 1024 + k] = w_in_l[(size_t)k * IN_COLS + 3072 + c]; }
        for (int idx = tid; idx < 16 * 512; idx += 512) Wk[idx] = w_gk2_l[idx];
        __syncthreads();
    }
    f32x4 wv[4];
#pragma unroll
    for (int j = 0; j < 4; ++j) wv[j] = *(const f32x4*)(w + 4 * lane + 256 * j);
    f32x4 nv[4];
    { const int m0 = mlo + gw;
      if (m0 < mhi) { const float* xr = (m0 < MP) ? hp + (size_t)m0 * D : hs + (size_t)(m0 - MP) * D;
#pragma unroll
          for (int j = 0; j < 4; ++j) nv[j] = *(const f32x4*)(xr + 4 * lane + 256 * j); } }
    for (int m = mlo + gw; m < mhi; m += NGW) {
        f32x4 v[4]; float ss = 0.f;
#pragma unroll
        for (int j = 0; j < 4; ++j) v[j] = nv[j];
        { const int mn = m + NGW;
          if (mn < mhi) { const float* xn = (mn < MP) ? hp + (size_t)mn * D : hs + (size_t)(mn - MP) * D;
#pragma unroll
              for (int j = 0; j < 4; ++j) nv[j] = *(const f32x4*)(xn + 4 * lane + 256 * j); } }
#pragma unroll
        for (int j = 0; j < 4; ++j) ss += (v[j].x * v[j].x + v[j].y * v[j].y) + (v[j].z * v[j].z + v[j].w * v[j].w);
        const float r = 1.0f / sqrtf(wave_sum(ss) * (1.0f / D) + EPS);
#pragma unroll
        for (int j = 0; j < 4; ++j) v[j] = v[j] * r * wv[j];
        if (MODE == 2) {
#pragma unroll
            for (int j = 0; j < 4; ++j) *(f32x4*)(outf + (size_t)m * D + 4 * lane + 256 * j) = v[j];
        } else {
#pragma unroll
            for (int j = 0; j < 4; ++j) { v2u o; o.x = pk2(v[j].x, v[j].y); o.y = pk2(v[j].z, v[j].w); *(v2u*)(HN + (size_t)m * D + 4 * lane + 256 * j) = o; }
        }
        if (MODE == 1) {
            float gl[16];
#pragma unroll
            for (int c = 0; c < 16; ++c) { float p = 0.f;
#pragma unroll
                for (int j = 0; j < 4; ++j) { const f32x4 wg = *(const LAS f32x4*)(Wg + c * 1024 + 4 * lane + 256 * j); p += (v[j].x * wg.x + v[j].y * wg.y) + (v[j].z * wg.z + v[j].w * wg.w); }
                gl[c] = wave_sum(p); if ((c & 3) == 3) asm volatile("" ::: "memory"); }
#pragma unroll
            for (int hb = 0; hb < 2; ++hb) { const int d0 = 4 * lane + 256 * hb;
                f32x4 acc = *(const f32x4*)(b_gk_l + d0);
#pragma unroll
                for (int c = 0; c < 16; ++c) { const f32x4 wk = *(const LAS f32x4*)(Wk + c * 512 + d0); acc = acc + wk * gl[c]; }
                f32x4 o;
#pragma unroll
                for (int i = 0; i < 4; ++i) { const float x = acc[i]; const float ls = (x < 0.f ? x : 0.f) - __logf(1.0f + __expf(-fabsf(x))); o[i] = ls * (1.0f / 16.0f); }
                *(f32x4*)(GLOG + (size_t)m * 512 + d0) = o; }
        }
    }
    if (MODE == 1) __syncthreads();
}

__device__ __forceinline__ void gla_seq(LAS unsigned char* lds, const bf16* PROJ, const float* GLOG, bf16* MIXOUT, const float* gn,
                                        int row0, int T, int h, const float* S0, float* Sout) {
    const int tid = opaque_tid(), lane = tid & 63, wave = __builtin_amdgcn_readfirstlane(tid >> 6);
    LAS float* qs = (LAS float*)lds;
    LAS float* ks = qs + 16 * 128;
    LAS float* as = ks + 16 * 128;
    LAS float* op = as + 16 * 128;
    const int e = tid & 255, dh = __builtin_amdgcn_readfirstlane(tid >> 8);
    float S[64];
#pragma unroll
    for (int i = 0; i < 64; ++i) S[i] = S0 ? S0[(size_t)(dh * 64 + i) * 256 + e] : 0.f;
    const int TB = T < 16 ? T : 16;
    for (int t0 = 0; t0 < T; t0 += TB) {
        __syncthreads();
        for (int idx = tid; idx < TB * 128; idx += 512) { const int t = idx >> 7, d = idx & 127; const size_t row = (size_t)(row0 + t0 + t);
            qs[idx] = bf2f(PROJ[row * NPJ + C_Q + h * 128 + d]); ks[idx] = bf2f(PROJ[row * NPJ + C_K + h * 128 + d]); as[idx] = __expf(GLOG[row * 512 + h * 128 + d]); }
        __syncthreads();
        for (int t = 0; t < TB; ++t) {
            const float v = bf2f(PROJ[(size_t)(row0 + t0 + t) * NPJ + C_V + h * 256 + e]);
            const LAS float* qp = qs + t * 128 + dh * 64; const LAS float* kp = ks + t * 128 + dh * 64; const LAS float* ap = as + t * 128 + dh * 64;
            float o = 0.f;
#pragma unroll
            for (int i4 = 0; i4 < 16; ++i4) { const f32x4 q4 = *(const LAS f32x4*)(qp + 4 * i4), k4 = *(const LAS f32x4*)(kp + 4 * i4), a4 = *(const LAS f32x4*)(ap + 4 * i4);
#pragma unroll
                for (int j = 0; j < 4; ++j) { const int i = 4 * i4 + j; S[i] = a4[j] * S[i] + k4[j] * v; o += q4[j] * S[i]; } }
            op[(t * 2 + dh) * 256 + e] = o;
        }
        __syncthreads();
#pragma unroll
        for (int tt = 0; tt < 2; ++tt) { const int t = wave * 2 + tt;
            if (t < TB) { const int e4 = lane * 4; const size_t row = (size_t)(row0 + t0 + t);
                const f32x4 o = *(const LAS f32x4*)(op + (t * 2) * 256 + e4) + *(const LAS f32x4*)(op + (t * 2 + 1) * 256 + e4);
                const float ss = wave_sum((o.x * o.x + o.y * o.y) + (o.z * o.z + o.w * o.w));
                const float r = 1.0f / sqrtf(ss * (1.0f / 256.0f) + EPS);
                const v2u gw2 = *(const v2u*)(PROJ + row * NPJ + C_GO + h * 256 + e4);
                const f32x4 g4 = *(const f32x4*)(gn + e4);
                const float g0 = bflo(gw2.x), g1 = bfhi(gw2.x), g2 = bflo(gw2.y), g3 = bfhi(gw2.y);
                v2u ow; ow.x = pk2(o.x * r * g4.x * (g0 * sigmoid_f(g0)), o.y * r * g4.y * (g1 * sigmoid_f(g1))); ow.y = pk2(o.z * r * g4.z * (g2 * sigmoid_f(g2)), o.w * r * g4.w * (g3 * sigmoid_f(g3)));
                *(v2u*)(MIXOUT + row * MIXW + h * 256 + e4) = ow; } }
    }
#pragma unroll
    for (int i = 0; i < 64; ++i) Sout[(size_t)(dh * 64 + i) * 256 + e] = S[i];
    __syncthreads();
}

typedef float f32x16 __attribute__((ext_vector_type(16)));
typedef short s16x4 __attribute__((ext_vector_type(4)));
#define MFMA32(a, b, c) __builtin_amdgcn_mfma_f32_32x32x16_bf16((a), (b), (c), 0, 0, 0)
constexpr int GL_QG = 0, GL_KG = 17408, GL_KD = 34816, GL_VV = 55296, GL_PP = 92160, GL_DEC = 101376, GL_TOT = 101888, GL_END = 110080;
constexpr int GL_SQ = 272, GL_SKD = 320, GL_SV = 576, GL_SP = 144, GL_SO = 1040;
static_assert(GL_END <= RING_BYTES && 64 * GL_SO <= GL_PP, "gla lds map");
__device__ __forceinline__ bf16x8 tr_frag(LAS unsigned char* p, int rowstride4) {
    const s16x4 lo = __builtin_amdgcn_ds_read_tr16_b64_v4i16((LAS s16x4*)p), hi = __builtin_amdgcn_ds_read_tr16_b64_v4i16((LAS s16x4*)(p + rowstride4));
    return __builtin_shufflevector(lo, hi, 0, 1, 2, 3, 4, 5, 6, 7);
}
template <bool FULL>
__device__ __forceinline__ void gla_chunked(LAS unsigned char* lds, const bf16* PROJ, const float* GLOG, bf16* MIXOUT, const float* gn, int row0, int nchunks, int h,
                                            int nprev, const float* Sloc_prev, const float* Dlog_prev, float* Sout, float* Dlog_out) {
    const int tid = opaque_tid(), lane = tid & 63, w = __builtin_amdgcn_readfirstlane(tid >> 6), r = lane & 31, hh = lane >> 5;
    const int tq = (lane & 15) >> 2, tp = lane & 3, tblk = (lane >> 4) & 1;
    const int dq = tid & 31, seg = tid >> 5;
    f32x16 S[4];
#pragma unroll
    for (int b = 0; b < 4; ++b)
#pragma unroll
        for (int i = 0; i < 16; ++i) S[b][i] = 0.f;
    for (int pi = 0; pi < nprev; ++pi) {
        int lo_ = 4 * hh * 256 + 32 * w + r; asm volatile("" : "+v"(lo_));
        const float* sp = Sloc_prev + (size_t)pi * 128 * 256 + lo_; const float* dp = Dlog_prev + pi * 128 + 4 * hh;
#pragma unroll
        for (int b = 0; b < 4; ++b) {
#pragma unroll
            for (int i = 0; i < 16; ++i) { const int dr = 32 * b + (i & 3) + 8 * (i >> 2); S[b][i] = __expf(dp[dr]) * S[b][i] + sp[dr * 256]; }
            asm volatile("" ::: "memory"); }
    }
    f32x4 dsum = (f32x4){0.f, 0.f, 0.f, 0.f};
    f32x4 gr[4]; v2u qv[4], kv[4]; v4u vv[4];
#define GLA_LOAD_RAW(R0) do { _Pragma("unroll") for (int i = 0; i < 4; ++i) { gr[i] = *(const f32x4*)(GLOG + (size_t)((R0) + 4 * seg + i) * 512 + h * 128 + 4 * dq); \
        const bf16* pr = PROJ + (size_t)((R0) + 4 * seg + i) * NPJ + h * 128 + 4 * dq; qv[i] = *(const v2u*)(pr + C_Q); kv[i] = *(const v2u*)(pr + C_K); } } while (0)
#define GLA_LOAD_V(R0) do { _Pragma("unroll") for (int i = 0; i < 4; ++i) { \
        const int idx = tid + 512 * i, sr = idx >> 5, ch = idx & 31; vv[i] = *(const v4u*)(PROJ + (size_t)((R0) + sr) * NPJ + C_V + h * 256 + ch * 8); } } while (0)
    GLA_LOAD_RAW(row0); GLA_LOAD_V(row0);
    for (int c = 0; c < nchunks; ++c) {
        const int r0 = row0 + 64 * c;
        {
            f32x4 cs[4];
#pragma unroll
            for (int i = 0; i < 4; ++i) { cs[i] = gr[i]; if (i) cs[i] = cs[i] + cs[i - 1]; }
            *(LAS f32x4*)(lds + GL_TOT + (seg * 128 + 4 * dq) * 4) = cs[3];
            LDS_BARRIER();
            f32x4 pre = (f32x4){0.f, 0.f, 0.f, 0.f}, tot = (f32x4){0.f, 0.f, 0.f, 0.f};
#pragma unroll
            for (int s2 = 0; s2 < 16; ++s2) { const f32x4 tv = *(const LAS f32x4*)(lds + GL_TOT + (s2 * 128 + 4 * dq) * 4); tot = tot + tv; if (s2 < seg) pre = pre + tv; }
#pragma unroll
            for (int i = 0; i < 4; ++i) { const f32x4 b = pre + cs[i]; const int t = 4 * seg + i;
                float q4[4] = {bflo(qv[i].x), bfhi(qv[i].x), bflo(qv[i].y), bfhi(qv[i].y)}, k4[4] = {bflo(kv[i].x), bfhi(kv[i].x), bflo(kv[i].y), bfhi(kv[i].y)};
                float qg[4], kg[4], kd[4];
#pragma unroll
                for (int j = 0; j < 4; ++j) { qg[j] = q4[j] * __expf(b[j]); kg[j] = k4[j] * __expf(-b[j]); kd[j] = k4[j] * __expf(tot[j] - b[j]); }
                v2u o;
                if (FULL) { o.x = pg8::cvt_pk_bf16(qg[0], qg[1]); o.y = pg8::cvt_pk_bf16(qg[2], qg[3]); *(LAS v2u*)(lds + GL_QG + t * GL_SQ + dq * 8) = o;
                            o.x = pg8::cvt_pk_bf16(kg[0], kg[1]); o.y = pg8::cvt_pk_bf16(kg[2], kg[3]); *(LAS v2u*)(lds + GL_KG + t * GL_SQ + dq * 8) = o; }
                o.x = pg8::cvt_pk_bf16(kd[0], kd[1]); o.y = pg8::cvt_pk_bf16(kd[2], kd[3]); *(LAS v2u*)(lds + GL_KD + t * GL_SKD + dq * 8) = o; }
            dsum = dsum + tot;
            if (seg == 0) { f32x4 dc; dc.x = __expf(tot.x); dc.y = __expf(tot.y); dc.z = __expf(tot.z); dc.w = __expf(tot.w); *(LAS f32x4*)(lds + GL_DEC + dq * 16) = dc; }
#pragma unroll
            for (int i = 0; i < 4; ++i) { const int idx = tid + 512 * i, sr = idx >> 5, ch = idx & 31; *(LAS v4u*)(lds + GL_VV + sr * GL_SV + ch * 16) = vv[i]; }
            if (c + 1 < nchunks) GLA_LOAD_RAW(r0 + 64);
        }
        LDS_BARRIER();
        for (int qa_ = 0; qa_ < REP_ATT; ++qa_) {
        if (FULL && w < 3) {
            const int bi = w > 0 ? 1 : 0, bj = w > 1 ? 1 : 0;
            f32x16 acc;
#pragma unroll
            for (int i = 0; i < 16; ++i) acc[i] = 0.f;
#pragma unroll
            for (int ks = 0; ks < 8; ++ks) {
                const bf16x8 a = *(const LAS bf16x8*)(lds + GL_QG + (32 * bi + r) * GL_SQ + (16 * ks + 8 * hh) * 2);
                const bf16x8 b = *(const LAS bf16x8*)(lds + GL_KG + (32 * bj + r) * GL_SQ + (16 * ks + 8 * hh) * 2);
                acc = MFMA32(a, b, acc); }
            int pbase = GL_PP + (32 * bi + 4 * hh) * GL_SP + (32 * bj + r) * 2; asm volatile("" : "+v"(pbase));
#pragma unroll
            for (int i = 0; i < 16; ++i) { const int tl = (i & 3) + 8 * (i >> 2) + 4 * hh; float v = acc[i]; if (bi == bj && r > tl) v = 0.f;
                *(LAS unsigned short*)(lds + pbase + ((i & 3) + 8 * (i >> 2)) * GL_SP) = (unsigned short)f2bf(v); }
        }
        if (FULL) LDS_BARRIER();
        }
        f32x16 o[2];
        {
            bf16x8 Bv[4];
#pragma unroll
            for (int ks = 0; ks < 4; ++ks) Bv[ks] = tr_frag(lds + GL_VV + (16 * ks + 8 * hh + tq) * GL_SV + (4 * w + 2 * tblk + (tp >> 1)) * 16 + 8 * (tp & 1), 4 * GL_SV);
            for (int qm_ = 0; qm_ < REP_OMM; ++qm_)
#pragma unroll
            for (int rb = 0; rb < (FULL ? 2 : 0); ++rb) {
#pragma unroll
                for (int i = 0; i < 16; ++i) o[rb][i] = 0.f;
#pragma unroll
                for (int b = 0; b < 4; ++b)
#pragma unroll
                    for (int s2 = 0; s2 < 2; ++s2) {
                        const LAS unsigned char* ap = lds + GL_QG + (32 * rb + r) * GL_SQ + (32 * b + 16 * s2 + 4 * hh) * 2;
                        const s16x4 lo = *(const LAS s16x4*)ap, hi = *(const LAS s16x4*)(ap + 16);
                        const bf16x8 a = __builtin_shufflevector(lo, hi, 0, 1, 2, 3, 4, 5, 6, 7);
                        v4u pk; pk.x = pg8::cvt_pk_bf16(S[b][8 * s2 + 0], S[b][8 * s2 + 1]); pk.y = pg8::cvt_pk_bf16(S[b][8 * s2 + 2], S[b][8 * s2 + 3]);
                        pk.z = pg8::cvt_pk_bf16(S[b][8 * s2 + 4], S[b][8 * s2 + 5]); pk.w = pg8::cvt_pk_bf16(S[b][8 * s2 + 6], S[b][8 * s2 + 7]);
                        o[rb] = MFMA32(a, __builtin_bit_cast(bf16x8, pk), o[rb]); if (s2) asm volatile("" ::: "memory"); }
#pragma unroll
                for (int ks = 0; ks < 4; ++ks) if (ks < 2 || rb == 1) {
                    const bf16x8 a = *(const LAS bf16x8*)(lds + GL_PP + (32 * rb + r) * GL_SP + (16 * ks + 8 * hh) * 2);
                    o[rb] = MFMA32(a, Bv[ks], o[rb]); }
            }
#pragma unroll
            for (int b = 0; b < 4; ++b) {
#pragma unroll
                for (int g4 = 0; g4 < 4; ++g4) { const f32x4 dc = *(const LAS f32x4*)(lds + GL_DEC + (32 * b + 8 * g4 + 4 * hh) * 4);
#pragma unroll
                    for (int j = 0; j < 4; ++j) S[b][4 * g4 + j] *= dc[j]; }
#pragma unroll
                for (int ks = 0; ks < 4; ++ks) {
                    const bf16x8 a = tr_frag(lds + GL_KD + (16 * ks + 8 * hh + tq) * GL_SKD + (4 * b + 2 * tblk + (tp >> 1)) * 16 + 8 * (tp & 1), 4 * GL_SKD);
                    S[b] = MFMA32(a, Bv[ks], S[b]); }
                asm volatile("" ::: "memory");
            }
        }
        LDS_BARRIER();
        if (!FULL) { if (c + 1 < nchunks) GLA_LOAD_V(r0 + 64); }
        if (FULL) for (int qe_ = 0; qe_ < REP_EPI; ++qe_) {
        v4u gpre[4];
#pragma unroll
        for (int i = 0; i < 4; ++i) gpre[i] = *(const v4u*)(PROJ + (size_t)(r0 + (tid >> 3)) * NPJ + C_GO + h * 256 + (tid & 7) * 32 + 8 * i);
        int obase = 4 * hh * GL_SO + (32 * w + r) * 4; asm volatile("" : "+v"(obase));
#pragma unroll
        for (int rb = 0; rb < 2; ++rb)
#pragma unroll
            for (int i = 0; i < 16; ++i) *(LAS float*)(lds + obase + (32 * rb + (i & 3) + 8 * (i >> 2)) * GL_SO) = o[rb][i];
        if (c + 1 < nchunks) GLA_LOAD_V(r0 + 64);
        LDS_BARRIER();
        {
            const int t = tid >> 3, sg = tid & 7, e0 = sg * 32; const size_t row = (size_t)(r0 + t);
            int e0g = e0; asm volatile("" : "+v"(e0g));
            f32x4 ov[8]; float ss = 0.f;
#pragma unroll
            for (int i = 0; i < 8; ++i) { ov[i] = *(const LAS f32x4*)(lds + t * GL_SO + (e0 + 4 * i) * 4); ss += (ov[i].x * ov[i].x + ov[i].y * ov[i].y) + (ov[i].z * ov[i].z + ov[i].w * ov[i].w); }
            ss += __shfl_xor(ss, 1); ss += __shfl_xor(ss, 2); ss += __shfl_xor(ss, 4);
            const float rn = 1.0f / sqrtf(ss * (1.0f / 256.0f) + EPS);
#pragma unroll
            for (int i = 0; i < 4; ++i) { const v4u gw4 = gpre[i];
                const f32x4 ga = *(const f32x4*)(gn + e0g + 8 * i), gb = *(const f32x4*)(gn + e0g + 8 * i + 4);
                const float g0 = bflo(gw4.x), g1 = bfhi(gw4.x), g2 = bflo(gw4.y), g3 = bfhi(gw4.y), g4 = bflo(gw4.z), g5 = bfhi(gw4.z), g6 = bflo(gw4.w), g7 = bfhi(gw4.w);
                const f32x4 oa = ov[2 * i], ob = ov[2 * i + 1]; v4u ow;
                ow.x = pg8::cvt_pk_bf16(oa.x * rn * ga.x * (g0 * sigmoid_f(g0)), oa.y * rn * ga.y * (g1 * sigmoid_f(g1)));
                ow.y = pg8::cvt_pk_bf16(oa.z * rn * ga.z * (g2 * sigmoid_f(g2)), oa.w * rn * ga.w * (g3 * sigmoid_f(g3)));
                ow.z = pg8::cvt_pk_bf16(ob.x * rn * gb.x * (g4 * sigmoid_f(g4)), ob.y * rn * gb.y * (g5 * sigmoid_f(g5)));
                ow.w = pg8::cvt_pk_bf16(ob.z * rn * gb.z * (g6 * sigmoid_f(g6)), ob.w * rn * gb.w * (g7 * sigmoid_f(g7)));
                *(v4u*)(MIXOUT + row * MIXW + h * 256 + e0 + 8 * i) = ow; }
        }
        LDS_BARRIER();
        }
    }
    if (Sout) {
        int lo_ = 4 * hh * 256 + 32 * w + r; asm volatile("" : "+v"(lo_)); float* sop = Sout + lo_;
#pragma unroll
        for (int b = 0; b < 4; ++b) {
#pragma unroll
            for (int i = 0; i < 16; ++i) sop[(32 * b + (i & 3) + 8 * (i >> 2)) * 256] = S[b][i];
            asm volatile("" ::: "memory"); }
    }
    if (Dlog_out && seg == 0) *(f32x4*)(Dlog_out + 4 * dq) = dsum;
#undef GLA_LOAD_RAW
#undef GLA_LOAD_V
}

__device__ __forceinline__ void gla_sample(LAS unsigned char* lds, const bf16* PROJ, const float* GLOG, bf16* MIXOUT, const float* gn, int r0, int h, const float* S0, float* Sout) {
    const int tid = opaque_tid(), lane = tid & 63, w = __builtin_amdgcn_readfirstlane(tid >> 6), r = lane & 31, hh = lane >> 5;
    const int tq = (lane & 15) >> 2, tp = lane & 3, tblk = (lane >> 4) & 1;
    int lane_off = 4 * hh * 256 + 32 * w + r; asm volatile("" : "+v"(lane_off));
    const float* s0p = S0 + lane_off; float* sop = Sout + lane_off;
    f32x16 S[4];
#pragma unroll
    for (int b = 0; b < 4; ++b) {
#pragma unroll
        for (int i = 0; i < 16; ++i) S[b][i] = s0p[(32 * b + (i & 3) + 8 * (i >> 2)) * 256];
        asm volatile("" ::: "memory"); }
    if (tid < 32) {
        const int dq = tid; f32x4 b = (f32x4){0.f, 0.f, 0.f, 0.f}, bs[8];
#pragma unroll
        for (int t = 0; t < 8; ++t) { b = b + *(const f32x4*)(GLOG + (size_t)(r0 + t) * 512 + h * 128 + 4 * dq); bs[t] = b; }
#pragma unroll
        for (int t = 0; t < 8; ++t) { const bf16* pr = PROJ + (size_t)(r0 + t) * NPJ + h * 128 + 4 * dq; const v2u qv = *(const v2u*)(pr + C_Q), kv = *(const v2u*)(pr + C_K);
            const float q4[4] = {bflo(qv.x), bfhi(qv.x), bflo(qv.y), bfhi(qv.y)}, k4[4] = {bflo(kv.x), bfhi(kv.x), bflo(kv.y), bfhi(kv.y)};
            float qg[4], kg[4], kd[4];
#pragma unroll
            for (int j = 0; j < 4; ++j) { qg[j] = q4[j] * __expf(bs[t][j]); kg[j] = k4[j] * __expf(-bs[t][j]); kd[j] = k4[j] * __expf(b[j] - bs[t][j]); }
            v2u o; o.x = pg8::cvt_pk_bf16(qg[0], qg[1]); o.y = pg8::cvt_pk_bf16(qg[2], qg[3]); *(LAS v2u*)(lds + GL_QG + t * GL_SQ + dq * 8) = o;
            o.x = pg8::cvt_pk_bf16(kg[0], kg[1]); o.y = pg8::cvt_pk_bf16(kg[2], kg[3]); *(LAS v2u*)(lds + GL_KG + t * GL_SQ + dq * 8) = o;
            o.x = pg8::cvt_pk_bf16(kd[0], kd[1]); o.y = pg8::cvt_pk_bf16(kd[2], kd[3]); *(LAS v2u*)(lds + GL_KD + t * GL_SKD + dq * 8) = o; }
        f32x4 dc; dc.x = __expf(b.x); dc.y = __expf(b.y); dc.z = __expf(b.z); dc.w = __expf(b.w); *(LAS f32x4*)(lds + GL_DEC + dq * 16) = dc;
    } else if (tid >= 256) {
        const int idx = tid - 256, sr = idx >> 5, ch = idx & 31;
        *(LAS v4u*)(lds + GL_VV + sr * GL_SV + ch * 16) = *(const v4u*)(PROJ + (size_t)(r0 + sr) * NPJ + C_V + h * 256 + ch * 8);
    } else if (tid >= 64) {
        const v4u z = (v4u){0u, 0u, 0u, 0u};
        for (int idx = tid - 64; idx < 256 + 128; idx += 192) {
            if (idx < 256) *(LAS v4u*)(lds + GL_VV + (8 + (idx >> 5)) * GL_SV + (idx & 31) * 16) = z;
            else { const int k2 = idx - 256; *(LAS v4u*)(lds + GL_KD + (8 + (k2 >> 4)) * GL_SKD + (k2 & 15) * 16) = z; } }
    }
    LDS_BARRIER();
    if (w == 0) {
        f32x16 acc;
#pragma unroll
        for (int i = 0; i < 16; ++i) acc[i] = 0.f;
#pragma unroll
        for (int ks = 0; ks < 8; ++ks) {
            const bf16x8 a = *(const LAS bf16x8*)(lds + GL_QG + r * GL_SQ + (16 * ks + 8 * hh) * 2);
            const bf16x8 b = *(const LAS bf16x8*)(lds + GL_KG + r * GL_SQ + (16 * ks + 8 * hh) * 2);
            acc = MFMA32(a, b, acc); }
#pragma unroll
        for (int i = 0; i < 16; ++i) { const int tl = (i & 3) + 8 * (i >> 2) + 4 * hh; float v = acc[i]; if (r > tl || tl >= 8) v = 0.f;
            if (r < 16) *(LAS unsigned short*)(lds + GL_PP + tl * GL_SP + r * 2) = (unsigned short)f2bf(v); }
    }
    LDS_BARRIER();
    f32x16 o;
    {
        const bf16x8 Bv = tr_frag(lds + GL_VV + (8 * hh + tq) * GL_SV + (4 * w + 2 * tblk + (tp >> 1)) * 16 + 8 * (tp & 1), 4 * GL_SV);
#pragma unroll
        for (int i = 0; i < 16; ++i) o[i] = 0.f;
#pragma unroll
        for (int b = 0; b < 4; ++b)
#pragma unroll
            for (int s2 = 0; s2 < 2; ++s2) {
                const LAS unsigned char* ap = lds + GL_QG + r * GL_SQ + (32 * b + 16 * s2 + 4 * hh) * 2;
                const s16x4 lo = *(const LAS s16x4*)ap, hi = *(const LAS s16x4*)(ap + 16);
                const bf16x8 a = __builtin_shufflevector(lo, hi, 0, 1, 2, 3, 4, 5, 6, 7);
                v4u pk; pk.x = pg8::cvt_pk_bf16(S[b][8 * s2 + 0], S[b][8 * s2 + 1]); pk.y = pg8::cvt_pk_bf16(S[b][8 * s2 + 2], S[b][8 * s2 + 3]);
                pk.z = pg8::cvt_pk_bf16(S[b][8 * s2 + 4], S[b][8 * s2 + 5]); pk.w = pg8::cvt_pk_bf16(S[b][8 * s2 + 6], S[b][8 * s2 + 7]);
                o = MFMA32(a, __builtin_bit_cast(bf16x8, pk), o); }
        { const bf16x8 a = *(const LAS bf16x8*)(lds + GL_PP + r * GL_SP + (8 * hh) * 2); o = MFMA32(a, Bv, o); }
#pragma unroll
        for (int b = 0; b < 4; ++b) {
#pragma unroll
            for (int g4 = 0; g4 < 4; ++g4) { const f32x4 dc = *(const LAS f32x4*)(lds + GL_DEC + (32 * b + 8 * g4 + 4 * hh) * 4);
#pragma unroll
                for (int j = 0; j < 4; ++j) S[b][4 * g4 + j] *= dc[j]; }
            const bf16x8 a = tr_frag(lds + GL_KD + (8 * hh + tq) * GL_SKD + (4 * b + 2 * tblk + (tp >> 1)) * 16 + 8 * (tp & 1), 4 * GL_SKD);
            S[b] = MFMA32(a, Bv, S[b]); }
    }
    LDS_BARRIER();
#pragma unroll
    for (int i = 0; i < 4; ++i) *(LAS float*)(lds + (i + 4 * hh) * GL_SO + (32 * w + r) * 4) = o[i];
    LDS_BARRIER();
    if (tid < 64) {
        const int t = tid >> 3, sg = tid & 7, e0 = sg * 32; const size_t row = (size_t)(r0 + t);
        f32x4 ov[8]; float ss = 0.f;
#pragma unroll
        for (int i = 0; i < 8; ++i) { ov[i] = *(const LAS f32x4*)(lds + t * GL_SO + (e0 + 4 * i) * 4); ss += (ov[i].x * ov[i].x + ov[i].y * ov[i].y) + (ov[i].z * ov[i].z + ov[i].w * ov[i].w); }
        ss += __shfl_xor(ss, 1); ss += __shfl_xor(ss, 2); ss += __shfl_xor(ss, 4);
        const float rn = 1.0f / sqrtf(ss * (1.0f / 256.0f) + EPS);
#pragma unroll
        for (int i = 0; i < 4; ++i) { const v4u gw4 = *(const v4u*)(PROJ + row * NPJ + C_GO + h * 256 + e0 + 8 * i);
            const f32x4 ga = *(const f32x4*)(gn + e0 + 8 * i), gb = *(const f32x4*)(gn + e0 + 8 * i + 4);
            const float g0 = bflo(gw4.x), g1 = bfhi(gw4.x), g2 = bflo(gw4.y), g3 = bfhi(gw4.y), g4 = bflo(gw4.z), g5 = bfhi(gw4.z), g6 = bflo(gw4.w), g7 = bfhi(gw4.w);
            const f32x4 oa = ov[2 * i], ob = ov[2 * i + 1]; v4u ow;
            ow.x = pg8::cvt_pk_bf16(oa.x * rn * ga.x * (g0 * sigmoid_f(g0)), oa.y * rn * ga.y * (g1 * sigmoid_f(g1)));
            ow.y = pg8::cvt_pk_bf16(oa.z * rn * ga.z * (g2 * sigmoid_f(g2)), oa.w * rn * ga.w * (g3 * sigmoid_f(g3)));
            ow.z = pg8::cvt_pk_bf16(ob.x * rn * gb.x * (g4 * sigmoid_f(g4)), ob.y * rn * gb.y * (g5 * sigmoid_f(g5)));
            ow.w = pg8::cvt_pk_bf16(ob.z * rn * gb.z * (g6 * sigmoid_f(g6)), ob.w * rn * gb.w * (g7 * sigmoid_f(g7)));
            *(v4u*)(MIXOUT + row * MIXW + h * 256 + e0 + 8 * i) = ow; }
    }
#pragma unroll
    for (int b = 0; b < 4; ++b) {
#pragma unroll
        for (int i = 0; i < 16; ++i) sop[(32 * b + (i & 3) + 8 * (i >> 2)) * 256] = S[b][i];
        asm volatile("" ::: "memory"); }
    LDS_BARRIER();
}

constexpr int PL_W = 0, PL_A = 40960, PL_SW = 320, PL_SA = 272, PL_X = 58368  , PL_O = 78592  ;
__device__ __forceinline__ void mat128_to_lds(LAS unsigned char* lds, int off, int stride, const float* src, bool tril) {
    const int tid = opaque_tid();
#pragma unroll
    for (int i = 0; i < 8; ++i) { const int idx = tid + 512 * i, row = idx >> 5, c4 = idx & 31; f32x4 v = *(const f32x4*)(src + row * 128 + 4 * c4);
        if (tril) { if (4 * c4 + 0 > row) v.x = 0.f; if (4 * c4 + 1 > row) v.y = 0.f; if (4 * c4 + 2 > row) v.z = 0.f; if (4 * c4 + 3 > row) v.w = 0.f; }
        v2u o; o.x = pg8::cvt_pk_bf16(v.x, v.y); o.y = pg8::cvt_pk_bf16(v.z, v.w); *(LAS v2u*)(lds + off + row * stride + c4 * 8) = o; }
}
template <int G>
__device__ __forceinline__ void pool_tile(LAS unsigned char* lds, const bf16* PROJ, bf16* MIXOUT, const float* scale_g, const float* hist_l, int row0, int pos0, bool sample, int seq0) {
    const int tid = opaque_tid(), lane = tid & 63, w = __builtin_amdgcn_readfirstlane(tid >> 6), r = lane & 31, hh = lane >> 5;
    const int tq = (lane & 15) >> 2, tp = lane & 3, tblk = (lane >> 4) & 1;
    const int c = tid & 127, tqr = tid >> 7, col = C_XP + G * 128 + c;
    constexpr int WIN = 2 << G;
    if (!sample) {
#pragma unroll
        for (int i = 0; i < 3; ++i) { const int idx = tid + 512 * i, rr = idx >> 4, ch = idx & 15;
            if (rr < 79) { const int p = pos0 - 15 + rr; v4u xv = (v4u){0u, 0u, 0u, 0u};
                if (p >= 0) xv = *(const v4u*)(PROJ + (size_t)(row0 - pos0 + p) * NPJ + C_XP + G * 128 + ch * 8);
                *(LAS v4u*)(lds + PL_X + rr * 256 + ch * 16) = xv; } }
        LDS_BARRIER();
        float P[32]; P[0] = 0.f; float xs[31];
#pragma unroll
        for (int i = 0; i < 31; ++i) { xs[i] = bf2f(*(const LAS unsigned short*)(lds + PL_X + (16 * tqr + i) * 256 + c * 2)); P[i + 1] = P[i] + xs[i]; }
#pragma unroll
        for (int tt = 0; tt < 16; ++tt) { const int pos = pos0 + 16 * tqr + tt; const int cnt = WIN < pos + 1 ? WIN : pos + 1;
            const float pooled = (P[16 + tt] - P[16 + tt - WIN]) / (float)cnt - xs[15 + tt];
            *(LAS unsigned short*)(lds + PL_A + (16 * tqr + tt) * PL_SA + c * 2) = (unsigned short)f2bf(pooled); }
    } else {
#pragma unroll
        for (int sq = 0; sq < 2; ++sq) { const int seq = seq0 + 2 * tqr + sq;
            float P[24]; P[0] = 0.f; float xs[23];
#pragma unroll
            for (int i = 0; i < 23; ++i) { xs[i] = i < 15 ? hist_l[((size_t)seq * 15 + i) * 512 + G * 128 + c] : bf2f(PROJ[(size_t)(MP + seq * ST + i - 15) * NPJ + col]); P[i + 1] = P[i] + xs[i]; }
#pragma unroll
            for (int tt = 0; tt < 8; ++tt) { const float pooled = (P[16 + tt] - P[16 + tt - WIN]) * (1.0f / (float)WIN) - xs[15 + tt];
                *(LAS unsigned short*)(lds + PL_A + (16 * tqr + 8 * sq + tt) * PL_SA + c * 2) = (unsigned short)f2bf(pooled); } }
    }
    LDS_BARRIER();
    {
        const int rb = w & 1, cb = w >> 1; f32x16 acc;
#pragma unroll
        for (int i = 0; i < 16; ++i) acc[i] = 0.f;
#pragma unroll
        for (int ks = 0; ks < 8; ++ks) {
            const bf16x8 a = *(const LAS bf16x8*)(lds + PL_A + (32 * rb + r) * PL_SA + (16 * ks + 8 * hh) * 2);
            const bf16x8 b = tr_frag(lds + PL_W + (16 * ks + 8 * hh + tq) * PL_SW + (4 * cb + 2 * tblk + (tp >> 1)) * 16 + 8 * (tp & 1), 4 * PL_SW);
            acc = MFMA32(a, b, acc); }
        const float sc = scale_g[32 * cb + r];
        int obase = PL_O + (32 * rb + 4 * hh) * PL_SA + (32 * cb + r) * 2; asm volatile("" : "+v"(obase));
#pragma unroll
        for (int i = 0; i < 16; ++i) *(LAS unsigned short*)(lds + obase + ((i & 3) + 8 * (i >> 2)) * PL_SA) = (unsigned short)f2bf(acc[i] * sc);
    }
    LDS_BARRIER();
#pragma unroll
    for (int i = 0; i < 2; ++i) { const int idx = tid + 512 * i, t = idx >> 4, ch = idx & 15;
        *(v4u*)(MIXOUT + (size_t)(row0 + t) * MIXW + 1024 + G * 128 + ch * 8) = *(const LAS v4u*)(lds + PL_O + t * PL_SA + ch * 16); }
    LDS_BARRIER();
}
constexpr int SG_WT = 0, SG_VI = 34816, SG_SW = 272, SG_SV = 320;
__device__ __forceinline__ void sg_chunk(LAS unsigned char* lds, const bf16* PROJ, bf16* MIXOUT, const float* bs_g, int row0, int g) {
    const int tid = opaque_tid(), lane = tid & 63, w = __builtin_amdgcn_readfirstlane(tid >> 6), r = lane & 31, hh = lane >> 5;
    const int tq = (lane & 15) >> 2, tp = lane & 3, tblk = (lane >> 4) & 1;
#pragma unroll
    for (int i = 0; i < 4; ++i) { const int idx = tid + 512 * i, sr = idx >> 4, ch = idx & 15;
        *(LAS v4u*)(lds + SG_VI + sr * SG_SV + ch * 16) = *(const v4u*)(PROJ + (size_t)(row0 + sr) * NPJ + C_VV + g * 128 + ch * 8); }
    LDS_BARRIER();
    const int dj = w & 3, pair = w >> 2;
#pragma unroll
    for (int pass = 0; pass < 2; ++pass) {
        const int bi = pass == 0 ? pair : 3 - pair, nks = 2 * (bi + 1);
        f32x16 acc;
#pragma unroll
        for (int i = 0; i < 16; ++i) acc[i] = 0.f;
#pragma unroll
        for (int ks = 0; ks < 8; ++ks) if (ks < nks) {
            const bf16x8 a = *(const LAS bf16x8*)(lds + SG_WT + (32 * bi + r) * SG_SW + (16 * ks + 8 * hh) * 2);
            const bf16x8 b = tr_frag(lds + SG_VI + (16 * ks + 8 * hh + tq) * SG_SV + (4 * dj + 2 * tblk + (tp >> 1)) * 16 + 8 * (tp & 1), 4 * SG_SV);
            acc = MFMA32(a, b, acc); }
#pragma unroll
        for (int i = 0; i < 16; ++i) { const int t = 32 * bi + (i & 3) + 8 * (i >> 2) + 4 * hh, d = 32 * dj + r;
            const float u = bf2f(PROJ[(size_t)(row0 + t) * NPJ + C_U + g * 128 + d]);
            MIXOUT[(size_t)(row0 + t) * MIXW + 1536 + g * 128 + d] = (bf16)f2bf(u * (acc[i] + bs_g[t])); }
    }
    LDS_BARRIER();
}

__device__ __forceinline__ void pool_item(LAS unsigned char* lds, const bf16* PROJ, bf16* MIXOUT, const float* wmix, const float* scale, const float* hist  ,
                                          int rowseq0, int tpos0, int nt, int g) {
    const int tid = opaque_tid();
    LAS float* pl = (LAS float*)lds;
    const int w = 2 << g;
    for (int idx = tid; idx < nt * 128; idx += 512) { const int t = idx >> 7, c = idx & 127, pos = tpos0 + t, col = C_XP + g * 128 + c;
        float sum = 0.f;
        for (int i = 0; i < w; ++i) { const int p = pos - i;
            if (p >= 0) sum += bf2f(PROJ[(size_t)(rowseq0 + p) * NPJ + col]);
            else if (hist) sum += hist[(size_t)(15 + p) * 512 + g * 128 + c]; }
        const int cnt = hist ? w : (w < pos + 1 ? w : pos + 1);
        pl[idx] = sum / (float)cnt - bf2f(PROJ[(size_t)(rowseq0 + pos) * NPJ + col]); }
    __syncthreads();
    const int j = tid & 127, tq = __builtin_amdgcn_readfirstlane(tid >> 7), tpq = nt >> 2;
    float acc[4] = {0.f, 0.f, 0.f, 0.f};
    for (int c = 0; c < 128; ++c) { const float wv = wmix[(size_t)(g * 128 + c) * 128 + j];
#pragma unroll
        for (int i = 0; i < 4; ++i) if (i < tpq) acc[i] += pl[(tq * tpq + i) * 128 + c] * wv; }
    const float sc = scale[g * 128 + j];
#pragma unroll
    for (int i = 0; i < 4; ++i) if (i < tpq) MIXOUT[(size_t)(rowseq0 + tpos0 + tq * tpq + i) * MIXW + 1024 + g * 128 + j] = (bf16)f2bf(acc[i] * sc);
    __syncthreads();
}

__device__ __forceinline__ void sg_item(LAS unsigned char* lds, const bf16* PROJ, bf16* MIXOUT, const float* ws, const float* bs, int row0, int L, int g) {
    const int tid = opaque_tid();
    LAS float* vt = (LAS float*)lds;
    LAS float* wt = vt + 128 * 128;
    for (int idx = tid; idx < L * 128; idx += 512) { const int s = idx >> 7, d = idx & 127;
        vt[idx] = bf2f(PROJ[(size_t)(row0 + s) * NPJ + C_VV + g * 128 + d]);
        wt[idx] = ws[(size_t)(g * 128 + s) * 128 + d]; }
    __syncthreads();
    const int d = tid & 127, tq = __builtin_amdgcn_readfirstlane(tid >> 7);
    for (int t = tq; t < L; t += 4) { float acc = 0.f;
        for (int s = 0; s <= t; ++s) acc += wt[t * 128 + s] * vt[s * 128 + d];
        const float u = bf2f(PROJ[(size_t)(row0 + t) * NPJ + C_U + g * 128 + d]);
        MIXOUT[(size_t)(row0 + t) * MIXW + 1536 + g * 128 + d] = (bf16)f2bf(u * (acc + bs[g * 128 + t])); }
    __syncthreads();
}


#ifndef PH
#define PH 0xFFFF
#endif
#if PH & 4096
#define MROWS MP
#else
#define MROWS M
#endif
__global__ void __launch_bounds__(NWAVES * 64, 2) hybrid_fwd(Args args) {
    extern __shared__ __attribute__((aligned(16))) unsigned char lds_raw[];
    LAS unsigned char* lds = (LAS unsigned char*)lds_raw;
    volatile LAS unsigned* MISC = (volatile LAS unsigned*)(lds + MISC_OFF);
    const int G = gridDim.x, bx = blockIdx.x, vcu = (G % 8 == 0) ? (bx % 8) * (G / 8) + bx / 8 : bx;
    unsigned char* ws = args.ws;
    gu32* ctl = (gu32*)(ws + WS_CTL);
    for (int u = threadIdx.x; u < (LDS_BYTES - LDSCTL_OFF) / 4; u += NWAVES * 64) ((LAS unsigned*)(lds + LDSCTL_OFF))[u] = 0u;
    __syncthreads();
    XcdBarrier bar = xcd_barrier_post((unsigned*)(ctl + CW_BAR), MISC + 8, (unsigned)G, true);
    XcdBarrier bar3 = xcd_barrier_post((unsigned*)(ctl + CW_BAR3), MISC + 12, 128u, vcu < 128);
    XcdBarrier bar2 = xcd_barrier_post((unsigned*)(ctl + CW_BAR2), MISC + 10, 64u, vcu >= 128 && vcu < 192);
#ifdef USE_CG
#define GRID_BAR() cooperative_groups::this_grid().sync()
#else
#define GRID_BAR() xcd_barrier(bar)
#endif

    bf16* HN = (bf16*)(ws + WS_HN);
    float* GLOG = (float*)(ws + WS_GLOG);
    float* SLOC = (float*)(ws + WS_HN);
    float* DLOG = (float*)(ws + WS_HN + 16 * MiB);
    bf16* MIX = (bf16*)(ws + WS_MIX);
    bf16* PROJ = (bf16*)(ws + WS_PROJ);
    bf16* FFH = (bf16*)(ws + WS_PROJ);
    bf16* FFHS = (bf16*)(ws + WS_FFHS);
    float* SLAB = (float*)(ws + WS_SLAB);
    float* H = args.out + O_Y;
    const float* xp_in = args.in[0]; const float* xs_in = args.in[1];

#if PH & 1
    for (int q_ = 0; q_ < REP_CONV; ++q_) { convert_weights(args, lds, vcu, G);
    __syncthreads(); }
#endif
#if PH & 2
    for (int q_ = 0; q_ < REP_N1; ++q_)
    norm_phase<1>(lds, vcu, G, xp_in, xs_in, args.in[4], HN, GLOG, nullptr, args.in[5], args.in[6], args.in[7]);
#endif
    GRID_BAR();

#ifdef EXP_ONELAYER
    for (int l = 0; l < 1; ++l) {
#else
    for (int l = 0; l < DEPTH; ++l) {
#endif
        unsigned char* wl = ws + WS_W + (size_t)l * W_LAYER;
#if PH & 4
        if (l > 0) {
            norm_phase<1>(lds, vcu, G, H, H + (size_t)MP * D, args.in[4] + l * D, HN, GLOG, nullptr, args.in[5] + (size_t)l * D * IN_COLS, args.in[6] + l * 16 * 512, args.in[7] + l * 512);
            GRID_BAR();
        }
#endif
        for (int rep_ = 0; rep_ < REP_PROJ; ++rep_) {
#if PH & 8
        {
            pg8::Gemm g{HN, (const bf16*)(wl + W_IN), D, D}; pg8::Order S; S.init(M, NPJ, D, G, bx, 1);
            pg8::EpiProj E{PROJ, args.out + O_SGV + (size_t)l * MS * 512, H};
            pg8::gemm_phase<pg8::EpiProj>(lds, g, S, E);
        }
#endif
        GRID_BAR();
        }
        for (int rep_ = 0; rep_ < REP_MIX; ++rep_) {
        {
            const float* gn = args.in[8] + l * 256;
            const float* wmix = args.in[9] + (size_t)l * 4 * 128 * 128; const float* pscale = args.in[10] + l * 512;
            const float* wsp = args.in[11] + (size_t)l * 4 * 128 * 128; const float* bsp = args.in[12] + l * 4 * 128;
            const float* spool = args.in[3] + (size_t)l * SB * 15 * 512;
#if PH & 32
            {
                for (int q_ = 0; q_ < REP_GS; ++q_)
                for (int it = vcu; it < SB * 4; it += G) { const int n = it >> 2, h = it & 3; const size_t so = ((size_t)(l * SB + n) * 4 + h) * 128 * 256;
                    gla_sample(lds, PROJ, GLOG, MIX, gn, MP + n * ST, h, args.in[2] + so, args.out + O_GLAS + so); }
                if (vcu >= 192) {
                    const int j = vcu - 192, g = j & 3, st = j >> 2;
                    mat128_to_lds(lds, PL_W, PL_SW, wmix + (size_t)g * 128 * 128, false);
                    if (g == 0) pool_tile<0>(lds, PROJ, MIX, pscale, spool, MP + st * 64, 0, true, st * 8);
                    else if (g == 1) pool_tile<1>(lds, PROJ, MIX, pscale + 128, spool, MP + st * 64, 0, true, st * 8);
                    else if (g == 2) pool_tile<2>(lds, PROJ, MIX, pscale + 256, spool, MP + st * 64, 0, true, st * 8);
                    else pool_tile<3>(lds, PROJ, MIX, pscale + 384, spool, MP + st * 64, 0, true, st * 8);
                }
                for (int q_ = 0; q_ < REP_SS; ++q_)
                for (int it = vcu < 192 ? vcu : 1 << 20; it < 512 + 136; it += 192) {
                    int r = it;
                    if (r < 512) { const int g2 = r & 3, n = r >> 2; sg_item(lds, PROJ, MIX, wsp, bsp, MP + n * ST, ST, g2); continue; } r -= 512;
                    const int tid = opaque_tid();
                    if (r < NB) { const int n = r; float* o = args.out + O_POOLP + (size_t)(l * NB + n) * 15 * 512;
                        for (int idx = tid; idx < 15 * 512; idx += 512) { const int i = idx >> 9, c = idx & 511; o[idx] = bf2f(PROJ[(size_t)(n * SEQ + SEQ - 15 + i) * NPJ + C_XP + c]); } }
                    else { const int n = r - NB; float* o = args.out + O_POOLS + (size_t)(l * SB + n) * 15 * 512; const float* hs = spool + (size_t)n * 15 * 512;
                        for (int idx = tid; idx < 15 * 512; idx += 512) { const int i = idx >> 9, c = idx & 511; o[idx] = i < 7 ? hs[(size_t)(8 + i) * 512 + c] : bf2f(PROJ[(size_t)(MP + n * ST + i - 7) * NPJ + C_XP + c]); } }
                }
            }
#endif
            GRID_BAR();
            if (vcu < 128) {
                const int g = vcu & 3;
#define POOL_TILES(T0, T1, FIRST, STEP) do { mat128_to_lds(lds, PL_W, PL_SW, wmix + (size_t)g * 128 * 128, false); \
                for (int tile = (T0) + (FIRST); tile < (T1); tile += (STEP)) { const int row0 = (tile >> 5) * SEQ + (tile & 31) * 64, pos0 = (tile & 31) * 64; \
                    if (g == 0) pool_tile<0>(lds, PROJ, MIX, pscale, nullptr, row0, pos0, false, 0); \
                    else if (g == 1) pool_tile<1>(lds, PROJ, MIX, pscale + 128, nullptr, row0, pos0, false, 0); \
                    else if (g == 2) pool_tile<2>(lds, PROJ, MIX, pscale + 256, nullptr, row0, pos0, false, 0); \
                    else pool_tile<3>(lds, PROJ, MIX, pscale + 384, nullptr, row0, pos0, false, 0); } } while (0)
                if (vcu < 96) {
#if PH & 16
                    const int nh = vcu / 3, js = vcu - 3 * nh;
                    for (int q_ = 0; q_ < REP_P1; ++q_)
                    gla_chunked<false>(lds, PROJ, GLOG, MIX, gn, (nh >> 2) * SEQ + js * (SEQ / 4), SEQ / 256, nh & 3, 0, nullptr, nullptr, SLOC + (size_t)(nh * 3 + js) * 128 * 256, DLOG + (nh * 3 + js) * 128);
#endif
                } else {
#if PH & 32
                    POOL_TILES(0, POOL_EARLY, (vcu - 96) >> 2, 8);
#endif
                }
                xcd_barrier(bar3);
#if PH & 16
                {
                    const int nh = vcu >> 2, js = vcu & 3;
                    for (int q_ = 0; q_ < REP_P2; ++q_)
                    gla_chunked<true>(lds, PROJ, GLOG, MIX, gn, (nh >> 2) * SEQ + js * (SEQ / 4), SEQ / 256, nh & 3, js, SLOC + (size_t)nh * 3 * 128 * 256, DLOG + nh * 3 * 128,
                                      js == 3 ? args.out + O_GLAP + ((size_t)(l * NB + (nh >> 2)) * 4 + (nh & 3)) * 128 * 256 : nullptr, nullptr);
                }
#endif
#if PH & 32
                for (int q_ = 0; q_ < REP_PL2; ++q_)
                POOL_TILES(POOL_EARLY, 256, vcu >> 2, 32);
#endif
#undef POOL_TILES
            }
#if PH & 32
            if (vcu >= 192) {
                const int j = vcu - 192, g = j & 3, jj = j >> 2;
                mat128_to_lds(lds, SG_WT, SG_SW, wsp + (size_t)g * 128 * 128, true);
                for (int ch = jj; ch < 128; ch += 16) sg_chunk(lds, PROJ, MIX, bsp + g * 128, ch * 128, g);
            }
#endif
#if PH & 4096
        if (vcu >= 128 && vcu < 192) {
            const int c2 = vcu - 128;
#define BAR2() do { for (int qb_ = 0; qb_ < REP_BAR2; ++qb_) xcd_barrier(bar2); } while (0)
            if (c2 < 64) { pg8::Gemm g{MIX, (const bf16*)(wl + W_BR), MIXW, MIXW}; pg8::Order S; S.init(MS, D, MIXW, 64, c2, 3, MP / 256, 4);
                pg8::EpiBranch E{PROJ, HN, SLAB}; pg8::gemm_phase<pg8::EpiBranch>(lds, g, S, E); }
            BAR2();
            {   const int tid = opaque_tid();
#pragma unroll 4
                for (int idx = tid; idx < 16 * 256; idx += 512) { const int rr = c2 * 16 + (idx >> 8), c4 = (idx & 255) * 4;
                    f32x4 a = *(const f32x4*)(SLAB + (size_t)rr * D + c4);
#pragma unroll
                    for (int k = 1; k < 4; ++k) a = a + *(const f32x4*)(SLAB + ((size_t)k * MS + rr) * D + c4);
                    v2u o; o.x = pg8::cvt_pk_bf16(a.x, a.y); o.y = pg8::cvt_pk_bf16(a.z, a.w); *(v2u*)(HN + (size_t)(MP + rr) * D + c4) = o; } }
            BAR2();
            if (c2 < 64) { pg8::Gemm g{HN, (const bf16*)(wl + W_OUT), D, D}; pg8::Order S; S.init(MS, D, D, 64, c2, 1, MP / 256, 4);
                pg8::EpiSlab E{SLAB}; pg8::gemm_phase<pg8::EpiSlab>(lds, g, S, E); }
            BAR2();
            for (int half_ = 0; half_ < 2; ++half_)
            {   const int tid = opaque_tid(), lane = tid & 63, wave = __builtin_amdgcn_readfirstlane(tid >> 6), rr = c2 * 16 + half_ * 8 + wave;
                const float* bsrc = (l == 0 ? xs_in : H + (size_t)MP * D) + (size_t)rr * D; float* hrow = H + (size_t)(MP + rr) * D; const float* wn = args.in[17] + l * D;
                f32x4 v[4]; float ss = 0.f;
#pragma unroll
                for (int j = 0; j < 4; ++j) { const int c4 = 4 * lane + 256 * j; f32x4 a = *(const f32x4*)(bsrc + c4);
#pragma unroll
                    for (int k = 0; k < 4; ++k) a = a + *(const f32x4*)(SLAB + ((size_t)k * MS + rr) * D + c4);
                    v[j] = a; *(f32x4*)(hrow + c4) = a; ss += (a.x * a.x + a.y * a.y) + (a.z * a.z + a.w * a.w); }
                const float r = 1.0f / sqrtf(wave_sum(ss) * (1.0f / D) + EPS);
#pragma unroll
                for (int j = 0; j < 4; ++j) { const int c4 = 4 * lane + 256 * j; const f32x4 wv = *(const f32x4*)(wn + c4); const f32x4 y = v[j] * r * wv;
                    v2u o; o.x = pg8::cvt_pk_bf16(y.x, y.y); o.y = pg8::cvt_pk_bf16(y.z, y.w); *(v2u*)(HN + (size_t)(MP + rr) * D + c4) = o; } }
            BAR2();
            for (int q_ = 0; q_ < REP_CH4; ++q_)
            if (c2 < 64) { pg8::Gemm g{HN, (const bf16*)(wl + W_FF1), D, D}; pg8::Order S; S.init(MS, FF, D, 64, c2, 1, MP / 256);
                pg8::EpiRelu2 E{FFHS - (size_t)MP * FF}; pg8::gemm_phase<pg8::EpiRelu2>(lds, g, S, E); }
            BAR2();
            { pg8::Gemm g{FFHS - (size_t)MP * FF, (const bf16*)(wl + W_FF2), FF, FF}; pg8::Order S; S.init(MS, D, FF, 64, c2, 1, MP / 256, 4);
                pg8::EpiSlab E{SLAB}; pg8::gemm_phase<pg8::EpiSlab>(lds, g, S, E); }
            BAR2();
            {   const int tid = opaque_tid();
#pragma unroll 4
                for (int idx = tid; idx < 16 * 256; idx += 512) { const int rr = c2 * 16 + (idx >> 8), c4 = (idx & 255) * 4; float* hp_ = H + (size_t)(MP + rr) * D + c4;
                    f32x4 a = *(const f32x4*)hp_;
#pragma unroll
                    for (int k = 0; k < 4; ++k) a = a + *(const f32x4*)(SLAB + ((size_t)k * MS + rr) * D + c4);
                    *(f32x4*)hp_ = a; } }
#undef BAR2
        }
#endif
        }
        GRID_BAR();
        }
#ifdef EXP_COPYGATES
        {   const int tid = opaque_tid();
            for (int row = vcu; row < M; row += G) for (int c = tid; c < 1024; c += 512) H[(size_t)row * D + c] = bf2f(PROJ[(size_t)row * NPJ + C_G + c]);
        }
        GRID_BAR();
#endif
        for (int rep_ = 0; rep_ < REP_BRANCH; ++rep_) {
#if PH & 64
        {
#ifdef EXP_PLAIN_BRANCH
            pg8::Gemm g{MIX, (const bf16*)(wl + W_BR), MIXW, MIXW}; pg8::Order S; S.init(M, D, MIXW, G, bx, 3);
            pg8::EpiPlain E{HN};
            pg8::gemm_phase<pg8::EpiPlain>(lds, g, S, E);
#else
            pg8::Gemm g{MIX, (const bf16*)(wl + W_BR), MIXW, MIXW}; pg8::Order S; S.init(MROWS, D, MIXW, G, bx, 3);
            pg8::EpiBranch E{PROJ, HN, nullptr};
            pg8::gemm_phase<pg8::EpiBranch>(lds, g, S, E);
#endif
        }
#endif
        GRID_BAR();
        }
#if PH & 128
        {
            pg8::Gemm g{HN, (const bf16*)(wl + W_OUT), D, D}; pg8::Order S; S.init(MROWS, D, D, G, bx, 1);
            pg8::EpiResid E{l == 0 ? xp_in : H, l == 0 ? xs_in : H + (size_t)MP * D, H};
            pg8::gemm_phase<pg8::EpiResid>(lds, g, S, E);
        }
#endif
        GRID_BAR();
        for (int rep_ = 0; rep_ < REP_NORM2; ++rep_) {
#if PH & 256
        norm_phase<0>(lds, vcu, G, H, H + (size_t)MP * D, args.in[17] + l * D, HN, nullptr, nullptr, nullptr, nullptr, nullptr, 0, MROWS);
#endif
        GRID_BAR();
        }
        for (int rep_ = 0; rep_ < REP_FFN1; ++rep_) {
#if PH & 512
        {
            pg8::Gemm g{HN, (const bf16*)(wl + W_FF1), D, D}; pg8::Order S; S.init(MROWS, FF, D, G, bx, 1);
            pg8::EpiRelu2 E{FFH};
            pg8::gemm_phase<pg8::EpiRelu2>(lds, g, S, E);
        }
#endif
        GRID_BAR();
        }
#if PH & 1024
        {
            pg8::Gemm g{FFH, (const bf16*)(wl + W_FF2), FF, FF}; pg8::Order S; S.init(MROWS, D, FF, G, bx, 1);
            pg8::EpiResid E{H, H + (size_t)MP * D, H};
            pg8::gemm_phase<pg8::EpiResid>(lds, g, S, E);
        }
#endif
        GRID_BAR();
    }
#if PH & 2048
    norm_phase<2>(lds, vcu, G, H, H + (size_t)MP * D, args.in[20], nullptr, nullptr, H, nullptr, nullptr, nullptr);
#endif
}

extern "C" void kernel_launch(void* const* d_in, const int* in_sizes, int n_in, void* d_out, int out_size, void* d_ws, size_t ws_size, hipStream_t stream) {
    static int grid = 0;
    if (grid == 0) {
        if (n_in != 21 || in_sizes[0] != MP * D || (size_t)out_size != O_END || ws_size < WS_END) {
            fprintf(stderr, "kernel_launch: unexpected shapes: n_in %d in0 %d out %d ws %zu (need %zu)\n", n_in, n_in > 0 ? in_sizes[0] : -1, out_size, ws_size, (size_t)WS_END); grid = -1; return; }
        int dev = 0, cus = 0, per_cu = 0;
        if (hipGetDevice(&dev) != hipSuccess || hipDeviceGetAttribute(&cus, hipDeviceAttributeMultiprocessorCount, dev) != hipSuccess) { grid = -1; return; }
        if (hipFuncSetAttribute((const void*)hybrid_fwd, hipFuncAttributeMaxDynamicSharedMemorySize, LDS_BYTES) != hipSuccess) { fprintf(stderr, "kernel_launch: hipFuncSetAttribute failed\n"); grid = -1; return; }
        if (hipOccupancyMaxActiveBlocksPerMultiprocessor(&per_cu, (const void*)hybrid_fwd, NWAVES * 64, LDS_BYTES) != hipSuccess || per_cu < 1) {
            fprintf(stderr, "kernel_launch: occupancy query reports %d blocks per CU\n", per_cu); (void)hipGetLastError(); grid = -1; return; }
        grid = cus;
    }
    if (grid < 0) return;
    if (hipMemsetAsync((char*)d_ws + WS_CTL, 0, CTL_ZERO_BYTES, stream) != hipSuccess) { fprintf(stderr, "kernel_launch: memset failed\n"); return; }
    Args a{};
    for (int i = 0; i < 21; ++i) a.in[i] = (const float*)d_in[i];
    a.out = (float*)d_out; a.ws = (unsigned char*)d_ws;
    void* kargs[] = {&a};
    hipError_t e = hipLaunchCooperativeKernel((const void*)hybrid_fwd, dim3(grid), dim3(NWAVES * 64), kargs, LDS_BYTES, stream);
    if (e != hipSuccess) fprintf(stderr, "kernel_launch: cooperative launch failed: %s (grid %d)\n", hipGetErrorString(e), grid);
}
```
